# Optimizing an MI355X kernel written in HIP

```python
import jax, jax.numpy as jnp
from jax import lax
import numpy as np

D_MODEL = 1024
BATCH = 8
SEQ = 8192
DEPTH = 2

A_HEADS = 4
A_HEAD_DIM = 128
D_A = A_HEADS * A_HEAD_DIM
CHUNK = 128
B_GROUPS = 4
D_B = D_MODEL - D_A
B_CONV = 3
D_IN_AB = 2 * D_A + 3 * D_B
D_RNN = D_MODEL
LRU_HEADS = 8
LRU_HEAD_DIM = D_RNN // LRU_HEADS
C_CONV = 4
LRU_C = 8.0
N_GROUPS = 4
EXPERTS_PER_GROUP = 8
N_EXPERTS = N_GROUPS * EXPERTS_PER_GROUP
TOP_K = 2
D_EXPERT = 512
MOE_BLOCK = 128
N_EVEN = (DEPTH + 1) // 2
N_ODD = DEPTH // 2
EPS = 1e-6

kernel_name = "hybrid_gmlp_shortconv_rglru_hmoe"


def rms_norm(x, g):
    xf = x.astype(jnp.float32)
    y = xf * lax.rsqrt(jnp.mean(jnp.square(xf), axis=-1, keepdims=True) + EPS)
    return y.astype(x.dtype) * g


def layer_norm(x, g):
    xf = x.astype(jnp.float32)
    mu = jnp.mean(xf, axis=-1, keepdims=True)
    var = jnp.mean(jnp.square(xf - mu), axis=-1, keepdims=True)
    return ((xf - mu) * lax.rsqrt(var + EPS)).astype(x.dtype) * g


def causal_conv(x, w):
    k_width = w.shape[0]
    t_len = x.shape[1]
    xp = jnp.pad(x, ((0, 0), (k_width - 1, 0), (0, 0)))
    y = xp[:, 0:t_len] * w[0]
    for k in range(1, k_width):
        y = y + xp[:, k:k + t_len] * w[k]
    return y


def mixer_ab(h, w_in, a_ln_g, a_ws, a_ws_b, b_conv_w, w_out):
    bsz, t_len, _ = h.shape
    z = h @ w_in
    u, v, gate_b, gate_c, xb = jnp.split(
        z, [D_A, 2 * D_A, 2 * D_A + D_B, 2 * D_A + 2 * D_B], axis=-1)
    u = jax.nn.gelu(u)
    v = layer_norm(jax.nn.gelu(v), a_ln_g)
    vc = v.reshape(bsz, t_len // CHUNK, CHUNK, A_HEADS, A_HEAD_DIM)
    causal = jnp.tril(jnp.ones((CHUNK, CHUNK), dtype=bool))
    ws = jnp.where(causal, a_ws, 0.0)
    mixed = jnp.einsum('hts,bcshd->bcthd', ws, vc) + a_ws_b.T[:, :, None]
    y_a = u * mixed.reshape(bsz, t_len, D_A)
    y_b = gate_b * causal_conv(gate_c * xb, b_conv_w)
    return jnp.concatenate([y_a, y_b], axis=-1) @ w_out


def mixer_rglru(h, w_in, conv_w, conv_b, w_a, b_a, w_x, b_x, lam, w_out):
    bsz, t_len, _ = h.shape
    gate, xr = jnp.split(h @ w_in, [D_RNN], axis=-1)
    gate = jax.nn.gelu(gate)
    xr = causal_conv(xr, conv_w) + conv_b
    xh = xr.reshape(bsz, t_len, LRU_HEADS, LRU_HEAD_DIM)
    r = jax.nn.sigmoid(jnp.einsum('bthi,hij->bthj', xh, w_a).reshape(bsz, t_len, D_RNN) + b_a)
    i = jax.nn.sigmoid(jnp.einsum('bthi,hij->bthj', xh, w_x).reshape(bsz, t_len, D_RNN) + b_x)
    log_a = (LRU_C * r.astype(jnp.float32)) * jax.nn.log_sigmoid(lam.astype(jnp.float32))
    a = jnp.exp(log_a)
    b = jnp.sqrt(-jnp.expm1(2.0 * log_a)) * (i * xr).astype(jnp.float32)

    def combine(left, right):
        a_l, b_l = left
        a_r, b_r = right
        return a_l * a_r, a_r * b_l + b_r

    _, hseq = lax.associative_scan(combine, (a, b), axis=1)
    return (gate * hseq.astype(h.dtype)) @ w_out


def hierarchical_moe(h, w_rg, b_rg, w_re, b_re, w_gate, w_up, w_down):
    bsz, t_len, d = h.shape
    n_tok = bsz * t_len
    xt = h.reshape(n_tok, d)
    g_logits = (xt @ w_rg + b_rg).astype(jnp.float32)
    g_idx = jnp.argmax(g_logits, axis=-1)
    g_prob = jnp.take_along_axis(jax.nn.softmax(g_logits, axis=-1), g_idx[:, None], axis=-1)
    e_logits = (xt @ w_re + b_re).astype(jnp.float32).reshape(n_tok, N_GROUPS, EXPERTS_PER_GROUP)
    e_sel = jnp.take_along_axis(e_logits, g_idx[:, None, None], axis=1)[:, 0]
    top_val, top_idx = lax.top_k(e_sel, TOP_K)
    gates = g_prob * jax.nn.softmax(top_val, axis=-1)
    expert_ids = g_idx[:, None].astype(jnp.int32) * EXPERTS_PER_GROUP + top_idx.astype(jnp.int32)

    n_slots = n_tok * TOP_K
    n_blocks = -(-n_slots // MOE_BLOCK) + N_EXPERTS
    flat_e = expert_ids.reshape(n_slots)
    flat_tok = jnp.repeat(jnp.arange(n_tok, dtype=jnp.int32), TOP_K)
    flat_g = gates.reshape(n_slots)
    order = jnp.argsort(flat_e)
    sorted_e = flat_e[order]
    counts = jnp.bincount(flat_e, length=N_EXPERTS)
    starts = jnp.cumsum(counts) - counts
    padded = (counts + MOE_BLOCK - 1) // MOE_BLOCK * MOE_BLOCK
    pad_ends = jnp.cumsum(padded)
    pad_starts = pad_ends - padded
    dest = pad_starts[sorted_e] + (jnp.arange(n_slots, dtype=jnp.int32) - starts[sorted_e])
    slot_tok = jnp.full((n_blocks * MOE_BLOCK,), n_tok, jnp.int32).at[dest].set(flat_tok[order])
    slot_g = jnp.zeros((n_blocks * MOE_BLOCK,), jnp.float32).at[dest].set(flat_g[order])
    block_e = jnp.minimum(
        jnp.searchsorted(pad_ends, jnp.arange(n_blocks, dtype=jnp.int32) * MOE_BLOCK, side='right'),
        N_EXPERTS - 1)
    x_pad = jnp.concatenate([xt, jnp.zeros((1, d), xt.dtype)], axis=0)

    def expert_block(args):
        tok_b, g_b, e = args
        xb = x_pad[tok_b]
        hid = jax.nn.silu(xb @ w_gate[e]) * (xb @ w_up[e])
        return (hid @ w_down[e]) * g_b[:, None].astype(xb.dtype)

    y = lax.map(expert_block, (slot_tok.reshape(n_blocks, MOE_BLOCK),
                               slot_g.reshape(n_blocks, MOE_BLOCK), block_e))
    out = jax.ops.segment_sum(y.reshape(-1, d), slot_tok, num_segments=n_tok + 1)[:n_tok]
    return out.reshape(bsz, t_len, d)


def setup_inputs(seed: int = 0) -> dict:
    key = jax.random.key(seed)
    ks = jax.random.split(key, 26)

    def nrm(k, shape, scale):
        return jax.random.normal(k, shape, jnp.float32) * scale

    a8 = jax.random.uniform(ks[17], (N_ODD, D_RNN), jnp.float32, 0.9, 0.999)
    a_base = a8 ** (1.0 / LRU_C)
    c_lambda = jnp.log(a_base) - jnp.log1p(-a_base)
    return {
        "x": nrm(ks[0], (BATCH, SEQ, D_MODEL), 1.0),
        "norm_mix_g": 1.0 + nrm(ks[1], (DEPTH, D_MODEL), 0.05),
        "norm_ffn_g": 1.0 + nrm(ks[2], (DEPTH, D_MODEL), 0.05),
        "norm_final_g": 1.0 + nrm(ks[3], (D_MODEL,), 0.05),
        "ab_w_in": nrm(ks[4], (N_EVEN, D_MODEL, D_IN_AB), D_MODEL ** -0.5),
        "a_ln_g": 1.0 + nrm(ks[5], (N_EVEN, D_A), 0.05),
        "a_ws": nrm(ks[6], (N_EVEN, A_HEADS, CHUNK, CHUNK), CHUNK ** -0.5),
        "a_ws_b": 1.0 + nrm(ks[7], (N_EVEN, A_HEADS, CHUNK), 0.1),
        "b_conv_w": nrm(ks[8], (N_EVEN, B_CONV, D_B), B_CONV ** -0.5),
        "ab_w_out": nrm(ks[9], (N_EVEN, D_A + D_B, D_MODEL), (D_A + D_B) ** -0.5),
        "c_w_in": nrm(ks[10], (N_ODD, D_MODEL, 2 * D_RNN), D_MODEL ** -0.5),
        "c_conv_w": nrm(ks[11], (N_ODD, C_CONV, D_RNN), C_CONV ** -0.5),
        "c_conv_b": nrm(ks[12], (N_ODD, D_RNN), 0.01),
        "c_w_a": nrm(ks[13], (N_ODD, LRU_HEADS, LRU_HEAD_DIM, LRU_HEAD_DIM), LRU_HEAD_DIM ** -0.5),
        "c_b_a": nrm(ks[14], (N_ODD, D_RNN), 0.01),
        "c_w_x": nrm(ks[15], (N_ODD, LRU_HEADS, LRU_HEAD_DIM, LRU_HEAD_DIM), LRU_HEAD_DIM ** -0.5),
        "c_b_x": nrm(ks[16], (N_ODD, D_RNN), 0.01),
        "c_lambda": c_lambda,
        "c_w_out": nrm(ks[18], (N_ODD, D_RNN, D_MODEL), D_RNN ** -0.5),
        "moe_w_rg": nrm(ks[19], (DEPTH, D_MODEL, N_GROUPS), D_MODEL ** -0.5),
        "moe_b_rg": nrm(ks[20], (DEPTH, N_GROUPS), 0.01),
        "moe_w_re": nrm(ks[21], (DEPTH, D_MODEL, N_EXPERTS), D_MODEL ** -0.5),
        "moe_b_re": nrm(ks[22], (DEPTH, N_EXPERTS), 0.01),
        "moe_w_gate": nrm(ks[23], (DEPTH, N_EXPERTS, D_MODEL, D_EXPERT), D_MODEL ** -0.5),
        "moe_w_up": nrm(ks[24], (DEPTH, N_EXPERTS, D_MODEL, D_EXPERT), D_MODEL ** -0.5),
        "moe_w_down": nrm(ks[25], (DEPTH, N_EXPERTS, D_EXPERT, D_MODEL), D_EXPERT ** -0.5),
    }


def reference(x, norm_mix_g, norm_ffn_g, norm_final_g,
              ab_w_in, a_ln_g, a_ws, a_ws_b, b_conv_w, ab_w_out,
              c_w_in, c_conv_w, c_conv_b, c_w_a, c_b_a, c_w_x, c_b_x, c_lambda, c_w_out,
              moe_w_rg, moe_b_rg, moe_w_re, moe_b_re, moe_w_gate, moe_w_up, moe_w_down):
    for layer in range(DEPTH):
        idx = layer // 2
        h = rms_norm(x, norm_mix_g[layer])
        if layer % 2 == 0:
            x = x + mixer_ab(h, ab_w_in[idx], a_ln_g[idx], a_ws[idx], a_ws_b[idx],
                             b_conv_w[idx], ab_w_out[idx])
        else:
            x = x + mixer_rglru(h, c_w_in[idx], c_conv_w[idx], c_conv_b[idx], c_w_a[idx],
                                c_b_a[idx], c_w_x[idx], c_b_x[idx], c_lambda[idx], c_w_out[idx])
        h = rms_norm(x, norm_ffn_g[layer])
        x = x + hierarchical_moe(h, moe_w_rg[layer], moe_b_rg[layer], moe_w_re[layer],
                                 moe_b_re[layer], moe_w_gate[layer], moe_w_up[layer],
                                 moe_w_down[layer])
    return rms_norm(x, norm_final_g)
```

```cpp
#include <hip/hip_runtime.h>
#include <cstdio>
#include <cstdint>

#ifndef DBG_STOP
#define DBG_STOP 4
#endif
#ifndef MK_CUTS
#define MK_CUTS 0
#endif

#define LAS __attribute__((address_space(3)))
#define GAS __attribute__((address_space(1)))
typedef unsigned short bf16;
typedef short bf16x8 __attribute__((ext_vector_type(8)));
typedef float f32x4 __attribute__((ext_vector_type(4)));
typedef float f32x2 __attribute__((ext_vector_type(2)));
typedef unsigned u32x4 __attribute__((ext_vector_type(4)));
typedef unsigned u32x2 __attribute__((ext_vector_type(2)));

constexpr int D = 1024, NBATCH = 8, SEQ = 8192, M = NBATCH * SEQ;
constexpr int NE = 32, DE = 512, NPAIR = 112;
constexpr float EPS = 1e-6f;
constexpr int NPH = 16;
#ifdef ONLY_PH
__host__ __device__ constexpr bool ph_on(int k) { return ((ONLY_PH >> k) & 1) != 0; }
#else
__host__ __device__ constexpr bool ph_on(int k) { return (k <= 3) || (k >= 4 && k <= 6 && DBG_STOP >= 2) || (k >= 7 && k <= 11 && DBG_STOP >= 3) || (k >= 12 && k <= 14 && DBG_STOP >= 4) || k == 15; }
#endif

constexpr size_t MiB = 1u << 20;
constexpr size_t WS_CTL = 0, CTL_ZERO_BYTES = 1 * MiB;
constexpr size_t WS_WSB = 1 * MiB;
constexpr size_t WS_WAX = 1 * MiB + 256 * 1024;
constexpr size_t WS_WRT = 2 * MiB;
constexpr size_t WS_RSTD = 3 * MiB;
constexpr size_t WS_CAR = 4 * MiB;
constexpr size_t WS_ELT = 8 * MiB;
constexpr size_t WS_ELG = 16 * MiB;
constexpr size_t WS_PLT = 24 * MiB;
constexpr size_t WS_WREST = 52 * MiB;
constexpr size_t WS_WV = 56 * MiB;
constexpr size_t WS_WO = 57 * MiB;
constexpr size_t WS_WC = 59 * MiB;
constexpr size_t WS_WCO = 63 * MiB;
constexpr size_t WS_WGU = 65 * MiB;
constexpr size_t WS_WD = 193 * MiB;
constexpr size_t WS_H = 257 * MiB;
constexpr size_t WS_Z = 385 * MiB;
constexpr size_t WS_VT = 641 * MiB;
constexpr size_t WS_Y = 705 * MiB;
constexpr size_t WS_END = 833 * MiB;
constexpr int CW_TMO = 0;
constexpr int CW_ECNT = 8192;
constexpr int CW_PCNT = 12288;
constexpr int CW_BAR = 32768;
constexpr int LDS_BYTES = 147456;
constexpr int TAB_OFF = 131072;
constexpr int MISC_OFF = LDS_BYTES - 256;

__device__ __forceinline__ float bflo(unsigned w) { return __uint_as_float(w << 16); }
__device__ __forceinline__ float bfhi(unsigned w) { return __uint_as_float(w & 0xffff0000u); }
__device__ __forceinline__ float bf1(unsigned short b) { return __uint_as_float(((unsigned)b) << 16); }
__device__ __forceinline__ unsigned cvt_pk_bf16(float lo, float hi) { unsigned r; asm volatile("v_cvt_pk_bf16_f32 %0, %1, %2" : "=v"(r) : "v"(lo), "v"(hi)); return r; }
__device__ __forceinline__ float wave_sum(float v) {
#pragma unroll
    for (int o = 1; o < 64; o <<= 1) v += __shfl_xor(v, o);
    return v;
}
__device__ __forceinline__ float sigmoidf_(float x) { return __builtin_amdgcn_rcpf(1.0f + __builtin_amdgcn_exp2f(-1.44269504f * x)); }
__device__ __forceinline__ float gelu_tanh(float x) { const float z = x * (1.0f + 0.044715f * x * x); return x * __builtin_amdgcn_rcpf(1.0f + __builtin_amdgcn_exp2f(-2.3022082f * z)); }
#define LDS_WAIT() asm volatile("s_waitcnt lgkmcnt(0)" ::: "memory")
#define VM_WAIT() asm volatile("s_waitcnt vmcnt(0)" ::: "memory")

namespace pg8 {
constexpr int BM = 256, BK = 64, HALF = 128, HTB = HALF * BK * 2, STAGE_BYTES = 8 * HTB, NXCD = 8, WGM = 8;
__host__ __device__ __forceinline__ int lds_byte(int r, int c) { const int st = (r >> 4) * 2 + (c >> 5), rr = r & 15, cc = c & 31, ob = rr * 64 + cc * 2; return st * 1024 + (ob ^ (((ob >> 9) & 1) << 5)); }
__host__ __device__ __forceinline__ void stage_rc(int b, int& R, int& C) { const int st = b / 1024, sb = b % 1024, swz = sb ^ (((sb >> 9) & 1) << 5); R = (st >> 1) * 16 + swz / 64; C = (st & 1) * 32 + (swz % 64) / 2; }
__host__ __device__ __forceinline__ int perm32(int rho) { const int n = rho >> 4, i = rho & 15; return 8 * (i >> 2) + 4 * n + (i & 3); }

struct Unit { int pm, pn; const char* A; const char* B0; const char* B1; const unsigned* list; const float* glist; int nvalid; };

template <class Epi, class Sched, bool GATHER>
__device__ __forceinline__ void gemm_phase(LAS unsigned char* lds, const int lda, const int ldb, const int K, const int nth, const Sched& S, const Epi& E) {
    const int tid = threadIdx.x, wid = __builtin_amdgcn_readfirstlane(tid >> 6), lane = tid & 63, wr = wid >> 2, wc = wid & 3, fr = lane & 15, fq = lane >> 4;
    const int nt = K / BK;
    int Rr[2], Cc[2]; unsigned voffB[2];
#pragma unroll
    for (int i = 0; i < 2; ++i) { int R, C; stage_rc(tid * 16 + i * 8192, R, C); Rr[i] = R; Cc[i] = C; const int Rb = Epi::PERM ? ((R & ~31) + perm32(R & 31)) : R; voffB[i] = (unsigned)(Rb * ldb + C) * 2u; }
    const size_t kstep = (size_t)(BK * 2);
    const size_t hstepB = (size_t)HALF * ldb * 2;
    const unsigned ldsw = (unsigned)wid * 1024u;
    const int aoff = lds_byte(wr * 64 + fr, fq * 8), boff = lds_byte(wc * 32 + fr, fq * 8);
#define PG8_SA(b, h) (((b) * 2 + (h)) * HTB)
#define PG8_SB(b, h) ((4 + (b) * 2 + (h)) * HTB)
#define PG8_STAGE(bufoff, gbase, voff) do { _Pragma("unroll") for (int _i = 0; _i < 2; ++_i) \
        __builtin_amdgcn_global_load_lds((const unsigned*)((const char*)(gbase) + (voff)[_i]), (LAS unsigned*)(lds + (bufoff) + ldsw + _i * 8192), 16, 0, 0); } while (0)
#define PG8_LDA(dst, b, h) do { _Pragma("unroll") for (int m = 0; m < 4; ++m) _Pragma("unroll") for (int k = 0; k < 2; ++k) dst[m][k] = *(const LAS bf16x8*)(lds + PG8_SA(b, h) + aoff + m * 2048 + k * 1024); } while (0)
#define PG8_LDB(dst, b, h) do { _Pragma("unroll") for (int n = 0; n < 2; ++n) _Pragma("unroll") for (int k = 0; k < 2; ++k) dst[n][k] = *(const LAS bf16x8*)(lds + PG8_SB(b, h) + boff + n * 2048 + k * 1024); } while (0)
#define PG8_MMA(ai, bj, At, Bt) do { __builtin_amdgcn_s_setprio(1); _Pragma("unroll") for (int m = 0; m < 4; ++m) _Pragma("unroll") for (int n = 0; n < 2; ++n) _Pragma("unroll") for (int k = 0; k < 2; ++k) \
        acc[ai][bj][m][n] = __builtin_amdgcn_mfma_f32_16x16x32_bf16(Bt[n][k], At[m][k], acc[ai][bj][m][n], 0, 0, 0); __builtin_amdgcn_s_setprio(0); } while (0)
#define PG8_WAIT_V(n) asm volatile("s_waitcnt vmcnt(" #n ")" ::: "memory")
#define PG8_WAIT_L(n) asm volatile("s_waitcnt lgkmcnt(" #n ")" ::: "memory")
#define PG8_BAR __builtin_amdgcn_s_barrier()
#define PG8_SCHED __builtin_amdgcn_sched_barrier(0)
    Unit cur, nxt; int ui = 0;
    if (!S.next(0, cur)) return;
    unsigned offc[2][2], offn[2][2], nid[2][2];
#pragma unroll
    for (int h = 0; h < 2; ++h)
#pragma unroll
        for (int i = 0; i < 2; ++i) {
            const int r = Rr[i] + HALF * h;
            if constexpr (GATHER) { const unsigned ent = r < cur.nvalid ? cur.list[r] : 0u; offc[h][i] = (ent & 0x7fffffffu) * (unsigned)(lda * 2) + (unsigned)(Cc[i] * 2); }
            else offc[h][i] = (unsigned)(r * lda + Cc[i]) * 2u;
            offn[h][i] = offc[h][i]; nid[h][i] = 0u;
        }
    f32x4 acc[2][2][4][2];
#pragma unroll
    for (int a = 0; a < 2; ++a)
#pragma unroll
        for (int b = 0; b < 2; ++b)
#pragma unroll
            for (int m = 0; m < 4; ++m)
#pragma unroll
                for (int n = 0; n < 2; ++n) acc[a][b][m][n] = (f32x4){0.f, 0.f, 0.f, 0.f};
    bf16x8 At[4][2], B0[2][2], B1[2][2];
    const char* cA = cur.A; const char* cB0 = cur.B0; const char* cB1 = cur.B1;
    PG8_STAGE(PG8_SB(0, 0), cB0, voffB); PG8_STAGE(PG8_SB(0, 1), cB0 + hstepB, voffB); PG8_STAGE(PG8_SA(0, 0), cA, offc[0]); PG8_STAGE(PG8_SA(0, 1), cA, offc[1]);
    if (wr == 1) PG8_BAR;
    PG8_WAIT_V(2); PG8_BAR;
    PG8_STAGE(PG8_SB(1, 0), cB0 + kstep, voffB); PG8_STAGE(PG8_SA(1, 0), cA + kstep, offc[0]); PG8_STAGE(PG8_SB(1, 1), cB0 + hstepB + kstep, voffB);
    PG8_WAIT_V(6); PG8_BAR;
    for (;;) {
        const bool has_next = S.next(ui + 1, nxt);
        if constexpr (GATHER) {
            if (has_next) {
#pragma unroll
                for (int h = 0; h < 2; ++h)
#pragma unroll
                    for (int i = 0; i < 2; ++i) { const int r = Rr[i] + HALF * h; nid[h][i] = r < nxt.nvalid ? nxt.list[r] : 0u; }
            }
        }
        const char* nA = has_next ? nxt.A : cA; const char* nB0 = has_next ? nxt.B0 : cB0;
        for (int t = 0; t < nt; t += 2) {
            const bool last = (t == nt - 2);
            const char* a1 = cA + (size_t)(t + 1) * kstep;
            const char* a2 = last ? nA : cA + (size_t)(t + 2) * kstep;
            const char* b2 = last ? nB0 : ((t + 2 < nth) ? cB0 + (size_t)(t + 2) * kstep : cB1 + (size_t)(t + 2 - nth) * kstep);
            const char* a3 = a2 + kstep; const char* b3 = b2 + kstep;
            unsigned o2[2][2];
            if constexpr (GATHER) {
                if (last && has_next) {
#pragma unroll
                    for (int h = 0; h < 2; ++h)
#pragma unroll
                        for (int i = 0; i < 2; ++i) offn[h][i] = (nid[h][i] & 0x7fffffffu) * (unsigned)(lda * 2) + (unsigned)(Cc[i] * 2);
                }
#pragma unroll
                for (int h = 0; h < 2; ++h)
#pragma unroll
                    for (int i = 0; i < 2; ++i) o2[h][i] = (last && has_next) ? offn[h][i] : offc[h][i];
            } else {
#pragma unroll
                for (int h = 0; h < 2; ++h)
#pragma unroll
                    for (int i = 0; i < 2; ++i) o2[h][i] = offc[h][i];
            }
            PG8_LDB(B0, 0, 0); PG8_LDB(B1, 0, 1); PG8_SCHED; PG8_LDA(At, 0, 0); PG8_STAGE(PG8_SA(1, 1), a1, offc[1]);
            PG8_WAIT_V(8); PG8_WAIT_L(0); PG8_BAR; PG8_MMA(0, 0, At, B0); PG8_MMA(0, 1, At, B1); PG8_BAR; PG8_SCHED;
            PG8_LDA(At, 0, 1); PG8_STAGE(PG8_SB(0, 0), b2, voffB); PG8_STAGE(PG8_SB(0, 1), b2 + hstepB, voffB); PG8_STAGE(PG8_SA(0, 0), a2, o2[0]);
            PG8_WAIT_V(8); PG8_WAIT_L(0); PG8_BAR; PG8_MMA(1, 0, At, B0); PG8_MMA(1, 1, At, B1); PG8_BAR; PG8_SCHED;
            PG8_LDB(B0, 1, 0); PG8_LDB(B1, 1, 1); PG8_SCHED; PG8_LDA(At, 1, 0); PG8_STAGE(PG8_SA(0, 1), a2, o2[1]);
            PG8_WAIT_V(8); PG8_WAIT_L(0); PG8_BAR; PG8_MMA(0, 0, At, B0); PG8_MMA(0, 1, At, B1); PG8_BAR; PG8_SCHED;
            PG8_LDA(At, 1, 1); PG8_STAGE(PG8_SB(1, 0), b3, voffB); PG8_STAGE(PG8_SB(1, 1), b3 + hstepB, voffB); PG8_STAGE(PG8_SA(1, 0), a3, o2[0]);
            PG8_WAIT_V(8); PG8_WAIT_L(0); PG8_BAR; PG8_MMA(1, 0, At, B0); PG8_MMA(1, 1, At, B1); PG8_BAR; PG8_SCHED;
        }
        if (wr == 0) PG8_BAR;
        E(acc, cur, wr, wc, fr, fq);
        if (!has_next) break;
#pragma unroll
        for (int a = 0; a < 2; ++a)
#pragma unroll
            for (int b = 0; b < 2; ++b)
#pragma unroll
                for (int m = 0; m < 4; ++m)
#pragma unroll
                    for (int n = 0; n < 2; ++n) acc[a][b][m][n] = (f32x4){0.f, 0.f, 0.f, 0.f};
        cur = nxt; cA = nA; cB0 = nB0; cB1 = nxt.B1; ++ui;
        if constexpr (GATHER) {
#pragma unroll
            for (int h = 0; h < 2; ++h)
#pragma unroll
                for (int i = 0; i < 2; ++i) offc[h][i] = offn[h][i];
        }
        if (wr == 1) PG8_BAR;
    }
    PG8_WAIT_V(0);
    PG8_BAR;
#undef PG8_SA
#undef PG8_SB
#undef PG8_STAGE
#undef PG8_LDA
#undef PG8_LDB
#undef PG8_MMA
#undef PG8_WAIT_V
#undef PG8_WAIT_L
#undef PG8_BAR
#undef PG8_SCHED
}

struct DenseOrder {
    int nM, nN, nwg, G, c; const char* A; const char* B; size_t tA, tB, b1off;
    __device__ __forceinline__ void init(int Mr, int N, int G_, int c_, const void* A_, int lda, const void* B_, int ldb, int nth) {
        nM = Mr / BM; nN = N / BM; nwg = nM * nN; G = G_; c = c_; A = (const char*)A_; B = (const char*)B_; tA = (size_t)BM * lda * 2; tB = (size_t)BM * ldb * 2; b1off = (size_t)nth * BK * 2; }
    __device__ __forceinline__ bool next(int i, Unit& u) const {
        const long L = (long)i * G + c; if (L >= nwg) return false;
        int wgid = (int)L; { const int q = nwg / NXCD, r = nwg % NXCD, xcd = wgid % NXCD, off = wgid / NXCD; wgid = (xcd < r ? xcd * (q + 1) : r * (q + 1) + (xcd - r) * q) + off; }
        const int nig = WGM * nN, gid = wgid / nig, fm = gid * WGM, gsz = (nM - fm) < WGM ? (nM - fm) : WGM;
        u.pm = fm + ((wgid % nig) % gsz); u.pn = (wgid % nig) / gsz;
        u.A = A + (size_t)u.pm * tA; u.B0 = B + (size_t)u.pn * tB; u.B1 = u.B0 + b1off; u.list = nullptr; u.glist = nullptr; u.nvalid = BM; return true;
    }
};
__device__ __forceinline__ int find_group(const LAS int* pref, int n, int rt, int lane) {
    const int j0 = lane, j1 = lane + 64;
    const bool f0 = j0 < n && pref[j0] <= rt && rt < pref[j0 + 1];
    const bool f1 = j1 < n && pref[j1] <= rt && rt < pref[j1 + 1];
    const unsigned long long m0 = __ballot(f0), m1 = __ballot(f1);
    return m0 ? (int)__builtin_ctzll(m0) : 64 + (int)__builtin_ctzll(m1 | (1ull << 63));
}
template <bool PAIR> struct GroupOrder {
    static constexpr size_t WSTRIDE = PAIR ? (size_t)1024 * 512 * 2 : (size_t)1024 * 1024 * 2, TB = PAIR ? (size_t)256 * 512 * 2 : (size_t)256 * 1024 * 2;
    const LAS int* pref; int ng, G, c, lane;
    const char* A; const char* W; const unsigned* lists; const float* glists;
    __device__ __forceinline__ bool next(int i, Unit& u) const {
        const LAS int* cnt = pref + 130;
        const long L = (long)i * G + c; const int total = __builtin_amdgcn_readfirstlane(pref[ng]);
        if (L >= 4L * total) return false;
        const int rt = (int)(L >> 2); u.pn = (int)(L & 3);
        const int g = __builtin_amdgcn_readfirstlane(find_group(pref, ng, rt, lane));
        const int tr = rt - __builtin_amdgcn_readfirstlane(pref[g]); const int cg = __builtin_amdgcn_readfirstlane(cnt[g]);
        u.pm = tr; u.nvalid = (cg - tr * BM) < BM ? (cg - tr * BM) : BM;
        u.list = lists + (size_t)g * 65536 + (size_t)tr * BM; u.glist = PAIR ? nullptr : glists + (size_t)g * 65536 + (size_t)tr * BM;
        u.A = A;
        if (PAIR) { const int grp = g / 28; int pi = g % 28, lo = 0; while (pi >= 7 - lo) { pi -= 7 - lo; ++lo; } const int hi = lo + 1 + pi;
            u.B0 = W + (size_t)(grp * 8 + lo) * WSTRIDE + (size_t)u.pn * TB; u.B1 = W + (size_t)(grp * 8 + hi) * WSTRIDE + (size_t)u.pn * TB; }
        else { u.B0 = W + (size_t)g * WSTRIDE + (size_t)u.pn * TB; u.B1 = u.B0; }
        return true;
    }
};

template <bool SCALE_COL> struct EpiZ {
    static constexpr bool PERM = true;
    bf16* O; int ldc; const float* rstd; int gelu_lt;
    __device__ __forceinline__ void operator()(const f32x4 (&acc)[2][2][4][2], const Unit& u, int wr, int wc, int fr, int fq) const {
        const int row0 = u.pm * BM + wr * 64 + fr, col0 = u.pn * BM + wc * 32 + 8 * fq; const bool act = u.pn < gelu_lt;
        f32x4 cs[2][2];
#pragma unroll
        for (int bj = 0; bj < 2; ++bj)
#pragma unroll
            for (int n = 0; n < 2; ++n) cs[bj][n] = SCALE_COL ? *(const f32x4*)(rstd + col0 + bj * HALF + 4 * n) : (f32x4){1.f, 1.f, 1.f, 1.f};
#pragma unroll
        for (int ai = 0; ai < 2; ++ai)
#pragma unroll
            for (int m = 0; m < 4; ++m) { const int r = row0 + ai * HALF + m * 16; const float rs = SCALE_COL ? 1.0f : rstd[r]; bf16* rowp = O + (size_t)r * ldc + col0;
#pragma unroll
                for (int bj = 0; bj < 2; ++bj) { f32x4 v0 = acc[ai][bj][m][0] * cs[bj][0] * rs, v1 = acc[ai][bj][m][1] * cs[bj][1] * rs;
                    if (act) {
#pragma unroll
                        for (int j = 0; j < 4; ++j) { v0[j] = gelu_tanh(v0[j]); v1[j] = gelu_tanh(v1[j]); } }
                    u32x4 w; w.x = cvt_pk_bf16(v0[0], v0[1]); w.y = cvt_pk_bf16(v0[2], v0[3]); w.z = cvt_pk_bf16(v1[0], v1[1]); w.w = cvt_pk_bf16(v1[2], v1[3]);
                    *(u32x4*)(rowp + bj * HALF) = w; } }
    }
};
struct EpiRes {
    static constexpr bool PERM = false;
    const float* base; float* out; int ldc;
    __device__ __forceinline__ void operator()(const f32x4 (&acc)[2][2][4][2], const Unit& u, int wr, int wc, int fr, int fq) const {
        const int row0 = u.pm * BM + wr * 64 + fr, col0 = u.pn * BM + wc * 32 + 4 * fq;
#pragma unroll
        for (int ai = 0; ai < 2; ++ai)
#pragma unroll
            for (int m = 0; m < 4; ++m) { const size_t off = (size_t)(row0 + ai * HALF + m * 16) * ldc + col0;
#pragma unroll
                for (int bj = 0; bj < 2; ++bj)
#pragma unroll
                    for (int n = 0; n < 2; ++n) { const f32x4 b = *(const f32x4*)(base + off + bj * HALF + n * 16); *(f32x4*)(out + off + bj * HALF + n * 16) = b + acc[ai][bj][m][n]; } }
    }
};
struct EpiG1 {
    static constexpr bool PERM = true;
    bf16* HID; const float* rstd;
    __device__ __forceinline__ void operator()(const f32x4 (&acc)[2][2][4][2], const Unit& u, int wr, int wc, int fr, int fq) const {
        const int col0 = u.pn * HALF + wc * 32 + 8 * fq;
#pragma unroll
        for (int ai = 0; ai < 2; ++ai)
#pragma unroll
            for (int m = 0; m < 4; ++m) { const int rl = ai * HALF + wr * 64 + m * 16 + fr;
                if (rl < u.nvalid) { const unsigned ent = u.list[rl]; const unsigned tok = ent & 0x7fffffffu, half = ent >> 31; const float gt = u.glist[rl], rs = rstd[tok];
                    float o[8];
#pragma unroll
                    for (int n = 0; n < 2; ++n)
#pragma unroll
                        for (int j = 0; j < 4; ++j) { const float g = acc[ai][0][m][n][j] * rs, up = acc[ai][1][m][n][j] * rs; o[4 * n + j] = g * sigmoidf_(g) * up * gt; }
                    u32x4 w; w.x = cvt_pk_bf16(o[0], o[1]); w.y = cvt_pk_bf16(o[2], o[3]); w.z = cvt_pk_bf16(o[4], o[5]); w.w = cvt_pk_bf16(o[6], o[7]);
                    *(u32x4*)(HID + (size_t)tok * 1024 + half * 512 + col0) = w; } }
    }
};
struct EpiG2 {
    static constexpr bool PERM = false;
    float* out;
    __device__ __forceinline__ void operator()(const f32x4 (&acc)[2][2][4][2], const Unit& u, int wr, int wc, int fr, int fq) const {
        const int col0 = u.pn * BM + wc * 32 + 4 * fq;
#pragma unroll
        for (int ai = 0; ai < 2; ++ai)
#pragma unroll
            for (int m = 0; m < 4; ++m) { const int rl = ai * HALF + wr * 64 + m * 16 + fr;
                if (rl < u.nvalid) { const unsigned tok = u.list[rl] & 0x7fffffffu; float* p = out + (size_t)tok * 1024 + col0;
#pragma unroll
                    for (int bj = 0; bj < 2; ++bj)
#pragma unroll
                        for (int n = 0; n < 2; ++n) { const f32x4 b = *(const f32x4*)(p + bj * HALF + n * 16); *(f32x4*)(p + bj * HALF + n * 16) = b + acc[ai][bj][m][n]; } } }
    }
};
}

#define XB_TMO      128
#define XB_XCNT(j)  (256  + 64 * (j))
#define XB_XSUB(j)  (1280 + 64 * (j))
#define XB_XGEN(j)  (2304 + 64 * (j))
#define XB_TOP      3328
#define XB_TOPGEN   3392
#define XCD_BAR_WORDS 3456
#define XB_SPIN_CAP (1u << 18)
__device__ __forceinline__ unsigned xb_ld(unsigned* p)              { return __hip_atomic_load(p, __ATOMIC_RELAXED, __HIP_MEMORY_SCOPE_AGENT); }
__device__ __forceinline__ unsigned xb_add(unsigned* p, unsigned v) { return __hip_atomic_fetch_add(p, v, __ATOMIC_RELAXED, __HIP_MEMORY_SCOPE_AGENT); }
__device__ __forceinline__ unsigned xb_xcc_id() { return (unsigned)__builtin_amdgcn_s_getreg((3 << 11) | 20) & 0xFu; }
#define XB_SPIN(cond, bar) do { unsigned _sp = 0; while (cond) { __builtin_amdgcn_s_sleep(1); \
    if ((++_sp & 255u) == 0u) { if (xb_ld(&(bar)[XB_TMO])) break; if (_sp > XB_SPIN_CAP) { atomicAdd(&(bar)[XB_TMO], 1u); break; } } } } while (0)
struct XcdBarrier { unsigned* bar; unsigned x; volatile LAS unsigned* st; };
__device__ __forceinline__ XcdBarrier xcd_barrier_post(unsigned* bar, volatile LAS unsigned* st) {
    XcdBarrier b; b.bar = bar; b.x = xb_xcc_id(); b.st = st;
    if (threadIdx.x == 0) (void)xb_add(&bar[XB_XCNT(b.x)], 1u);
    return b;
}
__device__ __forceinline__ void xcd_barrier_complete(unsigned* bar, unsigned x, unsigned& nloc, unsigned& nx) {
    const unsigned G = gridDim.x * gridDim.y * gridDim.z;
    unsigned sum, cnt, mine, sp = 0u;
    for (;;) {
        sum = 0u; cnt = 0u; mine = 0u;
#pragma unroll
        for (unsigned j = 0; j < 16; ++j) { const unsigned c = xb_ld(&bar[XB_XCNT(j)]); sum += c; cnt += (c > 0u) ? 1u : 0u; mine = (j == x) ? c : mine; }
        if (sum == G) break;
        __builtin_amdgcn_s_sleep(1);
        if ((++sp & 255u) == 0u) { if (xb_ld(&bar[XB_TMO])) break; if (sp > XB_SPIN_CAP) { atomicAdd(&bar[XB_TMO], 1u); break; } }
    }
    nloc = mine > 0u ? mine : 1u; nx = cnt > 0u ? cnt : 1u;
}
__device__ __forceinline__ void xcd_barrier(const XcdBarrier& b) {
    asm volatile("s_waitcnt vmcnt(0)" ::: "memory");
    __syncthreads();
    if (threadIdx.x == 0) {
        unsigned* bar = b.bar;
        __builtin_amdgcn_s_waitcnt(0);
        unsigned nloc = b.st[0], nx = b.st[1];
        if (nloc == 0u) { xcd_barrier_complete(bar, b.x, nloc, nx); b.st[0] = nloc; b.st[1] = nx; }
        const unsigned old = xb_add(&bar[XB_XSUB(b.x)], 1u);
        const unsigned gen = old / nloc;
        if (old + 1u == (gen + 1u) * nloc) {
            __builtin_amdgcn_fence(__ATOMIC_RELEASE, "agent");
            asm volatile("s_waitcnt vmcnt(0)" ::: "memory");
            const unsigned og = xb_add(&bar[XB_TOP], 1u);
            const unsigned tg = og / nx;
            if (og + 1u == (tg + 1u) * nx) xb_add(&bar[XB_TOPGEN], 1u);
            else XB_SPIN(xb_ld(&bar[XB_TOPGEN]) == tg, bar);
            __builtin_amdgcn_fence(__ATOMIC_ACQUIRE, "agent");
            xb_add(&bar[XB_XGEN(b.x)], 1u);
            asm volatile("s_waitcnt vmcnt(0)" ::: "memory");
        } else {
            XB_SPIN(xb_ld(&bar[XB_XGEN(b.x)]) == gen, bar);
            __builtin_amdgcn_fence(__ATOMIC_ACQUIRE, "agent");
            asm volatile("s_waitcnt vmcnt(0)" ::: "memory");
        }
    }
    __syncthreads();
}

__device__ __forceinline__ void tr_item(const float* W, int ldw, int k0, int n0, bf16* WT, int ldt, int rd0, LAS float* scr, int lane) {
#pragma unroll 8
    for (int i = 0; i < 32; ++i) { const int kk = 2 * i + (lane >> 5); scr[kk * 33 + (lane & 31)] = W[(size_t)(k0 + kk) * ldw + n0 + (lane & 31)]; }
    LDS_WAIT(); asm volatile("" ::: "memory");
    const int c = lane & 7;
#pragma unroll
    for (int j = 0; j < 4; ++j) { const int n = (lane >> 3) + 8 * j; const LAS float* s = scr + (8 * c) * 33 + n;
        u32x4 o; o.x = cvt_pk_bf16(s[0 * 33], s[1 * 33]); o.y = cvt_pk_bf16(s[2 * 33], s[3 * 33]); o.z = cvt_pk_bf16(s[4 * 33], s[5 * 33]); o.w = cvt_pk_bf16(s[6 * 33], s[7 * 33]);
        *(u32x4*)(WT + (size_t)(rd0 + n) * ldt + k0 + 8 * c) = o; }
    LDS_WAIT(); asm volatile("" ::: "memory");
}
__device__ __forceinline__ void norm_row(const float* xrow, const float* g, bf16* hrow, float* rstd_out, int lane) {
    const f32x4* xr = (const f32x4*)xrow + lane; const f32x4* gr = (const f32x4*)g + lane;
    f32x4 v[4]; float s = 0.f;
#pragma unroll
    for (int j = 0; j < 4; ++j) { v[j] = xr[64 * j]; s += (v[j].x * v[j].x + v[j].y * v[j].y) + (v[j].z * v[j].z + v[j].w * v[j].w); }
    s = wave_sum(s);
    if (lane == 0) *rstd_out = 1.0f / sqrtf(s * (1.0f / D) + EPS);
    u32x2* o8 = (u32x2*)hrow + lane;
#pragma unroll
    for (int j = 0; j < 4; ++j) { const f32x4 gv = gr[64 * j]; u32x2 w; w.x = cvt_pk_bf16(v[j].x * gv.x, v[j].y * gv.y); w.y = cvt_pk_bf16(v[j].z * gv.z, v[j].w * gv.w); o8[64 * j] = w; }
}

struct Args { const float* in[26]; float* out; unsigned char* ws; int ph_lo, ph_hi, li, pad; };

__device__ __forceinline__ void p0_prologue(const Args& a, LAS unsigned char* lds, int G, int wave, int lane) {
    unsigned char* ws = a.ws;
    LAS float* scr = (LAS float*)(lds + wave * 16384);
    const int gw = blockIdx.x * 8 + wave, NGW = G * 8;
    constexpr int I_IN = 16 * 80, I_OUT = 16 * 32, I_CIN = 16 * 64, I_CO = 16 * 32, I_AX = 8 * 2 * 8, I_MOE = 64 * 768, I_RT = 2 * 16;
    constexpr int NITEMS = I_IN + I_OUT + I_CIN + I_CO + I_AX + I_MOE + I_RT;
    for (int it = gw; it < NITEMS; it += NGW) {
        int r = it;
        if (r < I_IN) { const int kb = r / 80, nb = r % 80, n0 = 32 * nb;
            if (n0 < 512) tr_item(a.in[4], 2560, 64 * kb, n0, (bf16*)(ws + WS_WREST), 1024, n0, scr, lane);
            else if (n0 < 1024) tr_item(a.in[4], 2560, 64 * kb, n0, (bf16*)(ws + WS_WV), 1024, n0 - 512, scr, lane);
            else tr_item(a.in[4], 2560, 64 * kb, n0, (bf16*)(ws + WS_WREST), 1024, n0 - 512, scr, lane);
            continue; } r -= I_IN;
        if (r < I_OUT) { tr_item(a.in[9], 1024, 64 * (r / 32), 32 * (r % 32), (bf16*)(ws + WS_WO), 1024, 32 * (r % 32), scr, lane); continue; } r -= I_OUT;
        if (r < I_CIN) { tr_item(a.in[10], 2048, 64 * (r / 64), 32 * (r % 64), (bf16*)(ws + WS_WC), 1024, 32 * (r % 64), scr, lane); continue; } r -= I_CIN;
        if (r < I_CO) { tr_item(a.in[18], 1024, 64 * (r / 32), 32 * (r % 32), (bf16*)(ws + WS_WCO), 1024, 32 * (r % 32), scr, lane); continue; } r -= I_CO;
        if (r < I_AX) { const int h = r / 16, gate = (r / 8) & 1, kb = (r / 4) & 1, nb = r & 3;
            tr_item((gate ? a.in[15] : a.in[13]) + (size_t)h * 16384, 128, 64 * kb, 32 * nb, (bf16*)(ws + WS_WAX) + (size_t)h * 256 * 128, 128, gate * 128 + 32 * nb, scr, lane); continue; } r -= I_AX;
        if (r < I_MOE) { const int le = r / 768, q = r % 768;
            if (q < 512) { const int up = q / 256, qq = q % 256, kb = qq / 16, nb = qq % 16, n0 = 32 * nb;
                tr_item((up ? a.in[24] : a.in[23]) + (size_t)le * 1024 * 512, 512, 64 * kb, n0, (bf16*)(ws + WS_WGU) + (size_t)le * 1024 * 1024, 1024, (n0 / 128) * 256 + up * 128 + (n0 % 128), scr, lane); }
            else { const int qq = q - 512, kb = qq / 32, nb = qq % 32;
                tr_item(a.in[25] + (size_t)le * 512 * 1024, 1024, 64 * kb, 32 * nb, (bf16*)(ws + WS_WD) + (size_t)le * 1024 * 512, 512, 32 * nb, scr, lane); }
            continue; } r -= I_MOE;
        { const int l = r / 16, kb = r % 16; tr_item(a.in[21] + (size_t)l * 1024 * 32, 32, 64 * kb, 0, (bf16*)(ws + WS_WRT) + (size_t)l * 48 * 1024, 1024, 0, scr, lane); }
    }
    const int gt = blockIdx.x * 512 + threadIdx.x, NGT = G * 512;
    for (int i = gt; i < 2 * 16 * 1024; i += NGT) {
        const int l = i / 16384, n = (i / 1024) & 15, k = i & 1023;
        const float v = n < 4 ? a.in[19][(size_t)l * 4096 + k * 4 + n] : 0.f;
        ((bf16*)(ws + WS_WRT))[(size_t)l * 48 * 1024 + (size_t)(32 + n) * 1024 + k] = (bf16)(cvt_pk_bf16(v, 0.f) & 0xffffu); }
    for (int i = gt; i < 4 * 128 * 128; i += NGT) {
        const int t = (i >> 7) & 127, s = i & 127; const float v = s <= t ? a.in[6][i] : 0.f;
        ((bf16*)(ws + WS_WSB))[i] = (bf16)(cvt_pk_bf16(v, 0.f) & 0xffffu); }
    for (int m = gw; m < M; m += NGW) norm_row(a.in[0] + (size_t)m * D, a.in[1], (bf16*)(ws + WS_H) + (size_t)m * D, (float*)(ws + WS_RSTD) + m, lane);
}
__device__ __forceinline__ void norm_phase(const float* x, const float* g, bf16* H, float* rstd, int G, int wave, int lane) {
    const int gw = blockIdx.x * 8 + wave, NGW = G * 8;
    for (int m = gw; m < M; m += NGW) norm_row(x + (size_t)m * D, g, H + (size_t)m * D, rstd + m, lane);
}
__device__ __forceinline__ void final_norm_phase(float* x, const float* g, int G, int wave, int lane) {
    const int gw = blockIdx.x * 8 + wave, NGW = G * 8;
    for (int m = gw; m < M; m += NGW) {
        f32x4* xr = (f32x4*)(x + (size_t)m * D) + lane; const f32x4* gr = (const f32x4*)g + lane;
        f32x4 v[4]; float s = 0.f;
#pragma unroll
        for (int j = 0; j < 4; ++j) { v[j] = xr[64 * j]; s += (v[j].x * v[j].x + v[j].y * v[j].y) + (v[j].z * v[j].z + v[j].w * v[j].w); }
        const float rs = 1.0f / sqrtf(wave_sum(s) * (1.0f / D) + EPS);
#pragma unroll
        for (int j = 0; j < 4; ++j) xr[64 * j] = v[j] * rs * gr[64 * j];
    }
}

__device__ __forceinline__ void p2_spatial(const Args& a, LAS unsigned char* lds, int G, int wave, int lane) {
    const bf16* ZR = (const bf16*)(a.ws + WS_Z); const bf16* VT = (const bf16*)(a.ws + WS_VT); bf16* Y = (bf16*)(a.ws + WS_Y); const bf16* WSB = (const bf16*)(a.ws + WS_WSB);
    LAS unsigned char* T = lds;
    LAS float* MU = (LAS float*)(lds + 131072); LAS float* RS = MU + 128; LAS float* PART = (LAS float*)(lds + 131072 + 1024);
    const int tid = threadIdx.x, fr = lane & 15, fq = lane >> 4;
    for (int unit = blockIdx.x; unit < M / 128; unit += G) {
        const size_t row0 = (size_t)unit * 128;
        {
            const int cg = tid & 63, rg = tid >> 6, c0 = 8 * cg; const size_t R = row0 + 16 * rg;
            float w0[8], w1[8], w2[8], p2v[8], p1v[8];
#pragma unroll
            for (int j = 0; j < 8; ++j) { w0[j] = a.in[8][c0 + j]; w1[j] = a.in[8][512 + c0 + j]; w2[j] = a.in[8][1024 + c0 + j]; p2v[j] = 0.f; p1v[j] = 0.f; }
            if ((R & (SEQ - 1)) != 0) {
                const u32x4 gc2 = *(const u32x4*)(ZR + (R - 2) * 2048 + 1024 + c0), xb2 = *(const u32x4*)(ZR + (R - 2) * 2048 + 1536 + c0);
                const u32x4 gc1 = *(const u32x4*)(ZR + (R - 1) * 2048 + 1024 + c0), xb1 = *(const u32x4*)(ZR + (R - 1) * 2048 + 1536 + c0);
#pragma unroll
                for (int j = 0; j < 4; ++j) { p2v[2 * j] = bflo(gc2[j]) * bflo(xb2[j]); p2v[2 * j + 1] = bfhi(gc2[j]) * bfhi(xb2[j]); p1v[2 * j] = bflo(gc1[j]) * bflo(xb1[j]); p1v[2 * j + 1] = bfhi(gc1[j]) * bfhi(xb1[j]); }
            }
#pragma unroll 4
            for (int r = 0; r < 16; ++r) { const bf16* zr = ZR + (R + r) * 2048 + c0;
                const u32x4 gb = *(const u32x4*)(zr + 512), gc = *(const u32x4*)(zr + 1024), xb = *(const u32x4*)(zr + 1536);
                float cx[8], y[8];
#pragma unroll
                for (int j = 0; j < 4; ++j) { cx[2 * j] = bflo(gc[j]) * bflo(xb[j]); cx[2 * j + 1] = bfhi(gc[j]) * bfhi(xb[j]); }
#pragma unroll
                for (int j = 0; j < 8; ++j) { const float gbj = (j & 1) ? bfhi(gb[j >> 1]) : bflo(gb[j >> 1]); y[j] = gbj * (w0[j] * p2v[j] + w1[j] * p1v[j] + w2[j] * cx[j]); p2v[j] = p1v[j]; p1v[j] = cx[j]; }
                u32x4 o; o.x = cvt_pk_bf16(y[0], y[1]); o.y = cvt_pk_bf16(y[2], y[3]); o.z = cvt_pk_bf16(y[4], y[5]); o.w = cvt_pk_bf16(y[6], y[7]);
                *(u32x4*)(Y + (R + r) * 1024 + 512 + c0) = o; }
        }
#pragma unroll 4
        for (int p = 0; p < 16; ++p) { const int row = p * 32 + (tid >> 4), ch = tid & 15;
            const u32x4 v = *(const u32x4*)(VT + (size_t)row * M + row0 + ch * 8);
            *(LAS u32x4*)(T + row * 256 + ((ch ^ (row & 15)) << 4)) = v; }
        __syncthreads();
        const int sg = tid & 15, dg = tid >> 4;
        {   float s[8], q[8];
#pragma unroll
            for (int j = 0; j < 8; ++j) { s[j] = 0.f; q[j] = 0.f; }
#pragma unroll 4
            for (int rr = 0; rr < 16; ++rr) { const u32x4 v = *(const LAS u32x4*)(T + (16 * dg + rr) * 256 + ((sg ^ rr) << 4));
#pragma unroll
                for (int j = 0; j < 4; ++j) { const float lo = bflo(v[j]), hi = bfhi(v[j]); s[2 * j] += lo; q[2 * j] += lo * lo; s[2 * j + 1] += hi; q[2 * j + 1] += hi * hi; } }
#pragma unroll
            for (int j = 0; j < 8; ++j) { s[j] += __shfl_xor(s[j], 16); s[j] += __shfl_xor(s[j], 32); q[j] += __shfl_xor(q[j], 16); q[j] += __shfl_xor(q[j], 32); }
            if (lane < 16) {
#pragma unroll
                for (int j = 0; j < 8; ++j) { PART[(wave * 128 + 8 * sg + j) * 2] = s[j]; PART[(wave * 128 + 8 * sg + j) * 2 + 1] = q[j]; } }
        }
        __syncthreads();
        if (tid < 128) { float s = 0.f, q = 0.f;
#pragma unroll
            for (int w = 0; w < 8; ++w) { s += PART[(w * 128 + tid) * 2]; q += PART[(w * 128 + tid) * 2 + 1]; }
            const float mean = s * (1.0f / 512.0f); float var = q * (1.0f / 512.0f) - mean * mean; var = var > 0.f ? var : 0.f;
            MU[tid] = mean; RS[tid] = 1.0f / sqrtf(var + EPS); }
        __syncthreads();
        {   float mu8[8], rs8[8];
#pragma unroll
            for (int j = 0; j < 8; ++j) { mu8[j] = MU[8 * sg + j]; rs8[j] = RS[8 * sg + j]; }
#pragma unroll 4
            for (int rr = 0; rr < 16; ++rr) { const int row = 16 * dg + rr; const float gd = a.in[5][row]; LAS u32x4* pp = (LAS u32x4*)(T + row * 256 + ((sg ^ rr) << 4)); const u32x4 v = *pp; u32x4 o;
#pragma unroll
                for (int j = 0; j < 4; ++j) o[j] = cvt_pk_bf16((bflo(v[j]) - mu8[2 * j]) * rs8[2 * j] * gd, (bfhi(v[j]) - mu8[2 * j + 1]) * rs8[2 * j + 1] * gd);
                *pp = o; }
        }
        __syncthreads();
        {   const int hh = wave >> 1, rh = wave & 1;
#pragma unroll 1
            for (int nh = 0; nh < 2; ++nh) {
                f32x4 acc[4][4];
#pragma unroll
                for (int m = 0; m < 4; ++m)
#pragma unroll
                    for (int n = 0; n < 4; ++n) acc[m][n] = (f32x4){0.f, 0.f, 0.f, 0.f};
#pragma unroll
                for (int ks = 0; ks < 4; ++ks) { bf16x8 Af[4];
#pragma unroll
                    for (int m = 0; m < 4; ++m) Af[m] = *(const bf16x8*)(WSB + (size_t)((hh * 128 + 64 * rh + 16 * m + fr) * 128 + 32 * ks + 8 * fq));
#pragma unroll
                    for (int n = 0; n < 4; ++n) { const bf16x8 Bf = *(const LAS bf16x8*)(T + (hh * 128 + 64 * nh + 16 * n + fr) * 256 + (((4 * ks + fq) ^ fr) << 4));
#pragma unroll
                        for (int m = 0; m < 4; ++m) acc[m][n] = __builtin_amdgcn_mfma_f32_16x16x32_bf16(Bf, Af[m], acc[m][n], 0, 0, 0); } }
#pragma unroll
                for (int m = 0; m < 4; ++m) { const int t = 64 * rh + 16 * m + fr; const size_t R = row0 + t; const float bias = a.in[7][hh * 128 + t];
#pragma unroll
                    for (int n = 0; n < 4; ++n) { const int d = hh * 128 + 64 * nh + 16 * n + 4 * fq; const u32x2 u4 = *(const u32x2*)(ZR + R * 2048 + d);
                        u32x2 o; o.x = cvt_pk_bf16(bflo(u4.x) * (acc[m][n][0] + bias), bfhi(u4.x) * (acc[m][n][1] + bias)); o.y = cvt_pk_bf16(bflo(u4.y) * (acc[m][n][2] + bias), bfhi(u4.y) * (acc[m][n][3] + bias));
                        *(u32x2*)(Y + R * 1024 + d) = o; } }
            }
        }
        __syncthreads();
    }
}

__device__ __forceinline__ void route_phase(const Args& a, int l, LAS unsigned char* lds, int G, int wave, int lane) {
    const float* X = a.out; bf16* H = (bf16*)(a.ws + WS_H); float* RSTD = (float*)(a.ws + WS_RSTD);
    const bf16* WRT = (const bf16*)(a.ws + WS_WRT) + (size_t)l * 48 * 1024; const float* gvec = a.in[2] + l * 1024;
    const float* brg = a.in[20] + l * 4; const float* bre = a.in[22] + l * 32;
    unsigned* ECNT = (unsigned*)(a.ws + WS_CTL) + CW_ECNT + l * 2048; unsigned* PCNT = (unsigned*)(a.ws + WS_CTL) + CW_PCNT + l * 7168;
    unsigned* ELT = (unsigned*)(a.ws + WS_ELT); float* ELG = (float*)(a.ws + WS_ELG); unsigned* PLT = (unsigned*)(a.ws + WS_PLT);
    constexpr int WROW = 2064;
    LAS unsigned char* WL = lds; LAS float* GL = (LAS float*)(lds + 99072); LAS float* SCR = (LAS float*)(lds + 103168) + wave * 768;
    LAS int* TOK = (LAS int*)(lds + 127744);
    LAS int* HIST = (LAS int*)(lds + 135936);
    const int tid = threadIdx.x, fr = lane & 15, fq = lane >> 4;
    for (int tile = blockIdx.x; tile < M / 256; tile += G) {
        __syncthreads();
        for (int i = tid; i < 48 * 128; i += 512) { const int row = i >> 7, ch = i & 127; *(LAS u32x4*)(WL + row * WROW + ch * 16) = *(const u32x4*)(WRT + (size_t)row * 1024 + ch * 8); }
        if (tid < 256) *(LAS f32x4*)(GL + 4 * tid) = *(const f32x4*)(gvec + 4 * tid);
        if (tid < 288) HIST[tid] = 0;
        __syncthreads();
        for (int mt = 2 * wave; mt < 2 * wave + 2; ++mt) {
            const size_t row = (size_t)tile * 256 + 16 * mt + fr; const float* xr = X + row * D; bf16* hr = H + row * D;
            f32x4 acc[3]; acc[0] = acc[1] = acc[2] = (f32x4){0.f, 0.f, 0.f, 0.f}; float ss = 0.f;
#pragma unroll 4
            for (int ks = 0; ks < 32; ++ks) { const int k0 = 32 * ks + 8 * fq;
                const f32x4 x0 = *(const f32x4*)(xr + k0), x1 = *(const f32x4*)(xr + k0 + 4); const f32x4 g0 = *(const LAS f32x4*)(GL + k0), g1 = *(const LAS f32x4*)(GL + k0 + 4);
                ss += (x0.x * x0.x + x0.y * x0.y) + (x0.z * x0.z + x0.w * x0.w) + (x1.x * x1.x + x1.y * x1.y) + (x1.z * x1.z + x1.w * x1.w);
                u32x4 hw; hw.x = cvt_pk_bf16(x0.x * g0.x, x0.y * g0.y); hw.y = cvt_pk_bf16(x0.z * g0.z, x0.w * g0.w); hw.z = cvt_pk_bf16(x1.x * g1.x, x1.y * g1.y); hw.w = cvt_pk_bf16(x1.z * g1.z, x1.w * g1.w);
                *(u32x4*)(hr + k0) = hw; const bf16x8 Af = __builtin_bit_cast(bf16x8, hw);
#pragma unroll
                for (int n = 0; n < 3; ++n) { const bf16x8 Bf = *(const LAS bf16x8*)(WL + (16 * n + fr) * WROW + k0 * 2); acc[n] = __builtin_amdgcn_mfma_f32_16x16x32_bf16(Bf, Af, acc[n], 0, 0, 0); } }
            ss += __shfl_xor(ss, 16); ss += __shfl_xor(ss, 32);
            const float rstd = 1.0f / sqrtf(ss * (1.0f / D) + EPS);
            if (fq == 0) RSTD[row] = rstd;
#pragma unroll
            for (int n = 0; n < 3; ++n)
#pragma unroll
                for (int j = 0; j < 4; ++j) SCR[fr * 48 + 16 * n + 4 * fq + j] = acc[n][j] * rstd;
            LDS_WAIT(); asm volatile("" ::: "memory");
            if (lane < 16) { const LAS float* lg = SCR + lane * 48;
                float gl[4]; int gi = 0; float gm;
#pragma unroll
                for (int j = 0; j < 4; ++j) gl[j] = lg[32 + j] + brg[j];
                gm = gl[0];
#pragma unroll
                for (int j = 1; j < 4; ++j) if (gl[j] > gm) { gm = gl[j]; gi = j; }
                float den = 0.f;
#pragma unroll
                for (int j = 0; j < 4; ++j) den += __expf(gl[j] - gm);
                const float gp = 1.0f / den;
                float el[8];
#pragma unroll
                for (int j = 0; j < 8; ++j) el[j] = lg[8 * gi + j] + bre[8 * gi + j];
                int i1 = 0; float v1 = el[0];
#pragma unroll
                for (int j = 1; j < 8; ++j) if (el[j] > v1) { v1 = el[j]; i1 = j; }
                int i2 = -1; float v2 = -3.0e38f;
#pragma unroll
                for (int j = 0; j < 8; ++j) if (j != i1 && el[j] > v2) { v2 = el[j]; i2 = j; }
                const float e21 = __expf(v2 - v1), p1 = 1.0f / (1.0f + e21), p2 = e21 * p1;
                const int e1 = 8 * gi + i1, e2 = 8 * gi + i2; const int lo = i1 < i2 ? i1 : i2, hi = i1 < i2 ? i2 : i1;
                const int p = gi * 28 + (lo * (15 - lo)) / 2 + (hi - lo - 1);
                LAS int* tk = TOK + (16 * mt + lane) * 8;
                tk[0] = e1; tk[1] = e2; tk[2] = __float_as_int(gp * p1); tk[3] = __float_as_int(gp * p2);
                tk[4] = __hip_atomic_fetch_add(HIST + e1, 1, __ATOMIC_RELAXED, __HIP_MEMORY_SCOPE_WORKGROUP); tk[5] = __hip_atomic_fetch_add(HIST + e2, 1, __ATOMIC_RELAXED, __HIP_MEMORY_SCOPE_WORKGROUP); tk[6] = __hip_atomic_fetch_add(HIST + 32 + p, 1, __ATOMIC_RELAXED, __HIP_MEMORY_SCOPE_WORKGROUP); tk[7] = p; }
            LDS_WAIT(); asm volatile("" ::: "memory");
        }
        __syncthreads();
        if (tid < 32) { const int c = HIST[tid]; HIST[144 + tid] = c ? (int)__hip_atomic_fetch_add(ECNT + 64 * tid, (unsigned)c, __ATOMIC_RELAXED, __HIP_MEMORY_SCOPE_AGENT) : 0; }
        else if (tid < 144) { const int j = tid - 32; const int c = HIST[32 + j]; HIST[176 + j] = c ? (int)__hip_atomic_fetch_add(PCNT + 64 * j, (unsigned)c, __ATOMIC_RELAXED, __HIP_MEMORY_SCOPE_AGENT) : 0; }
        __syncthreads();
        if (tid < 256) { const LAS int* tk = TOK + tid * 8; const unsigned tok = (unsigned)(tile * 256 + tid);
            const int e1 = tk[0], e2 = tk[1]; const unsigned h1 = e1 < e2 ? 0u : 1u;
            const size_t s1 = (size_t)e1 * 65536 + HIST[144 + e1] + tk[4], s2 = (size_t)e2 * 65536 + HIST[144 + e2] + tk[5];
            ELT[s1] = tok | (h1 << 31); ELG[s1] = __int_as_float(tk[2]); ELT[s2] = tok | ((1u - h1) << 31); ELG[s2] = __int_as_float(tk[3]);
            PLT[(size_t)tk[7] * 65536 + HIST[176 + tk[7]] + tk[6]] = tok; }
    }
}
__device__ __forceinline__ void build_tables(LAS unsigned char* lds, unsigned* counters, int ng) {
    LAS int* pref = (LAS int*)(lds + TAB_OFF); LAS int* cnt = pref + 130;
    __syncthreads();
    if ((int)threadIdx.x < ng) cnt[threadIdx.x] = (int)__hip_atomic_load(counters + 64 * threadIdx.x, __ATOMIC_RELAXED, __HIP_MEMORY_SCOPE_AGENT);
    __syncthreads();
    if (threadIdx.x == 0) { int s = 0; for (int g = 0; g < ng; ++g) { pref[g] = s; s += (cnt[g] + 255) >> 8; } for (int g = ng; g < 130; ++g) pref[g] = s; }
    __syncthreads();
}

template <bool PASS2> __device__ __forceinline__ void scan_phase(const Args& a, LAS unsigned char* lds, int G, int wave, int lane) {
    const bf16* ZC = (const bf16*)(a.ws + WS_Z); bf16* Y = (bf16*)(a.ws + WS_Y); const bf16* WAX = (const bf16*)(a.ws + WS_WAX); float* CAR = (float*)(a.ws + WS_CAR);
    LAS unsigned char* RAW = lds;
    LAS unsigned char* AT = lds + 34816;
    const int tid = threadIdx.x, fr = lane & 15, fq = lane >> 4;
    for (int unit = blockIdx.x; unit < 1024; unit += G) {
        const int hd = unit & 7, blk = (unit >> 3) & 15, b = unit >> 7;
        const size_t Rbase = (size_t)b * SEQ + blk * 512;
        const int ch = 128 * hd + 16 * wave + fr;
        bf16x8 Br[4], Bi[4];
#pragma unroll
        for (int ks = 0; ks < 4; ++ks) { Br[ks] = *(const bf16x8*)(WAX + (size_t)((hd * 256 + 16 * wave + fr) * 128 + 32 * ks + 8 * fq)); Bi[ks] = *(const bf16x8*)(WAX + (size_t)((hd * 256 + 128 + 16 * wave + fr) * 128 + 32 * ks + 8 * fq)); }
        const float ba = a.in[14][ch], bx = a.in[16][ch];
        const float kl = -8.0f * 1.44269504f * log1pf(__expf(-a.in[17][ch]));
        const int cc = tid & 15, rq = tid >> 4;
        float cw[4][8], cb[8];
#pragma unroll
        for (int j = 0; j < 8; ++j) { const int c = 128 * hd + 8 * cc + j; cb[j] = a.in[12][c];
#pragma unroll
            for (int k = 0; k < 4; ++k) cw[k][j] = a.in[11][k * 1024 + c]; }
        float Hs = 0.f, Pa = 1.f;
        if (PASS2) { for (int j = 0; j < blk; ++j) { const f32x2 ab = *(const f32x2*)(CAR + ((size_t)(b * 16 + j) * 1024 + ch) * 2); Hs = ab.x * Hs + ab.y; } }
        for (int sb = 0; sb < 4; ++sb) {
            const size_t R0 = Rbase + 128 * sb;
            __syncthreads();
            for (int p = 0; p < 5; ++p) { const int rr = p * 32 + (tid >> 4);
                if (rr < 131) { const int pos = blk * 512 + 128 * sb - 3 + rr; u32x4 v = (u32x4){0u, 0u, 0u, 0u};
                    if (pos >= 0) v = *(const u32x4*)(ZC + (R0 + rr - 3) * 2048 + 1024 + 128 * hd + 8 * cc);
                    *(LAS u32x4*)(RAW + rr * 256 + cc * 16) = v; } }
            __syncthreads();
            {
                float xw[7][8];
#pragma unroll
                for (int i = 0; i < 7; ++i) { const u32x4 v = *(const LAS u32x4*)(RAW + (4 * rq + i) * 256 + cc * 16);
#pragma unroll
                    for (int j = 0; j < 4; ++j) { xw[i][2 * j] = bflo(v[j]); xw[i][2 * j + 1] = bfhi(v[j]); } }
#pragma unroll
                for (int i = 0; i < 4; ++i) { const int t = 4 * rq + i; float o[8];
#pragma unroll
                    for (int j = 0; j < 8; ++j) o[j] = cb[j] + cw[0][j] * xw[i][j] + cw[1][j] * xw[i + 1][j] + cw[2][j] * xw[i + 2][j] + cw[3][j] * xw[i + 3][j];
                    u32x4 w; w.x = cvt_pk_bf16(o[0], o[1]); w.y = cvt_pk_bf16(o[2], o[3]); w.z = cvt_pk_bf16(o[4], o[5]); w.w = cvt_pk_bf16(o[6], o[7]);
                    *(LAS u32x4*)(AT + t * 256 + ((cc ^ (t & 15)) << 4)) = w; }
            }
            __syncthreads();
            f32x4 ar[8], ai[8];
#pragma unroll
            for (int m = 0; m < 8; ++m) { ar[m] = (f32x4){0.f, 0.f, 0.f, 0.f}; ai[m] = (f32x4){0.f, 0.f, 0.f, 0.f};
#pragma unroll
                for (int ks = 0; ks < 4; ++ks) { const bf16x8 Af = *(const LAS bf16x8*)(AT + (16 * m + fr) * 256 + (((4 * ks + fq) ^ fr) << 4));
                    ar[m] = __builtin_amdgcn_mfma_f32_16x16x32_bf16(Af, Br[ks], ar[m], 0, 0, 0); ai[m] = __builtin_amdgcn_mfma_f32_16x16x32_bf16(Af, Bi[ks], ai[m], 0, 0, 0); } }
#pragma unroll
            for (int m = 0; m < 8; ++m) {
                float a4[4], b4[4];
#pragma unroll
                for (int i = 0; i < 4; ++i) { const int t = 16 * m + 4 * fq + i;
                    const float xr = bf1(*(const LAS unsigned short*)(AT + t * 256 + (((2 * wave + (fr >> 3)) ^ (t & 15)) << 4) + (fr & 7) * 2));
                    const float r = sigmoidf_(ar[m][i] + ba), ig = sigmoidf_(ai[m][i] + bx);
                    const float av = __builtin_amdgcn_exp2f(r * kl); float om = 1.0f - av * av; om = om > 0.f ? om : 0.f;
                    a4[i] = av; b4[i] = sqrtf(om) * ig * xr; }
                const float As = (a4[0] * a4[1]) * (a4[2] * a4[3]), Bs = ((b4[0] * a4[1] + b4[1]) * a4[2] + b4[2]) * a4[3] + b4[3];
                float A1 = As, B1 = Bs;
                { const float Ap = __shfl_up(As, 16), Bp = __shfl_up(Bs, 16); if (fq >= 1) { A1 = Ap * As; B1 = As * Bp + Bs; } }
                float A2 = A1, B2 = B1;
                { const float Ap = __shfl_up(A1, 32), Bp = __shfl_up(B1, 32); if (fq >= 2) { A2 = Ap * A1; B2 = A1 * Bp + B1; } }
                if (PASS2) {
                    float Ae = __shfl_up(A2, 16), Be = __shfl_up(B2, 16); if (fq == 0) { Ae = 1.f; Be = 0.f; }
                    float h = Ae * Hs + Be;
#pragma unroll
                    for (int i = 0; i < 4; ++i) { const int t = 16 * m + 4 * fq + i; h = a4[i] * h + b4[i];
                        const float gate = bf1(ZC[(R0 + t) * 2048 + ch]);
                        Y[(R0 + t) * 1024 + ch] = (bf16)(cvt_pk_bf16(gate * h, 0.f) & 0xffffu); }
                }
                const float At_ = __shfl(A2, fr + 48), Bt_ = __shfl(B2, fr + 48);
                Hs = At_ * Hs + Bt_; Pa *= At_;
            }
        }
        if (!PASS2 && fq == 0) *(f32x2*)(CAR + ((size_t)(b * 16 + blk) * 1024 + ch) * 2) = (f32x2){Pa, Hs};
    }
}

__global__ void __launch_bounds__(512, 2) fwd(Args args) {
    extern __shared__ __attribute__((aligned(16))) unsigned char lds_raw[];
    LAS unsigned char* lds = (LAS unsigned char*)lds_raw;
    volatile LAS unsigned* MISC = (volatile LAS unsigned*)(lds + MISC_OFF);
    const int tid = threadIdx.x, lane = tid & 63, wave = __builtin_amdgcn_readfirstlane(tid >> 6), G = gridDim.x;
    const int vcu = (G % 8 == 0) ? (int)(blockIdx.x % 8) * (G / 8) + (int)(blockIdx.x / 8) : (int)blockIdx.x;
    unsigned char* ws = args.ws;
    if (tid < 64) MISC[tid] = 0u;
    __syncthreads();
    XcdBarrier bar = xcd_barrier_post((unsigned*)(ws + WS_CTL) + CW_BAR + args.li * XCD_BAR_WORDS, MISC + 8);
    const int lo = args.ph_lo, hi = args.ph_hi;
#define IN(k) (ph_on(k) && lo <= (k) && (k) < hi)
#define SEAM(k) do { if (IN(k) && hi > (k) + 1) xcd_barrier(bar); } while (0)
    bf16* H = (bf16*)(ws + WS_H); float* RSTD = (float*)(ws + WS_RSTD); bf16* Z = (bf16*)(ws + WS_Z); bf16* Yb = (bf16*)(ws + WS_Y);

    if (IN(0)) p0_prologue(args, lds, G, wave, lane);
    SEAM(0);
    if (IN(1)) {
        { pg8::DenseOrder S; S.init(M, 2048, G, (int)blockIdx.x, H, 1024, ws + WS_WREST, 1024, 16);
          pg8::EpiZ<false> E{Z, 2048, RSTD, 2}; pg8::gemm_phase<pg8::EpiZ<false>, pg8::DenseOrder, false>(lds, 1024, 1024, 1024, 16, S, E); }
        { pg8::DenseOrder S; S.init(512, M, G, (int)blockIdx.x, ws + WS_WV, 1024, H, 1024, 16);
          pg8::EpiZ<true> E{(bf16*)(ws + WS_VT), M, RSTD, 1 << 30}; pg8::gemm_phase<pg8::EpiZ<true>, pg8::DenseOrder, false>(lds, 1024, 1024, 1024, 16, S, E); }
    }
    SEAM(1);
    if (IN(2)) p2_spatial(args, lds, G, wave, lane);
    SEAM(2);
    if (IN(3)) { pg8::DenseOrder S; S.init(M, 1024, G, (int)blockIdx.x, Yb, 1024, ws + WS_WO, 1024, 16);
        pg8::EpiRes E{args.in[0], args.out, 1024}; pg8::gemm_phase<pg8::EpiRes, pg8::DenseOrder, false>(lds, 1024, 1024, 1024, 16, S, E); }
    SEAM(3);
#define MOE_LAYER(l, pb) do { \
        if (IN(pb)) route_phase(args, l, lds, G, wave, lane); \
        SEAM(pb); \
        if (IN((pb) + 1)) { \
            build_tables(lds, (unsigned*)(ws + WS_CTL) + CW_ECNT + (l) * 2048, NE); \
            pg8::GroupOrder<false> S; S.pref = (const LAS int*)(lds + TAB_OFF); S.ng = NE; S.G = G; S.c = vcu; S.lane = lane; \
            S.A = (const char*)H; S.W = (const char*)(ws + WS_WGU) + (size_t)(l) * 32 * 1024 * 1024 * 2; S.lists = (const unsigned*)(ws + WS_ELT); S.glists = (const float*)(ws + WS_ELG); \
            pg8::EpiG1 E{Z, RSTD}; pg8::gemm_phase<pg8::EpiG1, pg8::GroupOrder<false>, true>(lds, 1024, 1024, 1024, 16, S, E); \
        } \
        SEAM((pb) + 1); \
        if (IN((pb) + 2)) { \
            build_tables(lds, (unsigned*)(ws + WS_CTL) + CW_PCNT + (l) * 7168, NPAIR); \
            pg8::GroupOrder<true> S; S.pref = (const LAS int*)(lds + TAB_OFF); S.ng = NPAIR; S.G = G; S.c = vcu; S.lane = lane; \
            S.A = (const char*)Z; S.W = (const char*)(ws + WS_WD) + (size_t)(l) * 32 * 1024 * 512 * 2; S.lists = (const unsigned*)(ws + WS_PLT); S.glists = nullptr; \
            pg8::EpiG2 E{args.out}; pg8::gemm_phase<pg8::EpiG2, pg8::GroupOrder<true>, true>(lds, 1024, 512, 1024, 8, S, E); \
        } \
        SEAM((pb) + 2); } while (0)
    MOE_LAYER(0, 4);
    if (IN(7)) norm_phase(args.out, args.in[1] + 1024, H, RSTD, G, wave, lane);
    SEAM(7);
    if (IN(8)) { pg8::DenseOrder S; S.init(M, 2048, G, (int)blockIdx.x, H, 1024, ws + WS_WC, 1024, 16);
        pg8::EpiZ<false> E{Z, 2048, RSTD, 4}; pg8::gemm_phase<pg8::EpiZ<false>, pg8::DenseOrder, false>(lds, 1024, 1024, 1024, 16, S, E); }
    SEAM(8);
    if (IN(9)) scan_phase<false>(args, lds, G, wave, lane);
    SEAM(9);
    if (IN(10)) scan_phase<true>(args, lds, G, wave, lane);
    SEAM(10);
    if (IN(11)) { pg8::DenseOrder S; S.init(M, 1024, G, (int)blockIdx.x, Yb, 1024, ws + WS_WCO, 1024, 16);
        pg8::EpiRes E{args.out, args.out, 1024}; pg8::gemm_phase<pg8::EpiRes, pg8::DenseOrder, false>(lds, 1024, 1024, 1024, 16, S, E); }
    SEAM(11);
    MOE_LAYER(1, 12);
#undef MOE_LAYER
    if (IN(15)) final_norm_phase(args.out, args.in[3], G, wave, lane);
#undef IN
#undef SEAM
}

extern "C" void kernel_launch(void* const* d_in, const int* in_sizes, int n_in, void* d_out, int out_size, void* d_ws, size_t ws_size, hipStream_t stream) {
    static int grid = 0;
    if (grid == 0) {
        if (n_in != 26 || in_sizes[0] != M * D || out_size != M * D || ws_size < WS_END) { fprintf(stderr, "kernel_launch: unexpected shapes (n_in %d, in0 %d, out %d, ws %zu < %zu); nothing launched\n", n_in, n_in > 0 ? in_sizes[0] : -1, out_size, ws_size, (size_t)WS_END); grid = -1; return; }
        int dev = 0, cus = 0, per_cu = 0;
        if (hipGetDevice(&dev) != hipSuccess || hipDeviceGetAttribute(&cus, hipDeviceAttributeMultiprocessorCount, dev) != hipSuccess) { grid = -1; return; }
        if (hipFuncSetAttribute((const void*)fwd, hipFuncAttributeMaxDynamicSharedMemorySize, LDS_BYTES) != hipSuccess) { fprintf(stderr, "kernel_launch: hipFuncSetAttribute failed\n"); grid = -1; return; }
        if (hipOccupancyMaxActiveBlocksPerMultiprocessor(&per_cu, (const void*)fwd, 512, LDS_BYTES) != hipSuccess || per_cu < 1) fprintf(stderr, "kernel_launch: occupancy query reports %d workgroups per CU\n", per_cu);
        (void)hipGetLastError();
        grid = cus;
    }
    if (grid < 0) return;
    if (hipMemsetAsync((char*)d_ws + WS_CTL, 0, CTL_ZERO_BYTES, stream) != hipSuccess) return;
    Args a{};
    for (int i = 0; i < 26; ++i) a.in[i] = (const float*)d_in[i];
    a.out = (float*)d_out; a.ws = (unsigned char*)d_ws; a.pad = 0;
#if MK_CUTS
    int li = 0;
    for (int k = 0; k < NPH; ++k) { if (!ph_on(k)) continue;
        a.ph_lo = k; a.ph_hi = k + 1; a.li = li++; hipLaunchKernelGGL(fwd, dim3(grid), dim3(512), LDS_BYTES, stream, a); }
#else
    a.ph_lo = 0; a.ph_hi = NPH; a.li = 0;
    hipLaunchKernelGGL(fwd, dim3(grid), dim3(512), LDS_BYTES, stream, a);
#endif
    const hipError_t le = hipPeekAtLastError();
    if (le != hipSuccess) fprintf(stderr, "kernel_launch: launch failed: %s\n", hipGetErrorName(le));
}
```

```cpp
#include <hip/hip_runtime.h>
#include <cstdio>
#include <cstdint>

#ifndef DBG_STOP
#define DBG_STOP 4
#endif
#ifndef REP_MASK
#define REP_MASK 0
#endif
#ifndef MK_CUTS
#define MK_CUTS 0
#endif

#define LAS __attribute__((address_space(3)))
#define GAS __attribute__((address_space(1)))
typedef unsigned short bf16;
typedef short bf16x8 __attribute__((ext_vector_type(8)));
typedef float f32x4 __attribute__((ext_vector_type(4)));
typedef float f32x2 __attribute__((ext_vector_type(2)));
typedef unsigned u32x4 __attribute__((ext_vector_type(4)));
typedef unsigned u32x2 __attribute__((ext_vector_type(2)));

constexpr int D = 1024, NBATCH = 8, SEQ = 8192, M = NBATCH * SEQ;
constexpr int NE = 32, DE = 512, NPAIR = 112;
constexpr float EPS = 1e-6f;
constexpr int NPH = 16;
#ifdef ONLY_PH
__host__ __device__ constexpr bool ph_on(int k) { return ((ONLY_PH >> k) & 1) != 0; }
#else
__host__ __device__ constexpr bool ph_on(int k) { return (k <= 3) || (k >= 4 && k <= 6 && DBG_STOP >= 2) || (k >= 7 && k <= 11 && DBG_STOP >= 3) || (k >= 12 && k <= 14 && DBG_STOP >= 4) || k == 15; }
#endif

constexpr size_t MiB = 1u << 20;
constexpr size_t WS_CTL = 0, CTL_ZERO_BYTES = 1 * MiB;
constexpr size_t WS_WSB = 1 * MiB;
constexpr size_t WS_WAX = 1 * MiB + 256 * 1024;
constexpr size_t WS_WRT = 2 * MiB;
constexpr size_t WS_RSTD = 3 * MiB;
constexpr size_t WS_CAR = 4 * MiB;
constexpr size_t WS_ELT = 8 * MiB;
constexpr size_t WS_ELG = 16 * MiB;
constexpr size_t WS_PLT = 24 * MiB;
constexpr size_t WS_WREST = 52 * MiB;
constexpr size_t WS_WV = 56 * MiB;
constexpr size_t WS_WO = 57 * MiB;
constexpr size_t WS_WC = 59 * MiB;
constexpr size_t WS_WCO = 63 * MiB;
constexpr size_t WS_WGU = 65 * MiB;
constexpr size_t WS_WD = 193 * MiB;
constexpr size_t WS_H = 257 * MiB;
constexpr size_t WS_Z = 385 * MiB;
constexpr size_t WS_VT = 641 * MiB;
constexpr size_t WS_Y = 705 * MiB;
constexpr size_t WS_END = 833 * MiB;
constexpr int CW_TMO = 0;
constexpr int CW_ECNT = 8192;
constexpr int CW_PCNT = 12288;
constexpr int CW_BAR = 32768;
constexpr int LDS_BYTES = 147456;
constexpr int TAB_OFF = 131072;
constexpr int MISC_OFF = LDS_BYTES - 256;

__device__ __forceinline__ float bflo(unsigned w) { return __uint_as_float(w << 16); }
__device__ __forceinline__ float bfhi(unsigned w) { return __uint_as_float(w & 0xffff0000u); }
__device__ __forceinline__ float bf1(unsigned short b) { return __uint_as_float(((unsigned)b) << 16); }
__device__ __forceinline__ unsigned cvt_pk_bf16(float lo, float hi) { unsigned r; asm volatile("v_cvt_pk_bf16_f32 %0, %1, %2" : "=v"(r) : "v"(lo), "v"(hi)); return r; }
__device__ __forceinline__ float wave_sum(float v) {
#pragma unroll
    for (int o = 1; o < 64; o <<= 1) v += __shfl_xor(v, o);
    return v;
}
__device__ __forceinline__ float sigmoidf_(float x) { return __builtin_amdgcn_rcpf(1.0f + __builtin_amdgcn_exp2f(-1.44269504f * x)); }
__device__ __forceinline__ float gelu_tanh(float x) { const float z = x * (1.0f + 0.044715f * x * x); return x * __builtin_amdgcn_rcpf(1.0f + __builtin_amdgcn_exp2f(-2.3022082f * z)); }
#define LDS_WAIT() asm volatile("s_waitcnt lgkmcnt(0)" ::: "memory")
#define VM_WAIT() asm volatile("s_waitcnt vmcnt(0)" ::: "memory")

namespace pg8 {
constexpr int BM = 256, BK = 64, HALF = 128, HTB = HALF * BK * 2, STAGE_BYTES = 8 * HTB, NXCD = 8, WGM = 8;
__host__ __device__ __forceinline__ int lds_byte(int r, int c) { const int st = (r >> 4) * 2 + (c >> 5), rr = r & 15, cc = c & 31, ob = rr * 64 + cc * 2; return st * 1024 + (ob ^ (((ob >> 9) & 1) << 5)); }
__host__ __device__ __forceinline__ void stage_rc(int b, int& R, int& C) { const int st = b / 1024, sb = b % 1024, swz = sb ^ (((sb >> 9) & 1) << 5); R = (st >> 1) * 16 + swz / 64; C = (st & 1) * 32 + (swz % 64) / 2; }
__host__ __device__ __forceinline__ int perm32(int rho) { const int n = rho >> 4, i = rho & 15; return 8 * (i >> 2) + 4 * n + (i & 3); }

struct Unit { int pm, pn; const char* A; const char* B0; const char* B1; const unsigned* list; const float* glist; int nvalid; };

template <class Epi, class Sched, bool GATHER>
__device__ __forceinline__ void gemm_phase(LAS unsigned char* lds, const int lda, const int ldb, const int K, const int nth, const Sched& S, const Epi& E) {
    const int tid = threadIdx.x, wid = __builtin_amdgcn_readfirstlane(tid >> 6), lane = tid & 63, wr = wid >> 2, wc = wid & 3, fr = lane & 15, fq = lane >> 4;
    const int nt = K / BK;
    int Rr[2], Cc[2]; unsigned voffB[2];
#pragma unroll
    for (int i = 0; i < 2; ++i) { int R, C; stage_rc(tid * 16 + i * 8192, R, C); Rr[i] = R; Cc[i] = C; const int Rb = Epi::PERM ? ((R & ~31) + perm32(R & 31)) : R; voffB[i] = (unsigned)(Rb * ldb + C) * 2u; }
    const size_t kstep = (size_t)(BK * 2);
    const size_t hstepB = (size_t)HALF * ldb * 2;
    const unsigned ldsw = (unsigned)wid * 1024u;
    const int aoff = lds_byte(wr * 64 + fr, fq * 8), boff = lds_byte(wc * 32 + fr, fq * 8);
#define PG8_SA(b, h) (((b) * 2 + (h)) * HTB)
#define PG8_SB(b, h) ((4 + (b) * 2 + (h)) * HTB)
#define PG8_STAGE(bufoff, gbase, voff) do { _Pragma("unroll") for (int _i = 0; _i < 2; ++_i) \
        __builtin_amdgcn_global_load_lds((const unsigned*)((const char*)(gbase) + (voff)[_i]), (LAS unsigned*)(lds + (bufoff) + ldsw + _i * 8192), 16, 0, 0); } while (0)
#define PG8_LDA(dst, b, h) do { _Pragma("unroll") for (int m = 0; m < 4; ++m) _Pragma("unroll") for (int k = 0; k < 2; ++k) dst[m][k] = *(const LAS bf16x8*)(lds + PG8_SA(b, h) + aoff + m * 2048 + k * 1024); } while (0)
#define PG8_LDB(dst, b, h) do { _Pragma("unroll") for (int n = 0; n < 2; ++n) _Pragma("unroll") for (int k = 0; k < 2; ++k) dst[n][k] = *(const LAS bf16x8*)(lds + PG8_SB(b, h) + boff + n * 2048 + k * 1024); } while (0)
#define PG8_MMA(ai, bj, At, Bt) do { __builtin_amdgcn_s_setprio(1); _Pragma("unroll") for (int m = 0; m < 4; ++m) _Pragma("unroll") for (int n = 0; n < 2; ++n) _Pragma("unroll") for (int k = 0; k < 2; ++k) \
        acc[ai][bj][m][n] = __builtin_amdgcn_mfma_f32_16x16x32_bf16(Bt[n][k], At[m][k], acc[ai][bj][m][n], 0, 0, 0); __builtin_amdgcn_s_setprio(0); } while (0)
#define PG8_WAIT_V(n) asm volatile("s_waitcnt vmcnt(" #n ")" ::: "memory")
#define PG8_WAIT_L(n) asm volatile("s_waitcnt lgkmcnt(" #n ")" ::: "memory")
#define PG8_BAR __builtin_amdgcn_s_barrier()
#define PG8_SCHED __builtin_amdgcn_sched_barrier(0)
    Unit cur, nxt; int ui = 0;
    if (!S.next(0, cur)) return;
    unsigned offc[2][2], offn[2][2], nid[2][2];
#pragma unroll
    for (int h = 0; h < 2; ++h)
#pragma unroll
        for (int i = 0; i < 2; ++i) {
            const int r = Rr[i] + HALF * h;
            if constexpr (GATHER) { const unsigned ent = r < cur.nvalid ? cur.list[r] : 0u; offc[h][i] = (ent & 0x7fffffffu) * (unsigned)(lda * 2) + (unsigned)(Cc[i] * 2); }
            else offc[h][i] = (unsigned)(r * lda + Cc[i]) * 2u;
            offn[h][i] = offc[h][i]; nid[h][i] = 0u;
        }
    f32x4 acc[2][2][4][2];
#pragma unroll
    for (int a = 0; a < 2; ++a)
#pragma unroll
        for (int b = 0; b < 2; ++b)
#pragma unroll
            for (int m = 0; m < 4; ++m)
#pragma unroll
                for (int n = 0; n < 2; ++n) acc[a][b][m][n] = (f32x4){0.f, 0.f, 0.f, 0.f};
    bf16x8 At[4][2], B0[2][2], B1[2][2];
    const char* cA = cur.A; const char* cB0 = cur.B0; const char* cB1 = cur.B1;
    PG8_STAGE(PG8_SB(0, 0), cB0, voffB); PG8_STAGE(PG8_SB(0, 1), cB0 + hstepB, voffB); PG8_STAGE(PG8_SA(0, 0), cA, offc[0]); PG8_STAGE(PG8_SA(0, 1), cA, offc[1]);
    if (wr == 1) PG8_BAR;
    PG8_WAIT_V(2); PG8_BAR;
    PG8_STAGE(PG8_SB(1, 0), cB0 + kstep, voffB); PG8_STAGE(PG8_SA(1, 0), cA + kstep, offc[0]); PG8_STAGE(PG8_SB(1, 1), cB0 + hstepB + kstep, voffB);
    PG8_WAIT_V(6); PG8_BAR;
    for (;;) {
        const bool has_next = S.next(ui + 1, nxt);
        if constexpr (GATHER) {
            if (has_next) {
#pragma unroll
                for (int h = 0; h < 2; ++h)
#pragma unroll
                    for (int i = 0; i < 2; ++i) { const int r = Rr[i] + HALF * h; nid[h][i] = r < nxt.nvalid ? nxt.list[r] : 0u; }
            }
        }
        const char* nA = has_next ? nxt.A : cA; const char* nB0 = has_next ? nxt.B0 : cB0;
        for (int t = 0; t < nt; t += 2) {
            const bool last = (t == nt - 2);
            const char* a1 = cA + (size_t)(t + 1) * kstep;
            const char* a2 = last ? nA : cA + (size_t)(t + 2) * kstep;
            const char* b2 = last ? nB0 : ((t + 2 < nth) ? cB0 + (size_t)(t + 2) * kstep : cB1 + (size_t)(t + 2 - nth) * kstep);
            const char* a3 = a2 + kstep; const char* b3 = b2 + kstep;
            unsigned o2[2][2];
            if constexpr (GATHER) {
                if (last && has_next) {
#pragma unroll
                    for (int h = 0; h < 2; ++h)
#pragma unroll
                        for (int i = 0; i < 2; ++i) offn[h][i] = (nid[h][i] & 0x7fffffffu) * (unsigned)(lda * 2) + (unsigned)(Cc[i] * 2);
                }
#pragma unroll
                for (int h = 0; h < 2; ++h)
#pragma unroll
                    for (int i = 0; i < 2; ++i) o2[h][i] = (last && has_next) ? offn[h][i] : offc[h][i];
            } else {
#pragma unroll
                for (int h = 0; h < 2; ++h)
#pragma unroll
                    for (int i = 0; i < 2; ++i) o2[h][i] = offc[h][i];
            }
            PG8_LDB(B0, 0, 0); PG8_LDB(B1, 0, 1); PG8_SCHED; PG8_LDA(At, 0, 0); PG8_STAGE(PG8_SA(1, 1), a1, offc[1]);
            PG8_WAIT_V(8); PG8_WAIT_L(0); PG8_BAR; PG8_MMA(0, 0, At, B0); PG8_MMA(0, 1, At, B1); PG8_BAR; PG8_SCHED;
            PG8_LDA(At, 0, 1); PG8_STAGE(PG8_SB(0, 0), b2, voffB); PG8_STAGE(PG8_SB(0, 1), b2 + hstepB, voffB); PG8_STAGE(PG8_SA(0, 0), a2, o2[0]);
            PG8_WAIT_V(8); PG8_WAIT_L(0); PG8_BAR; PG8_MMA(1, 0, At, B0); PG8_MMA(1, 1, At, B1); PG8_BAR; PG8_SCHED;
            PG8_LDB(B0, 1, 0); PG8_LDB(B1, 1, 1); PG8_SCHED; PG8_LDA(At, 1, 0); PG8_STAGE(PG8_SA(0, 1), a2, o2[1]);
            PG8_WAIT_V(8); PG8_WAIT_L(0); PG8_BAR; PG8_MMA(0, 0, At, B0); PG8_MMA(0, 1, At, B1); PG8_BAR; PG8_SCHED;
            PG8_LDA(At, 1, 1); PG8_STAGE(PG8_SB(1, 0), b3, voffB); PG8_STAGE(PG8_SB(1, 1), b3 + hstepB, voffB); PG8_STAGE(PG8_SA(1, 0), a3, o2[0]);
            PG8_WAIT_V(8); PG8_WAIT_L(0); PG8_BAR; PG8_MMA(1, 0, At, B0); PG8_MMA(1, 1, At, B1); PG8_BAR; PG8_SCHED;
        }
        if (wr == 0) PG8_BAR;
        E(acc, cur, wr, wc, fr, fq);
        if (!has_next) break;
#pragma unroll
        for (int a = 0; a < 2; ++a)
#pragma unroll
            for (int b = 0; b < 2; ++b)
#pragma unroll
                for (int m = 0; m < 4; ++m)
#pragma unroll
                    for (int n = 0; n < 2; ++n) acc[a][b][m][n] = (f32x4){0.f, 0.f, 0.f, 0.f};
        cur = nxt; cA = nA; cB0 = nB0; cB1 = nxt.B1; ++ui;
        if constexpr (GATHER) {
#pragma unroll
            for (int h = 0; h < 2; ++h)
#pragma unroll
                for (int i = 0; i < 2; ++i) offc[h][i] = offn[h][i];
        }
        if (wr == 1) PG8_BAR;
    }
    PG8_WAIT_V(0);
    PG8_BAR;
#undef PG8_SA
#undef PG8_SB
#undef PG8_STAGE
#undef PG8_LDA
#undef PG8_LDB
#undef PG8_MMA
#undef PG8_WAIT_V
#undef PG8_WAIT_L
#undef PG8_BAR
#undef PG8_SCHED
}

struct DenseOrder {
    int nM, nN, nwg, G, c; const char* A; const char* B; size_t tA, tB, b1off;
    __device__ __forceinline__ void init(int Mr, int N, int G_, int c_, const void* A_, int lda, const void* B_, int ldb, int nth) {
        nM = Mr / BM; nN = N / BM; nwg = nM * nN; G = G_; c = c_; A = (const char*)A_; B = (const char*)B_; tA = (size_t)BM * lda * 2; tB = (size_t)BM * ldb * 2; b1off = (size_t)nth * BK * 2; }
    __device__ __forceinline__ bool next(int i, Unit& u) const {
        const long L = (long)i * G + c; if (L >= nwg) return false;
        int wgid = (int)L; { const int q = nwg / NXCD, r = nwg % NXCD, xcd = wgid % NXCD, off = wgid / NXCD; wgid = (xcd < r ? xcd * (q + 1) : r * (q + 1) + (xcd - r) * q) + off; }
        const int nig = WGM * nN, gid = wgid / nig, fm = gid * WGM, gsz = (nM - fm) < WGM ? (nM - fm) : WGM;
        u.pm = fm + ((wgid % nig) % gsz); u.pn = (wgid % nig) / gsz;
        u.A = A + (size_t)u.pm * tA; u.B0 = B + (size_t)u.pn * tB; u.B1 = u.B0 + b1off; u.list = nullptr; u.glist = nullptr; u.nvalid = BM; return true;
    }
};
__device__ __forceinline__ int find_group(const LAS int* pref, int n, int rt, int lane) {
    const int j0 = lane, j1 = lane + 64;
    const bool f0 = j0 < n && pref[j0] <= rt && rt < pref[j0 + 1];
    const bool f1 = j1 < n && pref[j1] <= rt && rt < pref[j1 + 1];
    const unsigned long long m0 = __ballot(f0), m1 = __ballot(f1);
    return m0 ? (int)__builtin_ctzll(m0) : 64 + (int)__builtin_ctzll(m1 | (1ull << 63));
}
template <bool PAIR> struct GroupOrder {
    static constexpr size_t WSTRIDE = PAIR ? (size_t)1024 * 512 * 2 : (size_t)1024 * 1024 * 2, TB = PAIR ? (size_t)256 * 512 * 2 : (size_t)256 * 1024 * 2;
    const LAS int* pref; int ng, G, c, lane;
    const char* A; const char* W; const unsigned* lists; const float* glists;
    __device__ __forceinline__ bool next(int i, Unit& u) const {
        const LAS int* cnt = pref + 130;
        const long L = (long)i * G + c; const int total = __builtin_amdgcn_readfirstlane(pref[ng]);
        if (L >= 4L * total) return false;
        const int rt = (int)(L >> 2); u.pn = (int)(L & 3);
        const int g = __builtin_amdgcn_readfirstlane(find_group(pref, ng, rt, lane));
        const int tr = rt - __builtin_amdgcn_readfirstlane(pref[g]); const int cg = __builtin_amdgcn_readfirstlane(cnt[g]);
        u.pm = tr; u.nvalid = (cg - tr * BM) < BM ? (cg - tr * BM) : BM;
        u.list = lists + (size_t)g * 65536 + (size_t)tr * BM; u.glist = PAIR ? nullptr : glists + (size_t)g * 65536 + (size_t)tr * BM;
        u.A = A;
        if (PAIR) { const int grp = g / 28; int pi = g % 28, lo = 0; while (pi >= 7 - lo) { pi -= 7 - lo; ++lo; } const int hi = lo + 1 + pi;
            u.B0 = W + (size_t)(grp * 8 + lo) * WSTRIDE + (size_t)u.pn * TB; u.B1 = W + (size_t)(grp * 8 + hi) * WSTRIDE + (size_t)u.pn * TB; }
        else { u.B0 = W + (size_t)g * WSTRIDE + (size_t)u.pn * TB; u.B1 = u.B0; }
        return true;
    }
};

template <bool SCALE_COL> struct EpiZ {
    static constexpr bool PERM = true;
    bf16* O; int ldc; const float* rstd; int gelu_lt;
    __device__ __forceinline__ void operator()(const f32x4 (&acc)[2][2][4][2], const Unit& u, int wr, int wc, int fr, int fq) const {
        const int row0 = u.pm * BM + wr * 64 + fr, col0 = u.pn * BM + wc * 32 + 8 * fq; const bool act = u.pn < gelu_lt;
        f32x4 cs[2][2];
#pragma unroll
        for (int bj = 0; bj < 2; ++bj)
#pragma unroll
            for (int n = 0; n < 2; ++n) cs[bj][n] = SCALE_COL ? *(const f32x4*)(rstd + col0 + bj * HALF + 4 * n) : (f32x4){1.f, 1.f, 1.f, 1.f};
#pragma unroll
        for (int ai = 0; ai < 2; ++ai)
#pragma unroll
            for (int m = 0; m < 4; ++m) { const int r = row0 + ai * HALF + m * 16; const float rs = SCALE_COL ? 1.0f : rstd[r]; bf16* rowp = O + (size_t)r * ldc + col0;
#pragma unroll
                for (int bj = 0; bj < 2; ++bj) { f32x4 v0 = acc[ai][bj][m][0] * cs[bj][0] * rs, v1 = acc[ai][bj][m][1] * cs[bj][1] * rs;
                    if (act) {
#pragma unroll
                        for (int j = 0; j < 4; ++j) { v0[j] = gelu_tanh(v0[j]); v1[j] = gelu_tanh(v1[j]); } }
                    u32x4 w; w.x = cvt_pk_bf16(v0[0], v0[1]); w.y = cvt_pk_bf16(v0[2], v0[3]); w.z = cvt_pk_bf16(v1[0], v1[1]); w.w = cvt_pk_bf16(v1[2], v1[3]);
                    *(u32x4*)(rowp + bj * HALF) = w; } }
    }
};
struct EpiRes {
    static constexpr bool PERM = false;
    const float* __restrict__ base; float* __restrict__ out; int ldc;
    __device__ __forceinline__ void operator()(f32x4 (&acc)[2][2][4][2], const Unit& u, int wr, int wc, int fr, int fq) const {
        const int row0 = u.pm * BM + wr * 64 + fr, col0 = u.pn * BM + wc * 32 + 4 * fq;
#pragma unroll
        for (int ai = 0; ai < 2; ++ai)
#pragma unroll
            for (int m = 0; m < 4; ++m) { const size_t off = (size_t)(row0 + ai * HALF + m * 16) * ldc + col0;
#pragma unroll
                for (int bj = 0; bj < 2; ++bj)
#pragma unroll
                    for (int n = 0; n < 2; ++n) acc[ai][bj][m][n] += *(const f32x4*)(base + off + bj * HALF + n * 16); }
        asm volatile("" ::: "memory");
#pragma unroll
        for (int ai = 0; ai < 2; ++ai)
#pragma unroll
            for (int m = 0; m < 4; ++m) { const size_t off = (size_t)(row0 + ai * HALF + m * 16) * ldc + col0;
#pragma unroll
                for (int bj = 0; bj < 2; ++bj)
#pragma unroll
                    for (int n = 0; n < 2; ++n) *(f32x4*)(out + off + bj * HALF + n * 16) = acc[ai][bj][m][n]; }
    }
};
struct EpiG1 {
    static constexpr bool PERM = true;
    bf16* HID; const float* rstd;
    __device__ __forceinline__ void operator()(const f32x4 (&acc)[2][2][4][2], const Unit& u, int wr, int wc, int fr, int fq) const {
        const int col0 = u.pn * HALF + wc * 32 + 8 * fq;
#pragma unroll
        for (int ai = 0; ai < 2; ++ai)
#pragma unroll
            for (int m = 0; m < 4; ++m) { const int rl = ai * HALF + wr * 64 + m * 16 + fr;
                if (rl < u.nvalid) { const unsigned ent = u.list[rl]; const unsigned tok = ent & 0x7fffffffu, half = ent >> 31; const float gt = u.glist[rl], rs = rstd[tok];
                    float o[8];
#pragma unroll
                    for (int n = 0; n < 2; ++n)
#pragma unroll
                        for (int j = 0; j < 4; ++j) { const float g = acc[ai][0][m][n][j] * rs, up = acc[ai][1][m][n][j] * rs; o[4 * n + j] = g * sigmoidf_(g) * up * gt; }
                    u32x4 w; w.x = cvt_pk_bf16(o[0], o[1]); w.y = cvt_pk_bf16(o[2], o[3]); w.z = cvt_pk_bf16(o[4], o[5]); w.w = cvt_pk_bf16(o[6], o[7]);
                    *(u32x4*)(HID + (size_t)tok * 1024 + half * 512 + col0) = w; } }
    }
};
struct EpiG2 {
    static constexpr bool PERM = false;
    float* out;
    __device__ __forceinline__ void operator()(f32x4 (&acc)[2][2][4][2], const Unit& u, int wr, int wc, int fr, int fq) const {
        const int col0 = u.pn * BM + wc * 32 + 4 * fq;
        unsigned tokv[2][4];
#pragma unroll
        for (int ai = 0; ai < 2; ++ai)
#pragma unroll
            for (int m = 0; m < 4; ++m) { const int rl = ai * HALF + wr * 64 + m * 16 + fr; tokv[ai][m] = rl < u.nvalid ? (u.list[rl] & 0x7fffffffu) : 0xffffffffu; }
#pragma unroll
        for (int ai = 0; ai < 2; ++ai)
#pragma unroll
            for (int m = 0; m < 4; ++m) if (tokv[ai][m] != 0xffffffffu) { const float* __restrict__ p = out + (size_t)tokv[ai][m] * 1024 + col0;
#pragma unroll
                for (int bj = 0; bj < 2; ++bj)
#pragma unroll
                    for (int n = 0; n < 2; ++n) acc[ai][bj][m][n] += *(const f32x4*)(p + bj * HALF + n * 16); }
        asm volatile("" ::: "memory");
#pragma unroll
        for (int ai = 0; ai < 2; ++ai)
#pragma unroll
            for (int m = 0; m < 4; ++m) if (tokv[ai][m] != 0xffffffffu) { float* __restrict__ p = out + (size_t)tokv[ai][m] * 1024 + col0;
#pragma unroll
                for (int bj = 0; bj < 2; ++bj)
#pragma unroll
                    for (int n = 0; n < 2; ++n) *(f32x4*)(p + bj * HALF + n * 16) = acc[ai][bj][m][n]; }
    }
};
}

#define XB_TMO      128
#define XB_XCNT(j)  (256  + 64 * (j))
#define XB_XSUB(j)  (1280 + 64 * (j))
#define XB_XGEN(j)  (2304 + 64 * (j))
#define XB_TOP      3328
#define XB_TOPGEN   3392
#define XCD_BAR_WORDS 3456
#define XB_SPIN_CAP (1u << 18)
__device__ __forceinline__ unsigned xb_ld(unsigned* p)              { return __hip_atomic_load(p, __ATOMIC_RELAXED, __HIP_MEMORY_SCOPE_AGENT); }
__device__ __forceinline__ unsigned xb_add(unsigned* p, unsigned v) { return __hip_atomic_fetch_add(p, v, __ATOMIC_RELAXED, __HIP_MEMORY_SCOPE_AGENT); }
__device__ __forceinline__ unsigned xb_xcc_id() { return (unsigned)__builtin_amdgcn_s_getreg((3 << 11) | 20) & 0xFu; }
#define XB_SPIN(cond, bar) do { unsigned _sp = 0; while (cond) { __builtin_amdgcn_s_sleep(1); \
    if ((++_sp & 255u) == 0u) { if (xb_ld(&(bar)[XB_TMO])) break; if (_sp > XB_SPIN_CAP) { atomicAdd(&(bar)[XB_TMO], 1u); break; } } } } while (0)
struct XcdBarrier { unsigned* bar; unsigned x; volatile LAS unsigned* st; };
__device__ __forceinline__ XcdBarrier xcd_barrier_post(unsigned* bar, volatile LAS unsigned* st) {
    XcdBarrier b; b.bar = bar; b.x = xb_xcc_id(); b.st = st;
    if (threadIdx.x == 0) (void)xb_add(&bar[XB_XCNT(b.x)], 1u);
    return b;
}
__device__ __forceinline__ void xcd_barrier_complete(unsigned* bar, unsigned x, unsigned& nloc, unsigned& nx) {
    const unsigned G = gridDim.x * gridDim.y * gridDim.z;
    unsigned sum, cnt, mine, sp = 0u;
    for (;;) {
        sum = 0u; cnt = 0u; mine = 0u;
#pragma unroll
        for (unsigned j = 0; j < 16; ++j) { const unsigned c = xb_ld(&bar[XB_XCNT(j)]); sum += c; cnt += (c > 0u) ? 1u : 0u; mine = (j == x) ? c : mine; }
        if (sum == G) break;
        __builtin_amdgcn_s_sleep(1);
        if ((++sp & 255u) == 0u) { if (xb_ld(&bar[XB_TMO])) break; if (sp > XB_SPIN_CAP) { atomicAdd(&bar[XB_TMO], 1u); break; } }
    }
    nloc = mine > 0u ? mine : 1u; nx = cnt > 0u ? cnt : 1u;
}
__device__ __forceinline__ void xcd_barrier(const XcdBarrier& b) {
    asm volatile("s_waitcnt vmcnt(0)" ::: "memory");
    __syncthreads();
    if (threadIdx.x == 0) {
        unsigned* bar = b.bar;
        __builtin_amdgcn_s_waitcnt(0);
        unsigned nloc = b.st[0], nx = b.st[1];
        if (nloc == 0u) { xcd_barrier_complete(bar, b.x, nloc, nx); b.st[0] = nloc; b.st[1] = nx; }
        const unsigned old = xb_add(&bar[XB_XSUB(b.x)], 1u);
        const unsigned gen = old / nloc;
        if (old + 1u == (gen + 1u) * nloc) {
            __builtin_amdgcn_fence(__ATOMIC_RELEASE, "agent");
            asm volatile("s_waitcnt vmcnt(0)" ::: "memory");
            const unsigned og = xb_add(&bar[XB_TOP], 1u);
            const unsigned tg = og / nx;
            if (og + 1u == (tg + 1u) * nx) xb_add(&bar[XB_TOPGEN], 1u);
            else XB_SPIN(xb_ld(&bar[XB_TOPGEN]) == tg, bar);
            __builtin_amdgcn_fence(__ATOMIC_ACQUIRE, "agent");
            xb_add(&bar[XB_XGEN(b.x)], 1u);
            asm volatile("s_waitcnt vmcnt(0)" ::: "memory");
        } else {
            XB_SPIN(xb_ld(&bar[XB_XGEN(b.x)]) == gen, bar);
            __builtin_amdgcn_fence(__ATOMIC_ACQUIRE, "agent");
            asm volatile("s_waitcnt vmcnt(0)" ::: "memory");
        }
    }
    __syncthreads();
}

__device__ __forceinline__ void tr_item(const float* W, int ldw, int k0, int n0, bf16* WT, int ldt, int rd0, LAS float* scr, int lane) {
#pragma unroll 8
    for (int i = 0; i < 32; ++i) { const int kk = 2 * i + (lane >> 5); scr[kk * 33 + (lane & 31)] = W[(size_t)(k0 + kk) * ldw + n0 + (lane & 31)]; }
    LDS_WAIT(); asm volatile("" ::: "memory");
    const int c = lane & 7;
#pragma unroll
    for (int j = 0; j < 4; ++j) { const int n = (lane >> 3) + 8 * j; const LAS float* s = scr + (8 * c) * 33 + n;
        u32x4 o; o.x = cvt_pk_bf16(s[0 * 33], s[1 * 33]); o.y = cvt_pk_bf16(s[2 * 33], s[3 * 33]); o.z = cvt_pk_bf16(s[4 * 33], s[5 * 33]); o.w = cvt_pk_bf16(s[6 * 33], s[7 * 33]);
        *(u32x4*)(WT + (size_t)(rd0 + n) * ldt + k0 + 8 * c) = o; }
    LDS_WAIT(); asm volatile("" ::: "memory");
}
__device__ __forceinline__ void norm_row(const float* xrow, const float* g, bf16* hrow, float* rstd_out, int lane) {
    const f32x4* xr = (const f32x4*)xrow + lane; const f32x4* gr = (const f32x4*)g + lane;
    f32x4 v[4]; float s = 0.f;
#pragma unroll
    for (int j = 0; j < 4; ++j) { v[j] = xr[64 * j]; s += (v[j].x * v[j].x + v[j].y * v[j].y) + (v[j].z * v[j].z + v[j].w * v[j].w); }
    s = wave_sum(s);
    if (lane == 0) *rstd_out = 1.0f / sqrtf(s * (1.0f / D) + EPS);
    u32x2* o8 = (u32x2*)hrow + lane;
#pragma unroll
    for (int j = 0; j < 4; ++j) { const f32x4 gv = gr[64 * j]; u32x2 w; w.x = cvt_pk_bf16(v[j].x * gv.x, v[j].y * gv.y); w.y = cvt_pk_bf16(v[j].z * gv.z, v[j].w * gv.w); o8[64 * j] = w; }
}

struct Args { const float* in[26]; float* out; unsigned char* ws; int ph_lo, ph_hi, li, pad; };

__device__ __forceinline__ void p0_prologue(const Args& a, LAS unsigned char* lds, int G, int wave, int lane) {
    unsigned char* ws = a.ws;
    LAS float* scr = (LAS float*)(lds + wave * 16384);
    const int gw = blockIdx.x * 8 + wave, NGW = G * 8;
    constexpr int I_IN = 16 * 80, I_OUT = 16 * 32, I_CIN = 16 * 64, I_CO = 16 * 32, I_AX = 8 * 2 * 8, I_MOE = 64 * 768, I_RT = 2 * 16;
    constexpr int NITEMS = I_IN + I_OUT + I_CIN + I_CO + I_AX + I_MOE + I_RT;
    for (int it = gw; it < NITEMS; it += NGW) {
        int r = it;
        if (r < I_IN) { const int kb = r / 80, nb = r % 80, n0 = 32 * nb;
            if (n0 < 512) tr_item(a.in[4], 2560, 64 * kb, n0, (bf16*)(ws + WS_WREST), 1024, n0, scr, lane);
            else if (n0 < 1024) tr_item(a.in[4], 2560, 64 * kb, n0, (bf16*)(ws + WS_WV), 1024, n0 - 512, scr, lane);
            else tr_item(a.in[4], 2560, 64 * kb, n0, (bf16*)(ws + WS_WREST), 1024, n0 - 512, scr, lane);
            continue; } r -= I_IN;
        if (r < I_OUT) { tr_item(a.in[9], 1024, 64 * (r / 32), 32 * (r % 32), (bf16*)(ws + WS_WO), 1024, 32 * (r % 32), scr, lane); continue; } r -= I_OUT;
        if (r < I_CIN) { tr_item(a.in[10], 2048, 64 * (r / 64), 32 * (r % 64), (bf16*)(ws + WS_WC), 1024, 32 * (r % 64), scr, lane); continue; } r -= I_CIN;
        if (r < I_CO) { tr_item(a.in[18], 1024, 64 * (r / 32), 32 * (r % 32), (bf16*)(ws + WS_WCO), 1024, 32 * (r % 32), scr, lane); continue; } r -= I_CO;
        if (r < I_AX) { const int h = r / 16, gate = (r / 8) & 1, kb = (r / 4) & 1, nb = r & 3;
            tr_item((gate ? a.in[15] : a.in[13]) + (size_t)h * 16384, 128, 64 * kb, 32 * nb, (bf16*)(ws + WS_WAX) + (size_t)h * 256 * 128, 128, gate * 128 + 32 * nb, scr, lane); continue; } r -= I_AX;
        if (r < I_MOE) { const int le = r / 768, q = r % 768;
            if (q < 512) { const int up = q / 256, qq = q % 256, kb = qq / 16, nb = qq % 16, n0 = 32 * nb;
                tr_item((up ? a.in[24] : a.in[23]) + (size_t)le * 1024 * 512, 512, 64 * kb, n0, (bf16*)(ws + WS_WGU) + (size_t)le * 1024 * 1024, 1024, (n0 / 128) * 256 + up * 128 + (n0 % 128), scr, lane); }
            else { const int qq = q - 512, kb = qq / 32, nb = qq % 32;
                tr_item(a.in[25] + (size_t)le * 512 * 1024, 1024, 64 * kb, 32 * nb, (bf16*)(ws + WS_WD) + (size_t)le * 1024 * 512, 512, 32 * nb, scr, lane); }
            continue; } r -= I_MOE;
        { const int l = r / 16, kb = r % 16; tr_item(a.in[21] + (size_t)l * 1024 * 32, 32, 64 * kb, 0, (bf16*)(ws + WS_WRT) + (size_t)l * 48 * 1024, 1024, 0, scr, lane); }
    }
    const int gt = blockIdx.x * 512 + threadIdx.x, NGT = G * 512;
    for (int i = gt; i < 2 * 16 * 1024; i += NGT) {
        const int l = i / 16384, n = (i / 1024) & 15, k = i & 1023;
        const float v = n < 4 ? a.in[19][(size_t)l * 4096 + k * 4 + n] : 0.f;
        ((bf16*)(ws + WS_WRT))[(size_t)l * 48 * 1024 + (size_t)(32 + n) * 1024 + k] = (bf16)(cvt_pk_bf16(v, 0.f) & 0xffffu); }
    for (int i = gt; i < 4 * 128 * 128; i += NGT) {
        const int t = (i >> 7) & 127, s = i & 127; const float v = s <= t ? a.in[6][i] : 0.f;
        ((bf16*)(ws + WS_WSB))[i] = (bf16)(cvt_pk_bf16(v, 0.f) & 0xffffu); }
    for (int m = gw; m < M; m += NGW) norm_row(a.in[0] + (size_t)m * D, a.in[1], (bf16*)(ws + WS_H) + (size_t)m * D, (float*)(ws + WS_RSTD) + m, lane);
}
__device__ __forceinline__ void norm_phase(const float* x, const float* g, bf16* H, float* rstd, int G, int wave, int lane) {
    const int gw = blockIdx.x * 8 + wave, NGW = G * 8;
    for (int m = gw; m < M; m += NGW) norm_row(x + (size_t)m * D, g, H + (size_t)m * D, rstd + m, lane);
}
__device__ __forceinline__ void final_norm_phase(float* x, const float* g, int G, int wave, int lane) {
    const int gw = blockIdx.x * 8 + wave, NGW = G * 8;
    for (int m = gw; m < M; m += NGW) {
        f32x4* xr = (f32x4*)(x + (size_t)m * D) + lane; const f32x4* gr = (const f32x4*)g + lane;
        f32x4 v[4]; float s = 0.f;
#pragma unroll
        for (int j = 0; j < 4; ++j) { v[j] = xr[64 * j]; s += (v[j].x * v[j].x + v[j].y * v[j].y) + (v[j].z * v[j].z + v[j].w * v[j].w); }
        const float rs = 1.0f / sqrtf(wave_sum(s) * (1.0f / D) + EPS);
#pragma unroll
        for (int j = 0; j < 4; ++j) xr[64 * j] = v[j] * rs * gr[64 * j];
    }
}

__device__ __forceinline__ void p2_spatial(const Args& a, LAS unsigned char* lds, int G, int wave, int lane) {
    const bf16* ZR = (const bf16*)(a.ws + WS_Z); const bf16* VT = (const bf16*)(a.ws + WS_VT); bf16* Y = (bf16*)(a.ws + WS_Y); const bf16* WSB = (const bf16*)(a.ws + WS_WSB);
    LAS unsigned char* T = lds;
    LAS float* MU = (LAS float*)(lds + 131072); LAS float* RS = MU + 128; LAS float* PART = (LAS float*)(lds + 131072 + 1024);
    const int tid = threadIdx.x, fr = lane & 15, fq = lane >> 4;
    for (int unit = blockIdx.x; unit < M / 128; unit += G) {
        const size_t row0 = (size_t)unit * 128;
        {
            const int cg = tid & 63, rg = tid >> 6, c0 = 8 * cg; const size_t R = row0 + 16 * rg;
            float w0[8], w1[8], w2[8], p2v[8], p1v[8];
#pragma unroll
            for (int j = 0; j < 8; ++j) { w0[j] = a.in[8][c0 + j]; w1[j] = a.in[8][512 + c0 + j]; w2[j] = a.in[8][1024 + c0 + j]; p2v[j] = 0.f; p1v[j] = 0.f; }
            if ((R & (SEQ - 1)) != 0) {
                const u32x4 gc2 = *(const u32x4*)(ZR + (R - 2) * 2048 + 1024 + c0), xb2 = *(const u32x4*)(ZR + (R - 2) * 2048 + 1536 + c0);
                const u32x4 gc1 = *(const u32x4*)(ZR + (R - 1) * 2048 + 1024 + c0), xb1 = *(const u32x4*)(ZR + (R - 1) * 2048 + 1536 + c0);
#pragma unroll
                for (int j = 0; j < 4; ++j) { p2v[2 * j] = bflo(gc2[j]) * bflo(xb2[j]); p2v[2 * j + 1] = bfhi(gc2[j]) * bfhi(xb2[j]); p1v[2 * j] = bflo(gc1[j]) * bflo(xb1[j]); p1v[2 * j + 1] = bfhi(gc1[j]) * bfhi(xb1[j]); }
            }
#pragma unroll 4
            for (int r = 0; r < 16; ++r) { const bf16* zr = ZR + (R + r) * 2048 + c0;
                const u32x4 gb = *(const u32x4*)(zr + 512), gc = *(const u32x4*)(zr + 1024), xb = *(const u32x4*)(zr + 1536);
                float cx[8], y[8];
#pragma unroll
                for (int j = 0; j < 4; ++j) { cx[2 * j] = bflo(gc[j]) * bflo(xb[j]); cx[2 * j + 1] = bfhi(gc[j]) * bfhi(xb[j]); }
#pragma unroll
                for (int j = 0; j < 8; ++j) { const float gbj = (j & 1) ? bfhi(gb[j >> 1]) : bflo(gb[j >> 1]); y[j] = gbj * (w0[j] * p2v[j] + w1[j] * p1v[j] + w2[j] * cx[j]); p2v[j] = p1v[j]; p1v[j] = cx[j]; }
                u32x4 o; o.x = cvt_pk_bf16(y[0], y[1]); o.y = cvt_pk_bf16(y[2], y[3]); o.z = cvt_pk_bf16(y[4], y[5]); o.w = cvt_pk_bf16(y[6], y[7]);
                *(u32x4*)(Y + (R + r) * 1024 + 512 + c0) = o; }
        }
#pragma unroll 4
        for (int p = 0; p < 16; ++p) { const int row = p * 32 + (tid >> 4), ch = tid & 15;
            const u32x4 v = *(const u32x4*)(VT + (size_t)row * M + row0 + ch * 8);
            *(LAS u32x4*)(T + row * 256 + ((ch ^ (row & 15)) << 4)) = v; }
        __syncthreads();
        const int sg = tid & 15, dg = tid >> 4;
        {   float s[8], q[8];
#pragma unroll
            for (int j = 0; j < 8; ++j) { s[j] = 0.f; q[j] = 0.f; }
#pragma unroll 4
            for (int rr = 0; rr < 16; ++rr) { const u32x4 v = *(const LAS u32x4*)(T + (16 * dg + rr) * 256 + ((sg ^ rr) << 4));
#pragma unroll
                for (int j = 0; j < 4; ++j) { const float lo = bflo(v[j]), hi = bfhi(v[j]); s[2 * j] += lo; q[2 * j] += lo * lo; s[2 * j + 1] += hi; q[2 * j + 1] += hi * hi; } }
#pragma unroll
            for (int j = 0; j < 8; ++j) { s[j] += __shfl_xor(s[j], 16); s[j] += __shfl_xor(s[j], 32); q[j] += __shfl_xor(q[j], 16); q[j] += __shfl_xor(q[j], 32); }
            if (lane < 16) {
#pragma unroll
                for (int j = 0; j < 8; ++j) { PART[(wave * 128 + 8 * sg + j) * 2] = s[j]; PART[(wave * 128 + 8 * sg + j) * 2 + 1] = q[j]; } }
        }
        __syncthreads();
        if (tid < 128) { float s = 0.f, q = 0.f;
#pragma unroll
            for (int w = 0; w < 8; ++w) { s += PART[(w * 128 + tid) * 2]; q += PART[(w * 128 + tid) * 2 + 1]; }
            const float mean = s * (1.0f / 512.0f); float var = q * (1.0f / 512.0f) - mean * mean; var = var > 0.f ? var : 0.f;
            MU[tid] = mean; RS[tid] = 1.0f / sqrtf(var + EPS); }
        __syncthreads();
        {   float mu8[8], rs8[8];
#pragma unroll
            for (int j = 0; j < 8; ++j) { mu8[j] = MU[8 * sg + j]; rs8[j] = RS[8 * sg + j]; }
#pragma unroll 4
            for (int rr = 0; rr < 16; ++rr) { const int row = 16 * dg + rr; const float gd = a.in[5][row]; LAS u32x4* pp = (LAS u32x4*)(T + row * 256 + ((sg ^ rr) << 4)); const u32x4 v = *pp; u32x4 o;
#pragma unroll
                for (int j = 0; j < 4; ++j) o[j] = cvt_pk_bf16((bflo(v[j]) - mu8[2 * j]) * rs8[2 * j] * gd, (bfhi(v[j]) - mu8[2 * j + 1]) * rs8[2 * j + 1] * gd);
                *pp = o; }
        }
        __syncthreads();
        {   const int hh = wave >> 1, rh = wave & 1;
#pragma unroll 1
            for (int nh = 0; nh < 2; ++nh) {
                f32x4 acc[4][4];
#pragma unroll
                for (int m = 0; m < 4; ++m)
#pragma unroll
                    for (int n = 0; n < 4; ++n) acc[m][n] = (f32x4){0.f, 0.f, 0.f, 0.f};
#pragma unroll
                for (int ks = 0; ks < 4; ++ks) { bf16x8 Af[4];
#pragma unroll
                    for (int m = 0; m < 4; ++m) Af[m] = *(const bf16x8*)(WSB + (size_t)((hh * 128 + 64 * rh + 16 * m + fr) * 128 + 32 * ks + 8 * fq));
#pragma unroll
                    for (int n = 0; n < 4; ++n) { const bf16x8 Bf = *(const LAS bf16x8*)(T + (hh * 128 + 64 * nh + 16 * n + fr) * 256 + (((4 * ks + fq) ^ fr) << 4));
#pragma unroll
                        for (int m = 0; m < 4; ++m) acc[m][n] = __builtin_amdgcn_mfma_f32_16x16x32_bf16(Bf, Af[m], acc[m][n], 0, 0, 0); } }
#pragma unroll
                for (int m = 0; m < 4; ++m) { const int t = 64 * rh + 16 * m + fr; const size_t R = row0 + t; const float bias = a.in[7][hh * 128 + t];
#pragma unroll
                    for (int n = 0; n < 4; ++n) { const int d = hh * 128 + 64 * nh + 16 * n + 4 * fq; const u32x2 u4 = *(const u32x2*)(ZR + R * 2048 + d);
                        u32x2 o; o.x = cvt_pk_bf16(bflo(u4.x) * (acc[m][n][0] + bias), bfhi(u4.x) * (acc[m][n][1] + bias)); o.y = cvt_pk_bf16(bflo(u4.y) * (acc[m][n][2] + bias), bfhi(u4.y) * (acc[m][n][3] + bias));
                        *(u32x2*)(Y + R * 1024 + d) = o; } }
            }
        }
        __syncthreads();
    }
}

__device__ __forceinline__ void route_phase(const Args& a, int l, LAS unsigned char* lds, int G, int wave, int lane) {
    const float* X = a.out; bf16* H = (bf16*)(a.ws + WS_H); float* RSTD = (float*)(a.ws + WS_RSTD);
    const bf16* WRT = (const bf16*)(a.ws + WS_WRT) + (size_t)l * 48 * 1024; const float* gvec = a.in[2] + l * 1024;
    const float* brg = a.in[20] + l * 4; const float* bre = a.in[22] + l * 32;
    unsigned* ECNT = (unsigned*)(a.ws + WS_CTL) + CW_ECNT + l * 2048; unsigned* PCNT = (unsigned*)(a.ws + WS_CTL) + CW_PCNT + l * 7168;
    unsigned* ELT = (unsigned*)(a.ws + WS_ELT); float* ELG = (float*)(a.ws + WS_ELG); unsigned* PLT = (unsigned*)(a.ws + WS_PLT);
    constexpr int WROW = 2064;
    LAS unsigned char* WL = lds; LAS float* GL = (LAS float*)(lds + 99072); LAS float* SCR = (LAS float*)(lds + 103168) + wave * 768;
    LAS int* TOK = (LAS int*)(lds + 127744);
    LAS int* HIST = (LAS int*)(lds + 135936);
    const int tid = threadIdx.x, fr = lane & 15, fq = lane >> 4;
    for (int tile = blockIdx.x; tile < M / 256; tile += G) {
        __syncthreads();
        for (int i = tid; i < 48 * 128; i += 512) { const int row = i >> 7, ch = i & 127; *(LAS u32x4*)(WL + row * WROW + ch * 16) = *(const u32x4*)(WRT + (size_t)row * 1024 + ch * 8); }
        if (tid < 256) *(LAS f32x4*)(GL + 4 * tid) = *(const f32x4*)(gvec + 4 * tid);
        if (tid < 288) HIST[tid] = 0;
        __syncthreads();
        for (int mt = 2 * wave; mt < 2 * wave + 2; ++mt) {
            const size_t row = (size_t)tile * 256 + 16 * mt + fr; const float* xr = X + row * D; bf16* hr = H + row * D;
            f32x4 acc[3]; acc[0] = acc[1] = acc[2] = (f32x4){0.f, 0.f, 0.f, 0.f}; float ss = 0.f;
#pragma unroll 1
            for (int kb = 0; kb < 4; ++kb) {
                f32x4 xv[16];
#pragma unroll
                for (int j = 0; j < 8; ++j) { const int k0 = 32 * (8 * kb + j) + 8 * fq; xv[2 * j] = *(const f32x4*)(xr + k0); xv[2 * j + 1] = *(const f32x4*)(xr + k0 + 4); }
#pragma unroll
                for (int j = 0; j < 8; ++j) { const int k0 = 32 * (8 * kb + j) + 8 * fq; const f32x4 x0 = xv[2 * j], x1 = xv[2 * j + 1];
                    const f32x4 g0 = *(const LAS f32x4*)(GL + k0), g1 = *(const LAS f32x4*)(GL + k0 + 4);
                    ss += (x0.x * x0.x + x0.y * x0.y) + (x0.z * x0.z + x0.w * x0.w) + (x1.x * x1.x + x1.y * x1.y) + (x1.z * x1.z + x1.w * x1.w);
                    u32x4 hw; hw.x = cvt_pk_bf16(x0.x * g0.x, x0.y * g0.y); hw.y = cvt_pk_bf16(x0.z * g0.z, x0.w * g0.w); hw.z = cvt_pk_bf16(x1.x * g1.x, x1.y * g1.y); hw.w = cvt_pk_bf16(x1.z * g1.z, x1.w * g1.w);
                    *(u32x4*)(hr + k0) = hw; const bf16x8 Af = __builtin_bit_cast(bf16x8, hw);
#pragma unroll
                    for (int n = 0; n < 3; ++n) { const bf16x8 Bf = *(const LAS bf16x8*)(WL + (16 * n + fr) * WROW + k0 * 2); acc[n] = __builtin_amdgcn_mfma_f32_16x16x32_bf16(Bf, Af, acc[n], 0, 0, 0); } } }
            ss += __shfl_xor(ss, 16); ss += __shfl_xor(ss, 32);
            const float rstd = 1.0f / sqrtf(ss * (1.0f / D) + EPS);
            if (fq == 0) RSTD[row] = rstd;
#pragma unroll
            for (int n = 0; n < 3; ++n)
#pragma unroll
                for (int j = 0; j < 4; ++j) SCR[fr * 48 + 16 * n + 4 * fq + j] = acc[n][j] * rstd;
            LDS_WAIT(); asm volatile("" ::: "memory");
            if (lane < 16) { const LAS float* lg = SCR + lane * 48;
                float gl[4]; int gi = 0; float gm;
#pragma unroll
                for (int j = 0; j < 4; ++j) gl[j] = lg[32 + j] + brg[j];
                gm = gl[0];
#pragma unroll
                for (int j = 1; j < 4; ++j) if (gl[j] > gm) { gm = gl[j]; gi = j; }
                float den = 0.f;
#pragma unroll
                for (int j = 0; j < 4; ++j) den += __expf(gl[j] - gm);
                const float gp = 1.0f / den;
                float el[8];
#pragma unroll
                for (int j = 0; j < 8; ++j) el[j] = lg[8 * gi + j] + bre[8 * gi + j];
                int i1 = 0; float v1 = el[0];
#pragma unroll
                for (int j = 1; j < 8; ++j) if (el[j] > v1) { v1 = el[j]; i1 = j; }
                int i2 = -1; float v2 = -3.0e38f;
#pragma unroll
                for (int j = 0; j < 8; ++j) if (j != i1 && el[j] > v2) { v2 = el[j]; i2 = j; }
                const float e21 = __expf(v2 - v1), p1 = 1.0f / (1.0f + e21), p2 = e21 * p1;
                const int e1 = 8 * gi + i1, e2 = 8 * gi + i2; const int lo = i1 < i2 ? i1 : i2, hi = i1 < i2 ? i2 : i1;
                const int p = gi * 28 + (lo * (15 - lo)) / 2 + (hi - lo - 1);
                LAS int* tk = TOK + (16 * mt + lane) * 8;
                tk[0] = e1; tk[1] = e2; tk[2] = __float_as_int(gp * p1); tk[3] = __float_as_int(gp * p2);
                tk[4] = __hip_atomic_fetch_add(HIST + e1, 1, __ATOMIC_RELAXED, __HIP_MEMORY_SCOPE_WORKGROUP); tk[5] = __hip_atomic_fetch_add(HIST + e2, 1, __ATOMIC_RELAXED, __HIP_MEMORY_SCOPE_WORKGROUP); tk[6] = __hip_atomic_fetch_add(HIST + 32 + p, 1, __ATOMIC_RELAXED, __HIP_MEMORY_SCOPE_WORKGROUP); tk[7] = p; }
            LDS_WAIT(); asm volatile("" ::: "memory");
        }
        __syncthreads();
        if (tid < 32) { const int c = HIST[tid]; HIST[144 + tid] = c ? (int)__hip_atomic_fetch_add(ECNT + 64 * tid, (unsigned)c, __ATOMIC_RELAXED, __HIP_MEMORY_SCOPE_AGENT) : 0; }
        else if (tid < 144) { const int j = tid - 32; const int c = HIST[32 + j]; HIST[176 + j] = c ? (int)__hip_atomic_fetch_add(PCNT + 64 * j, (unsigned)c, __ATOMIC_RELAXED, __HIP_MEMORY_SCOPE_AGENT) : 0; }
        __syncthreads();
        if (tid < 256) { const LAS int* tk = TOK + tid * 8; const unsigned tok = (unsigned)(tile * 256 + tid);
            const int e1 = tk[0], e2 = tk[1]; const unsigned h1 = e1 < e2 ? 0u : 1u;
            const size_t s1 = (size_t)e1 * 65536 + HIST[144 + e1] + tk[4], s2 = (size_t)e2 * 65536 + HIST[144 + e2] + tk[5];
            ELT[s1] = tok | (h1 << 31); ELG[s1] = __int_as_float(tk[2]); ELT[s2] = tok | ((1u - h1) << 31); ELG[s2] = __int_as_float(tk[3]);
            PLT[(size_t)tk[7] * 65536 + HIST[176 + tk[7]] + tk[6]] = tok; }
    }
}
__device__ __forceinline__ void build_tables(LAS unsigned char* lds, unsigned* counters, int ng) {
    LAS int* pref = (LAS int*)(lds + TAB_OFF); LAS int* cnt = pref + 130;
    __syncthreads();
    if ((int)threadIdx.x < ng) cnt[threadIdx.x] = (int)__hip_atomic_load(counters + 64 * threadIdx.x, __ATOMIC_RELAXED, __HIP_MEMORY_SCOPE_AGENT);
    __syncthreads();
    if (threadIdx.x == 0) { int s = 0; for (int g = 0; g < ng; ++g) { pref[g] = s; s += (cnt[g] + 255) >> 8; } for (int g = ng; g < 130; ++g) pref[g] = s; }
    __syncthreads();
}

template <bool PASS2> __device__ __forceinline__ void scan_phase(const Args& a, LAS unsigned char* lds, int G, int wave, int lane) {
    const bf16* ZC = (const bf16*)(a.ws + WS_Z); bf16* Y = (bf16*)(a.ws + WS_Y); const bf16* WAX = (const bf16*)(a.ws + WS_WAX); float* CAR = (float*)(a.ws + WS_CAR);
    LAS unsigned char* RAW = lds;
    LAS unsigned char* AT = lds + 34816;
    LAS unsigned char* GT = lds + 67584;
    LAS float* CW = (LAS float*)(lds + 100352);
    const int tid = threadIdx.x, fr = lane & 15, fq = lane >> 4;
    const int cc = tid & 15, rq = tid >> 4;
    for (int unit = blockIdx.x; unit < 1024; unit += G) {
        const int hd = unit & 7, blk = (unit >> 3) & 15, b = unit >> 7;
        const size_t Rbase = (size_t)b * SEQ + blk * 512;
        const int ch = 128 * hd + 16 * wave + fr;
        bf16x8 Br[4], Bi[4];
#pragma unroll
        for (int ks = 0; ks < 4; ++ks) { Br[ks] = *(const bf16x8*)(WAX + (size_t)((hd * 256 + 16 * wave + fr) * 128 + 32 * ks + 8 * fq)); Bi[ks] = *(const bf16x8*)(WAX + (size_t)((hd * 256 + 128 + 16 * wave + fr) * 128 + 32 * ks + 8 * fq)); }
        const float ba = a.in[14][ch], bx = a.in[16][ch];
        const float kl = -8.0f * 1.44269504f * log1pf(__expf(-a.in[17][ch]));
        __syncthreads();
        if (tid < 128) { const int c = 128 * hd + tid;
#pragma unroll
            for (int k = 0; k < 4; ++k) CW[k * 128 + tid] = a.in[11][k * 1024 + c];
            CW[4 * 128 + tid] = a.in[12][c]; }
        float Hs = 0.f, Pa = 1.f;
        if (PASS2) { for (int j = 0; j < blk; ++j) { const f32x2 ab = *(const f32x2*)(CAR + ((size_t)(b * 16 + j) * 1024 + ch) * 2); Hs = ab.x * Hs + ab.y; } }
        u32x4 pr[5], pg[4];
#define SCAN_LOAD(sbn) do { const size_t R0n = Rbase + 128 * (sbn); \
            _Pragma("unroll") for (int p = 0; p < 5; ++p) { const int rr = p * 32 + rq; const int pos = blk * 512 + 128 * (sbn) - 3 + rr; pr[p] = (u32x4){0u, 0u, 0u, 0u}; \
                if (rr < 131 && pos >= 0) pr[p] = *(const u32x4*)(ZC + (R0n + rr - 3) * 2048 + 1024 + 128 * hd + 8 * cc); } \
            if (PASS2) { _Pragma("unroll") for (int p = 0; p < 4; ++p) pg[p] = *(const u32x4*)(ZC + (R0n + p * 32 + rq) * 2048 + 128 * hd + 8 * cc); } } while (0)
        SCAN_LOAD(0);
#pragma unroll 1
        for (int sb = 0; sb < 4; ++sb) {
            const size_t R0 = Rbase + 128 * sb;
#pragma unroll
            for (int p = 0; p < 5; ++p) { const int rr = p * 32 + rq; if (rr < 132) *(LAS u32x4*)(RAW + rr * 256 + cc * 16) = pr[p]; }
            if (PASS2) {
#pragma unroll
                for (int p = 0; p < 4; ++p) { const int row = p * 32 + rq; *(LAS u32x4*)(GT + row * 256 + ((cc ^ p) << 4)) = pg[p]; } }
            __syncthreads();
            if (sb < 3) SCAN_LOAD(sb + 1);
            {
                float cw[5][8];
#pragma unroll
                for (int k = 0; k < 5; ++k) { const f32x4 w0 = *(const LAS f32x4*)(CW + k * 128 + 8 * cc), w1 = *(const LAS f32x4*)(CW + k * 128 + 8 * cc + 4);
                    cw[k][0] = w0.x; cw[k][1] = w0.y; cw[k][2] = w0.z; cw[k][3] = w0.w; cw[k][4] = w1.x; cw[k][5] = w1.y; cw[k][6] = w1.z; cw[k][7] = w1.w; }
                float xw[7][8];
#pragma unroll
                for (int i = 0; i < 7; ++i) { const u32x4 v = *(const LAS u32x4*)(RAW + (4 * rq + i) * 256 + cc * 16);
#pragma unroll
                    for (int j = 0; j < 4; ++j) { xw[i][2 * j] = bflo(v[j]); xw[i][2 * j + 1] = bfhi(v[j]); } }
#pragma unroll
                for (int i = 0; i < 4; ++i) { const int t = 4 * rq + i; float o[8];
#pragma unroll
                    for (int j = 0; j < 8; ++j) o[j] = cw[4][j] + cw[0][j] * xw[i][j] + cw[1][j] * xw[i + 1][j] + cw[2][j] * xw[i + 2][j] + cw[3][j] * xw[i + 3][j];
                    u32x4 w; w.x = cvt_pk_bf16(o[0], o[1]); w.y = cvt_pk_bf16(o[2], o[3]); w.z = cvt_pk_bf16(o[4], o[5]); w.w = cvt_pk_bf16(o[6], o[7]);
                    const int key = (((t >> 5) & 3) << 2) | (t & 3);
                    *(LAS u32x4*)(AT + t * 256 + ((cc ^ key) << 4)) = w; }
            }
            __syncthreads();
            f32x4 ar[8], ai[8];
            const int arow = 32 * (fr >> 2) + (fr & 3);
#pragma unroll
            for (int m = 0; m < 8; ++m) { ar[m] = (f32x4){0.f, 0.f, 0.f, 0.f}; ai[m] = (f32x4){0.f, 0.f, 0.f, 0.f};
#pragma unroll
                for (int ks = 0; ks < 4; ++ks) { const bf16x8 Af = *(const LAS bf16x8*)(AT + (arow + 4 * m) * 256 + (((4 * ks + fq) ^ fr) << 4));
                    ar[m] = __builtin_amdgcn_mfma_f32_16x16x32_bf16(Af, Br[ks], ar[m], 0, 0, 0); ai[m] = __builtin_amdgcn_mfma_f32_16x16x32_bf16(Af, Bi[ks], ai[m], 0, 0, 0); } }
            float av[32], bv[32];
            const int cbase = 2 * wave + (fr >> 3);
#pragma unroll
            for (int m = 0; m < 8; ++m)
#pragma unroll
                for (int i = 0; i < 4; ++i) {
                    const float xr = bf1(*(const LAS unsigned short*)(AT + (32 * fq + 4 * m + i) * 256 + ((cbase ^ ((fq << 2) | i)) << 4) + (fr & 7) * 2));
                    const float r = sigmoidf_(ar[m][i] + ba), ig = sigmoidf_(ai[m][i] + bx);
                    const float aa = __builtin_amdgcn_exp2f(r * kl); float om = 1.0f - aa * aa; om = om > 0.f ? om : 0.f;
                    av[4 * m + i] = aa; bv[4 * m + i] = sqrtf(om) * ig * xr; }
            float As = 1.f, Bs = 0.f;
#pragma unroll
            for (int j = 0; j < 32; ++j) { Bs = av[j] * Bs + bv[j]; As *= av[j]; }
            float A1 = As, B1 = Bs;
            { const float Ap = __shfl_up(As, 16), Bp = __shfl_up(Bs, 16); if (fq >= 1) { A1 = Ap * As; B1 = As * Bp + Bs; } }
            float A2 = A1, B2 = B1;
            { const float Ap = __shfl_up(A1, 32), Bp = __shfl_up(B1, 32); if (fq >= 2) { A2 = Ap * A1; B2 = A1 * Bp + B1; } }
            if (PASS2) {
                float Ae = __shfl_up(A2, 16), Be = __shfl_up(B2, 16); if (fq == 0) { Ae = 1.f; Be = 0.f; }
                float h = Ae * Hs + Be;
                LAS unsigned short* gp = (LAS unsigned short*)(GT + (32 * fq) * 256 + ((cbase ^ fq) << 4) + (fr & 7) * 2);
#pragma unroll
                for (int j = 0; j < 32; ++j) { h = av[j] * h + bv[j]; const float gate = bf1(gp[j * 128]); gp[j * 128] = (unsigned short)(cvt_pk_bf16(gate * h, 0.f) & 0xffffu); }
            }
            const float At_ = __shfl(A2, fr + 48), Bt_ = __shfl(B2, fr + 48);
            Hs = At_ * Hs + Bt_; Pa *= At_;
            __syncthreads();
            if (PASS2) {
#pragma unroll
                for (int p = 0; p < 4; ++p) { const int row = p * 32 + rq; *(u32x4*)(Y + (R0 + row) * 1024 + 128 * hd + 8 * cc) = *(const LAS u32x4*)(GT + row * 256 + ((cc ^ p) << 4)); }
                __syncthreads();
            }
        }
#undef SCAN_LOAD
        if (!PASS2 && fq == 0) *(f32x2*)(CAR + ((size_t)(b * 16 + blk) * 1024 + ch) * 2) = (f32x2){Pa, Hs};
    }
}

__global__ void __launch_bounds__(512, 2) fwd(Args args) {
    extern __shared__ __attribute__((aligned(16))) unsigned char lds_raw[];
    LAS unsigned char* lds = (LAS unsigned char*)lds_raw;
    volatile LAS unsigned* MISC = (volatile LAS unsigned*)(lds + MISC_OFF);
    const int tid = threadIdx.x, lane = tid & 63, wave = __builtin_amdgcn_readfirstlane(tid >> 6), G = gridDim.x;
    const int vcu = (G % 8 == 0) ? (int)(blockIdx.x % 8) * (G / 8) + (int)(blockIdx.x / 8) : (int)blockIdx.x;
    unsigned char* ws = args.ws;
    if (tid < 64) MISC[tid] = 0u;
    __syncthreads();
    XcdBarrier bar = xcd_barrier_post((unsigned*)(ws + WS_CTL) + CW_BAR + args.li * XCD_BAR_WORDS, MISC + 8);
    const int lo = args.ph_lo, hi = args.ph_hi;
#define IN(k) (ph_on(k) && lo <= (k) && (k) < hi)
#define RUN(k, ...) do { if (IN(k)) { __VA_ARGS__ } if (IN(k) && ((REP_MASK >> (k)) & 1)) { __VA_ARGS__ } } while (0)
#define SEAM(k) do { if (IN(k) && hi > (k) + 1) xcd_barrier(bar); } while (0)
    bf16* H = (bf16*)(ws + WS_H); float* RSTD = (float*)(ws + WS_RSTD); bf16* Z = (bf16*)(ws + WS_Z); bf16* Yb = (bf16*)(ws + WS_Y);

    RUN(0, p0_prologue(args, lds, G, wave, lane););
    SEAM(0);
    RUN(1,
        { pg8::DenseOrder S; S.init(M, 2048, G, (int)blockIdx.x, H, 1024, ws + WS_WREST, 1024, 16);
          pg8::EpiZ<false> E{Z, 2048, RSTD, 2}; pg8::gemm_phase<pg8::EpiZ<false>, pg8::DenseOrder, false>(lds, 1024, 1024, 1024, 16, S, E); }
        { pg8::DenseOrder S; S.init(512, M, G, (int)blockIdx.x, ws + WS_WV, 1024, H, 1024, 16);
          pg8::EpiZ<true> E{(bf16*)(ws + WS_VT), M, RSTD, 1 << 30}; pg8::gemm_phase<pg8::EpiZ<true>, pg8::DenseOrder, false>(lds, 1024, 1024, 1024, 16, S, E); }
    );
    SEAM(1);
    RUN(2, p2_spatial(args, lds, G, wave, lane););
    SEAM(2);
    RUN(3, pg8::DenseOrder S; S.init(M, 1024, G, (int)blockIdx.x, Yb, 1024, ws + WS_WO, 1024, 16);
        pg8::EpiRes E{args.in[0], args.out, 1024}; pg8::gemm_phase<pg8::EpiRes, pg8::DenseOrder, false>(lds, 1024, 1024, 1024, 16, S, E););
    SEAM(3);
#define MOE_LAYER(l, pb) do { \
        if (IN(pb)) route_phase(args, l, lds, G, wave, lane); \
        SEAM(pb); \
        RUN((pb) + 1, \
            build_tables(lds, (unsigned*)(ws + WS_CTL) + CW_ECNT + (l) * 2048, NE); \
            pg8::GroupOrder<false> S; S.pref = (const LAS int*)(lds + TAB_OFF); S.ng = NE; S.G = G; S.c = vcu; S.lane = lane; \
            S.A = (const char*)H; S.W = (const char*)(ws + WS_WGU) + (size_t)(l) * 32 * 1024 * 1024 * 2; S.lists = (const unsigned*)(ws + WS_ELT); S.glists = (const float*)(ws + WS_ELG); \
            pg8::EpiG1 E{Z, RSTD}; pg8::gemm_phase<pg8::EpiG1, pg8::GroupOrder<false>, true>(lds, 1024, 1024, 1024, 16, S, E); \
        ); \
        SEAM((pb) + 1); \
        if (IN((pb) + 2)) { \
            build_tables(lds, (unsigned*)(ws + WS_CTL) + CW_PCNT + (l) * 7168, NPAIR); \
            pg8::GroupOrder<true> S; S.pref = (const LAS int*)(lds + TAB_OFF); S.ng = NPAIR; S.G = G; S.c = vcu; S.lane = lane; \
            S.A = (const char*)Z; S.W = (const char*)(ws + WS_WD) + (size_t)(l) * 32 * 1024 * 512 * 2; S.lists = (const unsigned*)(ws + WS_PLT); S.glists = nullptr; \
            pg8::EpiG2 E{args.out}; pg8::gemm_phase<pg8::EpiG2, pg8::GroupOrder<true>, true>(lds, 1024, 512, 1024, 8, S, E); \
        } \
        SEAM((pb) + 2); } while (0)
    MOE_LAYER(0, 4);
    RUN(7, norm_phase(args.out, args.in[1] + 1024, H, RSTD, G, wave, lane););
    SEAM(7);
    RUN(8, pg8::DenseOrder S; S.init(M, 2048, G, (int)blockIdx.x, H, 1024, ws + WS_WC, 1024, 16);
        pg8::EpiZ<false> E{Z, 2048, RSTD, 4}; pg8::gemm_phase<pg8::EpiZ<false>, pg8::DenseOrder, false>(lds, 1024, 1024, 1024, 16, S, E););
    SEAM(8);
    RUN(9, scan_phase<false>(args, lds, G, wave, lane););
    SEAM(9);
    RUN(10, scan_phase<true>(args, lds, G, wave, lane););
    SEAM(10);
    if (IN(11)) { pg8::DenseOrder S; S.init(M, 1024, G, (int)blockIdx.x, Yb, 1024, ws + WS_WCO, 1024, 16);
        pg8::EpiRes E{args.out, args.out, 1024}; pg8::gemm_phase<pg8::EpiRes, pg8::DenseOrder, false>(lds, 1024, 1024, 1024, 16, S, E); }
    SEAM(11);
    MOE_LAYER(1, 12);
#undef MOE_LAYER
    if (IN(15)) final_norm_phase(args.out, args.in[3], G, wave, lane);
#undef IN
#undef SEAM
}

extern "C" void kernel_launch(void* const* d_in, const int* in_sizes, int n_in, void* d_out, int out_size, void* d_ws, size_t ws_size, hipStream_t stream) {
    static int grid = 0;
    if (grid == 0) {
        if (n_in != 26 || in_sizes[0] != M * D || out_size != M * D || ws_size < WS_END) { fprintf(stderr, "kernel_launch: unexpected shapes (n_in %d, in0 %d, out %d, ws %zu < %zu); nothing launched\n", n_in, n_in > 0 ? in_sizes[0] : -1, out_size, ws_size, (size_t)WS_END); grid = -1; return; }
        int dev = 0, cus = 0, per_cu = 0;
        if (hipGetDevice(&dev) != hipSuccess || hipDeviceGetAttribute(&cus, hipDeviceAttributeMultiprocessorCount, dev) != hipSuccess) { grid = -1; return; }
        if (hipFuncSetAttribute((const void*)fwd, hipFuncAttributeMaxDynamicSharedMemorySize, LDS_BYTES) != hipSuccess) { fprintf(stderr, "kernel_launch: hipFuncSetAttribute failed\n"); grid = -1; return; }
        if (hipOccupancyMaxActiveBlocksPerMultiprocessor(&per_cu, (const void*)fwd, 512, LDS_BYTES) != hipSuccess || per_cu < 1) fprintf(stderr, "kernel_launch: occupancy query reports %d workgroups per CU\n", per_cu);
        (void)hipGetLastError();
        grid = cus;
    }
    if (grid < 0) return;
    if (hipMemsetAsync((char*)d_ws + WS_CTL, 0, CTL_ZERO_BYTES, stream) != hipSuccess) return;
    Args a{};
    for (int i = 0; i < 26; ++i) a.in[i] = (const float*)d_in[i];
    a.out = (float*)d_out; a.ws = (unsigned char*)d_ws; a.pad = 0;
#if MK_CUTS
    int li = 0;
    for (int k = 0; k < NPH; ++k) { if (!ph_on(k)) continue;
        a.ph_lo = k; a.ph_hi = k + 1; a.li = li++; hipLaunchKernelGGL(fwd, dim3(grid), dim3(512), LDS_BYTES, stream, a); }
#else
    a.ph_lo = 0; a.ph_hi = NPH; a.li = 0;
    hipLaunchKernelGGL(fwd, dim3(grid), dim3(512), LDS_BYTES, stream, a);
#endif
    const hipError_t le = hipPeekAtLastError();
    if (le != hipSuccess) fprintf(stderr, "kernel_launch: launch failed: %s\n", hipGetErrorName(le));
}
```

```cpp
#include <hip/hip_runtime.h>
#include <cstdio>
#include <cstdint>

#ifndef DBG_STOP
#define DBG_STOP 4
#endif
#ifndef REP_MASK
#define REP_MASK 0
#endif
#ifndef MK_CUTS
#define MK_CUTS 0
#endif

#define LAS __attribute__((address_space(3)))
#define GAS __attribute__((address_space(1)))
typedef unsigned short bf16;
typedef short bf16x8 __attribute__((ext_vector_type(8)));
typedef float f32x4 __attribute__((ext_vector_type(4)));
typedef float f32x2 __attribute__((ext_vector_type(2)));
typedef unsigned u32x4 __attribute__((ext_vector_type(4)));
typedef unsigned u32x2 __attribute__((ext_vector_type(2)));

constexpr int D = 1024, NBATCH = 8, SEQ = 8192, M = NBATCH * SEQ;
constexpr int NE = 32, DE = 512, NPAIR = 112;
constexpr float EPS = 1e-6f;
constexpr int NPH = 16;
#ifdef ONLY_PH
__host__ __device__ constexpr bool ph_on(int k) { return ((ONLY_PH >> k) & 1) != 0; }
#else
__host__ __device__ constexpr bool ph_on(int k) { return (k <= 3) || (k >= 4 && k <= 6 && DBG_STOP >= 2) || (k >= 7 && k <= 11 && DBG_STOP >= 3) || (k >= 12 && k <= 14 && DBG_STOP >= 4) || k == 15; }
#endif

constexpr size_t MiB = 1u << 20;
constexpr size_t WS_CTL = 0, CTL_ZERO_BYTES = 1 * MiB;
constexpr size_t WS_WSB = 1 * MiB;
constexpr size_t WS_WAX = 1 * MiB + 256 * 1024;
constexpr size_t WS_WRT = 2 * MiB;
constexpr size_t WS_RSTD = 3 * MiB;
constexpr size_t WS_CAR = 4 * MiB;
constexpr size_t WS_ELT = 8 * MiB;
constexpr size_t WS_ELG = 16 * MiB;
constexpr size_t WS_PLT = 24 * MiB;
constexpr size_t WS_WREST = 52 * MiB;
constexpr size_t WS_WV = 56 * MiB;
constexpr size_t WS_WO = 57 * MiB;
constexpr size_t WS_WC = 59 * MiB;
constexpr size_t WS_WCO = 63 * MiB;
constexpr size_t WS_WGU = 65 * MiB;
constexpr size_t WS_WD = 193 * MiB;
constexpr size_t WS_H = 257 * MiB;
constexpr size_t WS_Z = 385 * MiB;
constexpr size_t WS_VT = 641 * MiB;
constexpr size_t WS_Y = 705 * MiB;
constexpr size_t WS_XB = 833 * MiB;
constexpr size_t WS_END = 961 * MiB;
constexpr int CW_TMO = 0;
constexpr int CW_ECNT = 8192;
constexpr int CW_PCNT = 12288;
constexpr int CW_BAR = 32768;
constexpr int LDS_BYTES = 147456;
constexpr int TAB_OFF = 131072;
constexpr int MISC_OFF = LDS_BYTES - 256;

__device__ __forceinline__ float bflo(unsigned w) { return __uint_as_float(w << 16); }
__device__ __forceinline__ float bfhi(unsigned w) { return __uint_as_float(w & 0xffff0000u); }
__device__ __forceinline__ float bf1(unsigned short b) { return __uint_as_float(((unsigned)b) << 16); }
__device__ __forceinline__ unsigned cvt_pk_bf16(float lo, float hi) { unsigned r; asm volatile("v_cvt_pk_bf16_f32 %0, %1, %2" : "=v"(r) : "v"(lo), "v"(hi)); return r; }
__device__ __forceinline__ float wave_sum(float v) {
#pragma unroll
    for (int o = 1; o < 64; o <<= 1) v += __shfl_xor(v, o);
    return v;
}
__device__ __forceinline__ float sigmoidf_(float x) { return __builtin_amdgcn_rcpf(1.0f + __builtin_amdgcn_exp2f(-1.44269504f * x)); }
__device__ __forceinline__ float gelu_tanh(float x) { const float z = x * (1.0f + 0.044715f * x * x); return x * __builtin_amdgcn_rcpf(1.0f + __builtin_amdgcn_exp2f(-2.3022082f * z)); }
#define LDS_WAIT() asm volatile("s_waitcnt lgkmcnt(0)" ::: "memory")
#define VM_WAIT() asm volatile("s_waitcnt vmcnt(0)" ::: "memory")

namespace pg8 {
constexpr int BM = 256, BK = 64, HALF = 128, HTB = HALF * BK * 2, STAGE_BYTES = 8 * HTB, NXCD = 8, WGM = 8;
__host__ __device__ __forceinline__ int lds_byte(int r, int c) { const int st = (r >> 4) * 2 + (c >> 5), rr = r & 15, cc = c & 31, ob = rr * 64 + cc * 2; return st * 1024 + (ob ^ (((ob >> 9) & 1) << 5)); }
__host__ __device__ __forceinline__ void stage_rc(int b, int& R, int& C) { const int st = b / 1024, sb = b % 1024, swz = sb ^ (((sb >> 9) & 1) << 5); R = (st >> 1) * 16 + swz / 64; C = (st & 1) * 32 + (swz % 64) / 2; }
__host__ __device__ __forceinline__ int perm32(int rho) { const int n = rho >> 4, i = rho & 15; return 8 * (i >> 2) + 4 * n + (i & 3); }

struct Unit { int pm, pn; const char* A; const char* B0; const char* B1; const unsigned* list; const float* glist; int nvalid; };

template <class Epi, class Sched, bool GATHER>
__device__ __forceinline__ void gemm_phase(LAS unsigned char* lds, const int lda, const int ldb, const int K, const int nth, const Sched& S, const Epi& E) {
    const int tid = threadIdx.x, wid = __builtin_amdgcn_readfirstlane(tid >> 6), lane = tid & 63, wr = wid >> 2, wc = wid & 3, fr = lane & 15, fq = lane >> 4;
    const int nt = K / BK;
    int Rr[2], Cc[2]; unsigned voffB[2];
#pragma unroll
    for (int i = 0; i < 2; ++i) { int R, C; stage_rc(tid * 16 + i * 8192, R, C); Rr[i] = R; Cc[i] = C; const int Rb = Epi::PERM ? ((R & ~31) + perm32(R & 31)) : R; voffB[i] = (unsigned)(Rb * ldb + C) * 2u; }
    const size_t kstep = (size_t)(BK * 2);
    const size_t hstepB = (size_t)HALF * ldb * 2;
    const unsigned ldsw = (unsigned)wid * 1024u;
    const int aoff = lds_byte(wr * 64 + fr, fq * 8), boff = lds_byte(wc * 32 + fr, fq * 8);
#define PG8_SA(b, h) (((b) * 2 + (h)) * HTB)
#define PG8_SB(b, h) ((4 + (b) * 2 + (h)) * HTB)
#define PG8_STAGE(bufoff, gbase, voff) do { _Pragma("unroll") for (int _i = 0; _i < 2; ++_i) \
        __builtin_amdgcn_global_load_lds((const unsigned*)((const char*)(gbase) + (voff)[_i]), (LAS unsigned*)(lds + (bufoff) + ldsw + _i * 8192), 16, 0, 0); } while (0)
#define PG8_LDA(dst, b, h) do { _Pragma("unroll") for (int m = 0; m < 4; ++m) _Pragma("unroll") for (int k = 0; k < 2; ++k) dst[m][k] = *(const LAS bf16x8*)(lds + PG8_SA(b, h) + aoff + m * 2048 + k * 1024); } while (0)
#define PG8_LDB(dst, b, h) do { _Pragma("unroll") for (int n = 0; n < 2; ++n) _Pragma("unroll") for (int k = 0; k < 2; ++k) dst[n][k] = *(const LAS bf16x8*)(lds + PG8_SB(b, h) + boff + n * 2048 + k * 1024); } while (0)
#define PG8_MMA(ai, bj, At, Bt) do { __builtin_amdgcn_s_setprio(1); _Pragma("unroll") for (int m = 0; m < 4; ++m) _Pragma("unroll") for (int n = 0; n < 2; ++n) _Pragma("unroll") for (int k = 0; k < 2; ++k) \
        acc[ai][bj][m][n] = __builtin_amdgcn_mfma_f32_16x16x32_bf16(Bt[n][k], At[m][k], acc[ai][bj][m][n], 0, 0, 0); __builtin_amdgcn_s_setprio(0); } while (0)
#define PG8_WAIT_V(n) asm volatile("s_waitcnt vmcnt(" #n ")" ::: "memory")
#define PG8_WAIT_L(n) asm volatile("s_waitcnt lgkmcnt(" #n ")" ::: "memory")
#define PG8_BAR __builtin_amdgcn_s_barrier()
#define PG8_SCHED __builtin_amdgcn_sched_barrier(0)
    Unit cur, nxt; int ui = 0;
    if (!S.next(0, cur)) return;
    unsigned offc[2][2], offn[2][2], nid[2][2];
#pragma unroll
    for (int h = 0; h < 2; ++h)
#pragma unroll
        for (int i = 0; i < 2; ++i) {
            const int r = Rr[i] + HALF * h;
            if constexpr (GATHER) { const unsigned ent = r < cur.nvalid ? cur.list[r] : 0u; offc[h][i] = (ent & 0x7fffffffu) * (unsigned)(lda * 2) + (unsigned)(Cc[i] * 2); }
            else offc[h][i] = (unsigned)(r * lda + Cc[i]) * 2u;
            offn[h][i] = offc[h][i]; nid[h][i] = 0u;
        }
    f32x4 acc[2][2][4][2];
#pragma unroll
    for (int a = 0; a < 2; ++a)
#pragma unroll
        for (int b = 0; b < 2; ++b)
#pragma unroll
            for (int m = 0; m < 4; ++m)
#pragma unroll
                for (int n = 0; n < 2; ++n) acc[a][b][m][n] = (f32x4){0.f, 0.f, 0.f, 0.f};
    bf16x8 At[4][2], B0[2][2], B1[2][2];
    const char* cA = cur.A; const char* cB0 = cur.B0; const char* cB1 = cur.B1;
    PG8_STAGE(PG8_SB(0, 0), cB0, voffB); PG8_STAGE(PG8_SB(0, 1), cB0 + hstepB, voffB); PG8_STAGE(PG8_SA(0, 0), cA, offc[0]); PG8_STAGE(PG8_SA(0, 1), cA, offc[1]);
    if (wr == 1) PG8_BAR;
    PG8_WAIT_V(2); PG8_BAR;
    PG8_STAGE(PG8_SB(1, 0), cB0 + kstep, voffB); PG8_STAGE(PG8_SA(1, 0), cA + kstep, offc[0]); PG8_STAGE(PG8_SB(1, 1), cB0 + hstepB + kstep, voffB);
    PG8_WAIT_V(6); PG8_BAR;
    for (;;) {
        const bool has_next = S.next(ui + 1, nxt);
        if constexpr (GATHER) {
            if (has_next) {
#pragma unroll
                for (int h = 0; h < 2; ++h)
#pragma unroll
                    for (int i = 0; i < 2; ++i) { const int r = Rr[i] + HALF * h; nid[h][i] = r < nxt.nvalid ? nxt.list[r] : 0u; }
            }
        }
        const char* nA = has_next ? nxt.A : cA; const char* nB0 = has_next ? nxt.B0 : cB0;
        for (int t = 0; t < nt; t += 2) {
            const bool last = (t == nt - 2);
            const char* a1 = cA + (size_t)(t + 1) * kstep;
            const char* a2 = last ? nA : cA + (size_t)(t + 2) * kstep;
            const char* b2 = last ? nB0 : ((t + 2 < nth) ? cB0 + (size_t)(t + 2) * kstep : cB1 + (size_t)(t + 2 - nth) * kstep);
            const char* a3 = a2 + kstep; const char* b3 = b2 + kstep;
            unsigned o2[2][2];
            if constexpr (GATHER) {
                if (last && has_next) {
#pragma unroll
                    for (int h = 0; h < 2; ++h)
#pragma unroll
                        for (int i = 0; i < 2; ++i) offn[h][i] = (nid[h][i] & 0x7fffffffu) * (unsigned)(lda * 2) + (unsigned)(Cc[i] * 2);
                }
#pragma unroll
                for (int h = 0; h < 2; ++h)
#pragma unroll
                    for (int i = 0; i < 2; ++i) o2[h][i] = (last && has_next) ? offn[h][i] : offc[h][i];
            } else {
#pragma unroll
                for (int h = 0; h < 2; ++h)
#pragma unroll
                    for (int i = 0; i < 2; ++i) o2[h][i] = offc[h][i];
            }
            PG8_LDB(B0, 0, 0); PG8_LDB(B1, 0, 1); PG8_SCHED; PG8_LDA(At, 0, 0); PG8_STAGE(PG8_SA(1, 1), a1, offc[1]);
            PG8_WAIT_V(8); PG8_WAIT_L(0); PG8_BAR; PG8_MMA(0, 0, At, B0); PG8_MMA(0, 1, At, B1); PG8_BAR; PG8_SCHED;
            PG8_LDA(At, 0, 1); PG8_STAGE(PG8_SB(0, 0), b2, voffB); PG8_STAGE(PG8_SB(0, 1), b2 + hstepB, voffB); PG8_STAGE(PG8_SA(0, 0), a2, o2[0]);
            PG8_WAIT_V(8); PG8_WAIT_L(0); PG8_BAR; PG8_MMA(1, 0, At, B0); PG8_MMA(1, 1, At, B1); PG8_BAR; PG8_SCHED;
            PG8_LDB(B0, 1, 0); PG8_LDB(B1, 1, 1); PG8_SCHED; PG8_LDA(At, 1, 0); PG8_STAGE(PG8_SA(0, 1), a2, o2[1]);
            PG8_WAIT_V(8); PG8_WAIT_L(0); PG8_BAR; PG8_MMA(0, 0, At, B0); PG8_MMA(0, 1, At, B1); PG8_BAR; PG8_SCHED;
            PG8_LDA(At, 1, 1); PG8_STAGE(PG8_SB(1, 0), b3, voffB); PG8_STAGE(PG8_SB(1, 1), b3 + hstepB, voffB); PG8_STAGE(PG8_SA(1, 0), a3, o2[0]);
            PG8_WAIT_V(8); PG8_WAIT_L(0); PG8_BAR; PG8_MMA(1, 0, At, B0); PG8_MMA(1, 1, At, B1); PG8_BAR; PG8_SCHED;
        }
        if (wr == 0) PG8_BAR;
        E(acc, cur, wr, wc, fr, fq);
        if (!has_next) break;
#pragma unroll
        for (int a = 0; a < 2; ++a)
#pragma unroll
            for (int b = 0; b < 2; ++b)
#pragma unroll
                for (int m = 0; m < 4; ++m)
#pragma unroll
                    for (int n = 0; n < 2; ++n) acc[a][b][m][n] = (f32x4){0.f, 0.f, 0.f, 0.f};
        cur = nxt; cA = nA; cB0 = nB0; cB1 = nxt.B1; ++ui;
        if constexpr (GATHER) {
#pragma unroll
            for (int h = 0; h < 2; ++h)
#pragma unroll
                for (int i = 0; i < 2; ++i) offc[h][i] = offn[h][i];
        }
        if (wr == 1) PG8_BAR;
    }
    PG8_WAIT_V(0);
    PG8_BAR;
#undef PG8_SA
#undef PG8_SB
#undef PG8_STAGE
#undef PG8_LDA
#undef PG8_LDB
#undef PG8_MMA
#undef PG8_WAIT_V
#undef PG8_WAIT_L
#undef PG8_BAR
#undef PG8_SCHED
}

struct DenseOrder {
    int nM, nN, nwg, G, c; const char* A; const char* B; size_t tA, tB, b1off;
    __device__ __forceinline__ void init(int Mr, int N, int G_, int c_, const void* A_, int lda, const void* B_, int ldb, int nth) {
        nM = Mr / BM; nN = N / BM; nwg = nM * nN; G = G_; c = c_; A = (const char*)A_; B = (const char*)B_; tA = (size_t)BM * lda * 2; tB = (size_t)BM * ldb * 2; b1off = (size_t)nth * BK * 2; }
    __device__ __forceinline__ bool next(int i, Unit& u) const {
        const long L = (long)i * G + c; if (L >= nwg) return false;
        int wgid = (int)L; { const int q = nwg / NXCD, r = nwg % NXCD, xcd = wgid % NXCD, off = wgid / NXCD; wgid = (xcd < r ? xcd * (q + 1) : r * (q + 1) + (xcd - r) * q) + off; }
        const int nig = WGM * nN, gid = wgid / nig, fm = gid * WGM, gsz = (nM - fm) < WGM ? (nM - fm) : WGM;
        u.pm = fm + ((wgid % nig) % gsz); u.pn = (wgid % nig) / gsz;
        u.A = A + (size_t)u.pm * tA; u.B0 = B + (size_t)u.pn * tB; u.B1 = u.B0 + b1off; u.list = nullptr; u.glist = nullptr; u.nvalid = BM; return true;
    }
};
__device__ __forceinline__ int find_group(const LAS int* pref, int n, int rt, int lane) {
    const int j0 = lane, j1 = lane + 64;
    const bool f0 = j0 < n && pref[j0] <= rt && rt < pref[j0 + 1];
    const bool f1 = j1 < n && pref[j1] <= rt && rt < pref[j1 + 1];
    const unsigned long long m0 = __ballot(f0), m1 = __ballot(f1);
    return m0 ? (int)__builtin_ctzll(m0) : 64 + (int)__builtin_ctzll(m1 | (1ull << 63));
}
template <bool PAIR> struct GroupOrder {
    static constexpr size_t WSTRIDE = PAIR ? (size_t)1024 * 512 * 2 : (size_t)1024 * 1024 * 2, TB = PAIR ? (size_t)256 * 512 * 2 : (size_t)256 * 1024 * 2;
    const LAS int* pref; int ng, G, c, lane;
    const char* A; const char* W; const unsigned* lists; const float* glists;
    __device__ __forceinline__ bool next(int i, Unit& u) const {
        const LAS int* cnt = pref + 130;
        const long L = (long)i * G + c; const int total = __builtin_amdgcn_readfirstlane(pref[ng]);
        if (L >= 4L * total) return false;
        const int rt = (int)(L >> 2); u.pn = (int)(L & 3);
        const int g = __builtin_amdgcn_readfirstlane(find_group(pref, ng, rt, lane));
        const int tr = rt - __builtin_amdgcn_readfirstlane(pref[g]); const int cg = __builtin_amdgcn_readfirstlane(cnt[g]);
        u.pm = tr; u.nvalid = (cg - tr * BM) < BM ? (cg - tr * BM) : BM;
        u.list = lists + (size_t)g * 65536 + (size_t)tr * BM; u.glist = PAIR ? nullptr : glists + (size_t)g * 65536 + (size_t)tr * BM;
        u.A = A;
        if (PAIR) { const int grp = g / 28; int pi = g % 28, lo = 0; while (pi >= 7 - lo) { pi -= 7 - lo; ++lo; } const int hi = lo + 1 + pi;
            u.B0 = W + (size_t)(grp * 8 + lo) * WSTRIDE + (size_t)u.pn * TB; u.B1 = W + (size_t)(grp * 8 + hi) * WSTRIDE + (size_t)u.pn * TB; }
        else { u.B0 = W + (size_t)g * WSTRIDE + (size_t)u.pn * TB; u.B1 = u.B0; }
        return true;
    }
};

template <bool SCALE_COL> struct EpiZ {
    static constexpr bool PERM = true;
    bf16* O; int ldc; const float* rstd; int gelu_lt; int st_on;
    __device__ __forceinline__ void operator()(const f32x4 (&acc)[2][2][4][2], const Unit& u, int wr, int wc, int fr, int fq) const {
        const int row0 = u.pm * BM + wr * 64 + fr, col0 = u.pn * BM + wc * 32 + 8 * fq; const bool act = u.pn < gelu_lt;
        f32x4 cs[2][2];
#pragma unroll
        for (int bj = 0; bj < 2; ++bj)
#pragma unroll
            for (int n = 0; n < 2; ++n) cs[bj][n] = SCALE_COL ? *(const f32x4*)(rstd + col0 + bj * HALF + 4 * n) : (f32x4){1.f, 1.f, 1.f, 1.f};
#pragma unroll
        for (int ai = 0; ai < 2; ++ai)
#pragma unroll
            for (int m = 0; m < 4; ++m) { const int r = row0 + ai * HALF + m * 16; const float rs = SCALE_COL ? 1.0f : rstd[r]; bf16* rowp = O + (size_t)r * ldc + col0;
#pragma unroll
                for (int bj = 0; bj < 2; ++bj) { f32x4 v0 = acc[ai][bj][m][0] * cs[bj][0] * rs, v1 = acc[ai][bj][m][1] * cs[bj][1] * rs;
                    if (act) {
#pragma unroll
                        for (int j = 0; j < 4; ++j) { v0[j] = gelu_tanh(v0[j]); v1[j] = gelu_tanh(v1[j]); } }
                    u32x4 w; w.x = cvt_pk_bf16(v0[0], v0[1]); w.y = cvt_pk_bf16(v0[2], v0[3]); w.z = cvt_pk_bf16(v1[0], v1[1]); w.w = cvt_pk_bf16(v1[2], v1[3]);
                    if (st_on) *(u32x4*)(rowp + bj * HALF) = w; } }
    }
};
template <bool BASE_F32> struct EpiRes {
    static constexpr bool PERM = true;
    const void* __restrict__ base; bf16* __restrict__ out;
    __device__ __forceinline__ void operator()(f32x4 (&acc)[2][2][4][2], const Unit& u, int wr, int wc, int fr, int fq) const {
        const int row0 = u.pm * BM + wr * 64 + fr, col0 = u.pn * BM + wc * 32 + 8 * fq;
#pragma unroll
        for (int ai = 0; ai < 2; ++ai)
#pragma unroll
            for (int m = 0; m < 4; ++m) { const size_t off = (size_t)(row0 + ai * HALF + m * 16) * 1024 + col0;
#pragma unroll
                for (int bj = 0; bj < 2; ++bj) {
                    if (BASE_F32) { const float* bp = (const float*)base + off + bj * HALF; acc[ai][bj][m][0] += *(const f32x4*)bp; acc[ai][bj][m][1] += *(const f32x4*)(bp + 4); }
                    else { const u32x4 w = *(const u32x4*)((const bf16*)base + off + bj * HALF);
                        acc[ai][bj][m][0] += (f32x4){bflo(w.x), bfhi(w.x), bflo(w.y), bfhi(w.y)}; acc[ai][bj][m][1] += (f32x4){bflo(w.z), bfhi(w.z), bflo(w.w), bfhi(w.w)}; } } }
        asm volatile("" ::: "memory");
#pragma unroll
        for (int ai = 0; ai < 2; ++ai)
#pragma unroll
            for (int m = 0; m < 4; ++m) { const size_t off = (size_t)(row0 + ai * HALF + m * 16) * 1024 + col0;
#pragma unroll
                for (int bj = 0; bj < 2; ++bj) { const f32x4 v0 = acc[ai][bj][m][0], v1 = acc[ai][bj][m][1];
                    u32x4 w; w.x = cvt_pk_bf16(v0[0], v0[1]); w.y = cvt_pk_bf16(v0[2], v0[3]); w.z = cvt_pk_bf16(v1[0], v1[1]); w.w = cvt_pk_bf16(v1[2], v1[3]);
                    *(u32x4*)(out + off + bj * HALF) = w; } }
    }
};
struct EpiG1 {
    static constexpr bool PERM = true;
    bf16* HID; const float* rstd;
    __device__ __forceinline__ void operator()(const f32x4 (&acc)[2][2][4][2], const Unit& u, int wr, int wc, int fr, int fq) const {
        const int col0 = u.pn * HALF + wc * 32 + 8 * fq;
#pragma unroll
        for (int ai = 0; ai < 2; ++ai)
#pragma unroll
            for (int m = 0; m < 4; ++m) { const int rl = ai * HALF + wr * 64 + m * 16 + fr;
                if (rl < u.nvalid) { const unsigned ent = u.list[rl]; const unsigned tok = ent & 0x7fffffffu, half = ent >> 31; const float gt = u.glist[rl], rs = rstd[tok];
                    float o[8];
#pragma unroll
                    for (int n = 0; n < 2; ++n)
#pragma unroll
                        for (int j = 0; j < 4; ++j) { const float g = acc[ai][0][m][n][j] * rs, up = acc[ai][1][m][n][j] * rs; o[4 * n + j] = g * sigmoidf_(g) * up * gt; }
                    u32x4 w; w.x = cvt_pk_bf16(o[0], o[1]); w.y = cvt_pk_bf16(o[2], o[3]); w.z = cvt_pk_bf16(o[4], o[5]); w.w = cvt_pk_bf16(o[6], o[7]);
                    *(u32x4*)(HID + (size_t)tok * 1024 + half * 512 + col0) = w; } }
    }
};
struct EpiG2 {
    static constexpr bool PERM = true;
    bf16* out;
    __device__ __forceinline__ void operator()(f32x4 (&acc)[2][2][4][2], const Unit& u, int wr, int wc, int fr, int fq) const {
        const int col0 = u.pn * BM + wc * 32 + 8 * fq;
        unsigned tokv[2][4];
#pragma unroll
        for (int ai = 0; ai < 2; ++ai)
#pragma unroll
            for (int m = 0; m < 4; ++m) { const int rl = ai * HALF + wr * 64 + m * 16 + fr; tokv[ai][m] = rl < u.nvalid ? (u.list[rl] & 0x7fffffffu) : 0xffffffffu; }
#pragma unroll
        for (int ai = 0; ai < 2; ++ai)
#pragma unroll
            for (int m = 0; m < 4; ++m) if (tokv[ai][m] != 0xffffffffu) { const bf16* __restrict__ p = out + (size_t)tokv[ai][m] * 1024 + col0;
#pragma unroll
                for (int bj = 0; bj < 2; ++bj) { const u32x4 w = *(const u32x4*)(p + bj * HALF);
                    acc[ai][bj][m][0] += (f32x4){bflo(w.x), bfhi(w.x), bflo(w.y), bfhi(w.y)}; acc[ai][bj][m][1] += (f32x4){bflo(w.z), bfhi(w.z), bflo(w.w), bfhi(w.w)}; } }
        asm volatile("" ::: "memory");
#pragma unroll
        for (int ai = 0; ai < 2; ++ai)
#pragma unroll
            for (int m = 0; m < 4; ++m) if (tokv[ai][m] != 0xffffffffu) { bf16* __restrict__ p = out + (size_t)tokv[ai][m] * 1024 + col0;
#pragma unroll
                for (int bj = 0; bj < 2; ++bj) { const f32x4 v0 = acc[ai][bj][m][0], v1 = acc[ai][bj][m][1];
                    u32x4 w; w.x = cvt_pk_bf16(v0[0], v0[1]); w.y = cvt_pk_bf16(v0[2], v0[3]); w.z = cvt_pk_bf16(v1[0], v1[1]); w.w = cvt_pk_bf16(v1[2], v1[3]);
                    *(u32x4*)(p + bj * HALF) = w; } }
    }
};
}

#define XB_TMO      128
#define XB_XCNT(j)  (256  + 64 * (j))
#define XB_XSUB(j)  (1280 + 64 * (j))
#define XB_XGEN(j)  (2304 + 64 * (j))
#define XB_TOP      3328
#define XB_TOPGEN   3392
#define XCD_BAR_WORDS 3456
#define XB_SPIN_CAP (1u << 18)
__device__ __forceinline__ unsigned xb_ld(unsigned* p)              { return __hip_atomic_load(p, __ATOMIC_RELAXED, __HIP_MEMORY_SCOPE_AGENT); }
__device__ __forceinline__ unsigned xb_add(unsigned* p, unsigned v) { return __hip_atomic_fetch_add(p, v, __ATOMIC_RELAXED, __HIP_MEMORY_SCOPE_AGENT); }
__device__ __forceinline__ unsigned xb_xcc_id() { return (unsigned)__builtin_amdgcn_s_getreg((3 << 11) | 20) & 0xFu; }
#define XB_SPIN(cond, bar) do { unsigned _sp = 0; while (cond) { __builtin_amdgcn_s_sleep(1); \
    if ((++_sp & 255u) == 0u) { if (xb_ld(&(bar)[XB_TMO])) break; if (_sp > XB_SPIN_CAP) { atomicAdd(&(bar)[XB_TMO], 1u); break; } } } } while (0)
struct XcdBarrier { unsigned* bar; unsigned x; volatile LAS unsigned* st; };
__device__ __forceinline__ XcdBarrier xcd_barrier_post(unsigned* bar, volatile LAS unsigned* st) {
    XcdBarrier b; b.bar = bar; b.x = xb_xcc_id(); b.st = st;
    if (threadIdx.x == 0) (void)xb_add(&bar[XB_XCNT(b.x)], 1u);
    return b;
}
__device__ __forceinline__ void xcd_barrier_complete(unsigned* bar, unsigned x, unsigned& nloc, unsigned& nx) {
    const unsigned G = gridDim.x * gridDim.y * gridDim.z;
    unsigned sum, cnt, mine, sp = 0u;
    for (;;) {
        sum = 0u; cnt = 0u; mine = 0u;
#pragma unroll
        for (unsigned j = 0; j < 16; ++j) { const unsigned c = xb_ld(&bar[XB_XCNT(j)]); sum += c; cnt += (c > 0u) ? 1u : 0u; mine = (j == x) ? c : mine; }
        if (sum == G) break;
        __builtin_amdgcn_s_sleep(1);
        if ((++sp & 255u) == 0u) { if (xb_ld(&bar[XB_TMO])) break; if (sp > XB_SPIN_CAP) { atomicAdd(&bar[XB_TMO], 1u); break; } }
    }
    nloc = mine > 0u ? mine : 1u; nx = cnt > 0u ? cnt : 1u;
}
__device__ __forceinline__ void xcd_barrier(const XcdBarrier& b) {
    asm volatile("s_waitcnt vmcnt(0)" ::: "memory");
    __syncthreads();
    if (threadIdx.x == 0) {
        unsigned* bar = b.bar;
        __builtin_amdgcn_s_waitcnt(0);
        unsigned nloc = b.st[0], nx = b.st[1];
        if (nloc == 0u) { xcd_barrier_complete(bar, b.x, nloc, nx); b.st[0] = nloc; b.st[1] = nx; }
        const unsigned old = xb_add(&bar[XB_XSUB(b.x)], 1u);
        const unsigned gen = old / nloc;
        if (old + 1u == (gen + 1u) * nloc) {
            __builtin_amdgcn_fence(__ATOMIC_RELEASE, "agent");
            asm volatile("s_waitcnt vmcnt(0)" ::: "memory");
            const unsigned og = xb_add(&bar[XB_TOP], 1u);
            const unsigned tg = og / nx;
            if (og + 1u == (tg + 1u) * nx) xb_add(&bar[XB_TOPGEN], 1u);
            else XB_SPIN(xb_ld(&bar[XB_TOPGEN]) == tg, bar);
            __builtin_amdgcn_fence(__ATOMIC_ACQUIRE, "agent");
            xb_add(&bar[XB_XGEN(b.x)], 1u);
            asm volatile("s_waitcnt vmcnt(0)" ::: "memory");
        } else {
            XB_SPIN(xb_ld(&bar[XB_XGEN(b.x)]) == gen, bar);
            __builtin_amdgcn_fence(__ATOMIC_ACQUIRE, "agent");
            asm volatile("s_waitcnt vmcnt(0)" ::: "memory");
        }
    }
    __syncthreads();
}

__device__ __forceinline__ void tr_item(const float* W, int ldw, int k0, int n0, bf16* WT, int ldt, int rd0, LAS float* scr, int lane) {
#pragma unroll 8
    for (int i = 0; i < 32; ++i) { const int kk = 2 * i + (lane >> 5); scr[kk * 33 + (lane & 31)] = W[(size_t)(k0 + kk) * ldw + n0 + (lane & 31)]; }
    LDS_WAIT(); asm volatile("" ::: "memory");
    const int c = lane & 7;
#pragma unroll
    for (int j = 0; j < 4; ++j) { const int n = (lane >> 3) + 8 * j; const LAS float* s = scr + (8 * c) * 33 + n;
        u32x4 o; o.x = cvt_pk_bf16(s[0 * 33], s[1 * 33]); o.y = cvt_pk_bf16(s[2 * 33], s[3 * 33]); o.z = cvt_pk_bf16(s[4 * 33], s[5 * 33]); o.w = cvt_pk_bf16(s[6 * 33], s[7 * 33]);
        *(u32x4*)(WT + (size_t)(rd0 + n) * ldt + k0 + 8 * c) = o; }
    LDS_WAIT(); asm volatile("" ::: "memory");
}
__device__ __forceinline__ void norm_row(const float* xrow, const float* g, bf16* hrow, float* rstd_out, int lane) {
    const f32x4* xr = (const f32x4*)xrow + lane; const f32x4* gr = (const f32x4*)g + lane;
    f32x4 v[4]; float s = 0.f;
#pragma unroll
    for (int j = 0; j < 4; ++j) { v[j] = xr[64 * j]; s += (v[j].x * v[j].x + v[j].y * v[j].y) + (v[j].z * v[j].z + v[j].w * v[j].w); }
    s = wave_sum(s);
    if (lane == 0) *rstd_out = 1.0f / sqrtf(s * (1.0f / D) + EPS);
    u32x2* o8 = (u32x2*)hrow + lane;
#pragma unroll
    for (int j = 0; j < 4; ++j) { const f32x4 gv = gr[64 * j]; u32x2 w; w.x = cvt_pk_bf16(v[j].x * gv.x, v[j].y * gv.y); w.y = cvt_pk_bf16(v[j].z * gv.z, v[j].w * gv.w); o8[64 * j] = w; }
}

struct Args { const float* in[26]; float* out; unsigned char* ws; int ph_lo, ph_hi, li, pad; };

__device__ __forceinline__ void p0_prologue(const Args& a, LAS unsigned char* lds, int G, int wave, int lane) {
    unsigned char* ws = a.ws;
    LAS float* scr = (LAS float*)(lds + wave * 16384);
    const int gw = blockIdx.x * 8 + wave, NGW = G * 8;
    constexpr int I_IN = 16 * 80, I_OUT = 16 * 32, I_CIN = 16 * 64, I_CO = 16 * 32, I_AX = 8 * 2 * 8, I_MOE = 64 * 768, I_RT = 2 * 16;
    constexpr int NITEMS = I_IN + I_OUT + I_CIN + I_CO + I_AX + I_MOE + I_RT;
    for (int it = gw; it < NITEMS; it += NGW) {
        int r = it;
        if (r < I_IN) { const int kb = r / 80, nb = r % 80, n0 = 32 * nb;
            if (n0 < 512) tr_item(a.in[4], 2560, 64 * kb, n0, (bf16*)(ws + WS_WREST), 1024, n0, scr, lane);
            else if (n0 < 1024) tr_item(a.in[4], 2560, 64 * kb, n0, (bf16*)(ws + WS_WV), 1024, n0 - 512, scr, lane);
            else tr_item(a.in[4], 2560, 64 * kb, n0, (bf16*)(ws + WS_WREST), 1024, n0 - 512, scr, lane);
            continue; } r -= I_IN;
        if (r < I_OUT) { tr_item(a.in[9], 1024, 64 * (r / 32), 32 * (r % 32), (bf16*)(ws + WS_WO), 1024, 32 * (r % 32), scr, lane); continue; } r -= I_OUT;
        if (r < I_CIN) { tr_item(a.in[10], 2048, 64 * (r / 64), 32 * (r % 64), (bf16*)(ws + WS_WC), 1024, 32 * (r % 64), scr, lane); continue; } r -= I_CIN;
        if (r < I_CO) { tr_item(a.in[18], 1024, 64 * (r / 32), 32 * (r % 32), (bf16*)(ws + WS_WCO), 1024, 32 * (r % 32), scr, lane); continue; } r -= I_CO;
        if (r < I_AX) { const int h = r / 16, gate = (r / 8) & 1, kb = (r / 4) & 1, nb = r & 3;
            tr_item((gate ? a.in[15] : a.in[13]) + (size_t)h * 16384, 128, 64 * kb, 32 * nb, (bf16*)(ws + WS_WAX) + (size_t)h * 256 * 128, 128, gate * 128 + 32 * nb, scr, lane); continue; } r -= I_AX;
        if (r < I_MOE) { const int le = r / 768, q = r % 768;
            if (q < 512) { const int up = q / 256, qq = q % 256, kb = qq / 16, nb = qq % 16, n0 = 32 * nb;
                tr_item((up ? a.in[24] : a.in[23]) + (size_t)le * 1024 * 512, 512, 64 * kb, n0, (bf16*)(ws + WS_WGU) + (size_t)le * 1024 * 1024, 1024, (n0 / 128) * 256 + up * 128 + (n0 % 128), scr, lane); }
            else { const int qq = q - 512, kb = qq / 32, nb = qq % 32;
                tr_item(a.in[25] + (size_t)le * 512 * 1024, 1024, 64 * kb, 32 * nb, (bf16*)(ws + WS_WD) + (size_t)le * 1024 * 512, 512, 32 * nb, scr, lane); }
            continue; } r -= I_MOE;
        { const int l = r / 16, kb = r % 16; tr_item(a.in[21] + (size_t)l * 1024 * 32, 32, 64 * kb, 0, (bf16*)(ws + WS_WRT) + (size_t)l * 48 * 1024, 1024, 0, scr, lane); }
    }
    const int gt = blockIdx.x * 512 + threadIdx.x, NGT = G * 512;
    for (int i = gt; i < 2 * 16 * 1024; i += NGT) {
        const int l = i / 16384, n = (i / 1024) & 15, k = i & 1023;
        const float v = n < 4 ? a.in[19][(size_t)l * 4096 + k * 4 + n] : 0.f;
        ((bf16*)(ws + WS_WRT))[(size_t)l * 48 * 1024 + (size_t)(32 + n) * 1024 + k] = (bf16)(cvt_pk_bf16(v, 0.f) & 0xffffu); }
    for (int i = gt; i < 4 * 128 * 128; i += NGT) {
        const int t = (i >> 7) & 127, s = i & 127; const float v = s <= t ? a.in[6][i] : 0.f;
        ((bf16*)(ws + WS_WSB))[i] = (bf16)(cvt_pk_bf16(v, 0.f) & 0xffffu); }
    for (int m = gw; m < M; m += NGW) norm_row(a.in[0] + (size_t)m * D, a.in[1], (bf16*)(ws + WS_H) + (size_t)m * D, (float*)(ws + WS_RSTD) + m, lane);
}
__device__ __forceinline__ void norm_phase(const bf16* xb, const float* g, bf16* H, float* rstd, int G, int wave, int lane) {
    const int gw = blockIdx.x * 8 + wave, NGW = G * 8;
    for (int m = gw; m < M; m += NGW) {
        const u32x4* xr = (const u32x4*)(xb + (size_t)m * D) + lane; u32x4* hr = (u32x4*)(H + (size_t)m * D) + lane;
        u32x4 v[2]; float s = 0.f;
#pragma unroll
        for (int j = 0; j < 2; ++j) { v[j] = xr[64 * j];
#pragma unroll
            for (int k = 0; k < 4; ++k) { const float lo = bflo(v[j][k]), hi = bfhi(v[j][k]); s += lo * lo + hi * hi; } }
        s = wave_sum(s);
        if (lane == 0) rstd[m] = 1.0f / sqrtf(s * (1.0f / D) + EPS);
#pragma unroll
        for (int j = 0; j < 2; ++j) { const f32x4 g0 = *(const f32x4*)(g + 8 * lane + 512 * j), g1 = *(const f32x4*)(g + 8 * lane + 512 * j + 4); u32x4 o;
            o.x = cvt_pk_bf16(bflo(v[j].x) * g0.x, bfhi(v[j].x) * g0.y); o.y = cvt_pk_bf16(bflo(v[j].y) * g0.z, bfhi(v[j].y) * g0.w);
            o.z = cvt_pk_bf16(bflo(v[j].z) * g1.x, bfhi(v[j].z) * g1.y); o.w = cvt_pk_bf16(bflo(v[j].w) * g1.z, bfhi(v[j].w) * g1.w); hr[64 * j] = o; }
    }
}
__device__ __forceinline__ void final_norm_phase(const bf16* xb, float* out, const float* g, int G, int wave, int lane) {
    const int gw = blockIdx.x * 8 + wave, NGW = G * 8;
    for (int m = gw; m < M; m += NGW) {
        const u32x4* xr = (const u32x4*)(xb + (size_t)m * D) + lane; float* orow = out + (size_t)m * D;
        u32x4 v[2]; float s = 0.f;
#pragma unroll
        for (int j = 0; j < 2; ++j) { v[j] = xr[64 * j];
#pragma unroll
            for (int k = 0; k < 4; ++k) { const float lo = bflo(v[j][k]), hi = bfhi(v[j][k]); s += lo * lo + hi * hi; } }
        const float rs = 1.0f / sqrtf(wave_sum(s) * (1.0f / D) + EPS);
#pragma unroll
        for (int j = 0; j < 2; ++j) { const f32x4 g0 = *(const f32x4*)(g + 8 * lane + 512 * j), g1 = *(const f32x4*)(g + 8 * lane + 512 * j + 4);
            *(f32x4*)(orow + 8 * lane + 512 * j) = (f32x4){bflo(v[j].x) * rs * g0.x, bfhi(v[j].x) * rs * g0.y, bflo(v[j].y) * rs * g0.z, bfhi(v[j].y) * rs * g0.w};
            *(f32x4*)(orow + 8 * lane + 512 * j + 4) = (f32x4){bflo(v[j].z) * rs * g1.x, bfhi(v[j].z) * rs * g1.y, bflo(v[j].w) * rs * g1.z, bfhi(v[j].w) * rs * g1.w}; }
    }
}

__device__ __forceinline__ void p2_spatial(const Args& a, LAS unsigned char* lds, int G, int wave, int lane) {
    const bf16* ZR = (const bf16*)(a.ws + WS_Z); const bf16* VT = (const bf16*)(a.ws + WS_VT); bf16* Y = (bf16*)(a.ws + WS_Y); const bf16* WSB = (const bf16*)(a.ws + WS_WSB);
    LAS unsigned char* T = lds;
    LAS float* MU = (LAS float*)(lds + 131072); LAS float* RS = MU + 128; LAS float* PART = (LAS float*)(lds + 131072 + 1024);
    const int tid = threadIdx.x, fr = lane & 15, fq = lane >> 4;
    for (int unit = blockIdx.x; unit < M / 128; unit += G) {
        const size_t row0 = (size_t)unit * 128;
        {
            const int cg = tid & 63, rg = tid >> 6, c0 = 8 * cg; const size_t R = row0 + 16 * rg;
            float w0[8], w1[8], w2[8], p2v[8], p1v[8];
#pragma unroll
            for (int j = 0; j < 8; ++j) { w0[j] = a.in[8][c0 + j]; w1[j] = a.in[8][512 + c0 + j]; w2[j] = a.in[8][1024 + c0 + j]; p2v[j] = 0.f; p1v[j] = 0.f; }
            if ((R & (SEQ - 1)) != 0) {
                const u32x4 gc2 = *(const u32x4*)(ZR + (R - 2) * 2048 + 1024 + c0), xb2 = *(const u32x4*)(ZR + (R - 2) * 2048 + 1536 + c0);
                const u32x4 gc1 = *(const u32x4*)(ZR + (R - 1) * 2048 + 1024 + c0), xb1 = *(const u32x4*)(ZR + (R - 1) * 2048 + 1536 + c0);
#pragma unroll
                for (int j = 0; j < 4; ++j) { p2v[2 * j] = bflo(gc2[j]) * bflo(xb2[j]); p2v[2 * j + 1] = bfhi(gc2[j]) * bfhi(xb2[j]); p1v[2 * j] = bflo(gc1[j]) * bflo(xb1[j]); p1v[2 * j + 1] = bfhi(gc1[j]) * bfhi(xb1[j]); }
            }
#pragma unroll 4
            for (int r = 0; r < 16; ++r) { const bf16* zr = ZR + (R + r) * 2048 + c0;
                const u32x4 gb = *(const u32x4*)(zr + 512), gc = *(const u32x4*)(zr + 1024), xb = *(const u32x4*)(zr + 1536);
                float cx[8], y[8];
#pragma unroll
                for (int j = 0; j < 4; ++j) { cx[2 * j] = bflo(gc[j]) * bflo(xb[j]); cx[2 * j + 1] = bfhi(gc[j]) * bfhi(xb[j]); }
#pragma unroll
                for (int j = 0; j < 8; ++j) { const float gbj = (j & 1) ? bfhi(gb[j >> 1]) : bflo(gb[j >> 1]); y[j] = gbj * (w0[j] * p2v[j] + w1[j] * p1v[j] + w2[j] * cx[j]); p2v[j] = p1v[j]; p1v[j] = cx[j]; }
                u32x4 o; o.x = cvt_pk_bf16(y[0], y[1]); o.y = cvt_pk_bf16(y[2], y[3]); o.z = cvt_pk_bf16(y[4], y[5]); o.w = cvt_pk_bf16(y[6], y[7]);
                *(u32x4*)(Y + (R + r) * 1024 + 512 + c0) = o; }
        }
#pragma unroll 4
        for (int p = 0; p < 16; ++p) { const int row = p * 32 + (tid >> 4), ch = tid & 15;
            const u32x4 v = *(const u32x4*)(VT + (size_t)row * M + row0 + ch * 8);
            *(LAS u32x4*)(T + row * 256 + ((ch ^ (row & 15)) << 4)) = v; }
        __syncthreads();
        const int sg = tid & 15, dg = tid >> 4;
        {   float s[8], q[8];
#pragma unroll
            for (int j = 0; j < 8; ++j) { s[j] = 0.f; q[j] = 0.f; }
#pragma unroll 4
            for (int rr = 0; rr < 16; ++rr) { const u32x4 v = *(const LAS u32x4*)(T + (16 * dg + rr) * 256 + ((sg ^ rr) << 4));
#pragma unroll
                for (int j = 0; j < 4; ++j) { const float lo = bflo(v[j]), hi = bfhi(v[j]); s[2 * j] += lo; q[2 * j] += lo * lo; s[2 * j + 1] += hi; q[2 * j + 1] += hi * hi; } }
#pragma unroll
            for (int j = 0; j < 8; ++j) { s[j] += __shfl_xor(s[j], 16); s[j] += __shfl_xor(s[j], 32); q[j] += __shfl_xor(q[j], 16); q[j] += __shfl_xor(q[j], 32); }
            if (lane < 16) {
#pragma unroll
                for (int j = 0; j < 8; ++j) { PART[(wave * 128 + 8 * sg + j) * 2] = s[j]; PART[(wave * 128 + 8 * sg + j) * 2 + 1] = q[j]; } }
        }
        __syncthreads();
        if (tid < 128) { float s = 0.f, q = 0.f;
#pragma unroll
            for (int w = 0; w < 8; ++w) { s += PART[(w * 128 + tid) * 2]; q += PART[(w * 128 + tid) * 2 + 1]; }
            const float mean = s * (1.0f / 512.0f); float var = q * (1.0f / 512.0f) - mean * mean; var = var > 0.f ? var : 0.f;
            MU[tid] = mean; RS[tid] = 1.0f / sqrtf(var + EPS); }
        __syncthreads();
        {   float mu8[8], rs8[8];
#pragma unroll
            for (int j = 0; j < 8; ++j) { mu8[j] = MU[8 * sg + j]; rs8[j] = RS[8 * sg + j]; }
#pragma unroll 4
            for (int rr = 0; rr < 16; ++rr) { const int row = 16 * dg + rr; const float gd = a.in[5][row]; LAS u32x4* pp = (LAS u32x4*)(T + row * 256 + ((sg ^ rr) << 4)); const u32x4 v = *pp; u32x4 o;
#pragma unroll
                for (int j = 0; j < 4; ++j) o[j] = cvt_pk_bf16((bflo(v[j]) - mu8[2 * j]) * rs8[2 * j] * gd, (bfhi(v[j]) - mu8[2 * j + 1]) * rs8[2 * j + 1] * gd);
                *pp = o; }
        }
        __syncthreads();
        {   const int hh = wave >> 1, rh = wave & 1;
#pragma unroll 1
            for (int nh = 0; nh < 2; ++nh) {
                f32x4 acc[4][4];
#pragma unroll
                for (int m = 0; m < 4; ++m)
#pragma unroll
                    for (int n = 0; n < 4; ++n) acc[m][n] = (f32x4){0.f, 0.f, 0.f, 0.f};
#pragma unroll
                for (int ks = 0; ks < 4; ++ks) { bf16x8 Af[4];
#pragma unroll
                    for (int m = 0; m < 4; ++m) Af[m] = *(const bf16x8*)(WSB + (size_t)((hh * 128 + 64 * rh + 16 * m + fr) * 128 + 32 * ks + 8 * fq));
#pragma unroll
                    for (int n = 0; n < 4; ++n) { const bf16x8 Bf = *(const LAS bf16x8*)(T + (hh * 128 + 64 * nh + 16 * n + fr) * 256 + (((4 * ks + fq) ^ fr) << 4));
#pragma unroll
                        for (int m = 0; m < 4; ++m) acc[m][n] = __builtin_amdgcn_mfma_f32_16x16x32_bf16(Bf, Af[m], acc[m][n], 0, 0, 0); } }
#pragma unroll
                for (int m = 0; m < 4; ++m) { const int t = 64 * rh + 16 * m + fr; const size_t R = row0 + t; const float bias = a.in[7][hh * 128 + t];
#pragma unroll
                    for (int n = 0; n < 4; ++n) { const int d = hh * 128 + 64 * nh + 16 * n + 4 * fq; const u32x2 u4 = *(const u32x2*)(ZR + R * 2048 + d);
                        u32x2 o; o.x = cvt_pk_bf16(bflo(u4.x) * (acc[m][n][0] + bias), bfhi(u4.x) * (acc[m][n][1] + bias)); o.y = cvt_pk_bf16(bflo(u4.y) * (acc[m][n][2] + bias), bfhi(u4.y) * (acc[m][n][3] + bias));
                        *(u32x2*)(Y + R * 1024 + d) = o; } }
            }
        }
        __syncthreads();
    }
}

__device__ __forceinline__ void route_phase(const Args& a, int l, LAS unsigned char* lds, int G, int wave, int lane) {
    const bf16* X = (const bf16*)(a.ws + WS_XB); bf16* H = (bf16*)(a.ws + WS_H); float* RSTD = (float*)(a.ws + WS_RSTD);
    const bf16* WRT = (const bf16*)(a.ws + WS_WRT) + (size_t)l * 48 * 1024; const float* gvec = a.in[2] + l * 1024;
    const float* brg = a.in[20] + l * 4; const float* bre = a.in[22] + l * 32;
    unsigned* ECNT = (unsigned*)(a.ws + WS_CTL) + CW_ECNT + l * 2048; unsigned* PCNT = (unsigned*)(a.ws + WS_CTL) + CW_PCNT + l * 7168;
    unsigned* ELT = (unsigned*)(a.ws + WS_ELT); float* ELG = (float*)(a.ws + WS_ELG); unsigned* PLT = (unsigned*)(a.ws + WS_PLT);
    constexpr int WROW = 2064;
    LAS unsigned char* WL = lds; LAS float* GL = (LAS float*)(lds + 99072); LAS float* SCR = (LAS float*)(lds + 103168) + wave * 768;
    LAS int* TOK = (LAS int*)(lds + 127744);
    LAS int* HIST = (LAS int*)(lds + 135936);
    const int tid = threadIdx.x, fr = lane & 15, fq = lane >> 4;
    for (int tile = blockIdx.x; tile < M / 256; tile += G) {
        __syncthreads();
        for (int i = tid; i < 48 * 128; i += 512) { const int row = i >> 7, ch = i & 127; *(LAS u32x4*)(WL + row * WROW + ch * 16) = *(const u32x4*)(WRT + (size_t)row * 1024 + ch * 8); }
        if (tid < 256) *(LAS f32x4*)(GL + 4 * tid) = *(const f32x4*)(gvec + 4 * tid);
        if (tid < 288) HIST[tid] = 0;
        __syncthreads();
        for (int mt = 2 * wave; mt < 2 * wave + 2; ++mt) {
            const size_t row = (size_t)tile * 256 + 16 * mt + fr; const bf16* xr = X + row * D; bf16* hr = H + row * D;
            f32x4 acc[3]; acc[0] = acc[1] = acc[2] = (f32x4){0.f, 0.f, 0.f, 0.f}; float ss = 0.f;
#pragma unroll 1
            for (int kb = 0; kb < 4; ++kb) {
                u32x4 xv[8];
#pragma unroll
                for (int j = 0; j < 8; ++j) xv[j] = *(const u32x4*)(xr + 32 * (8 * kb + j) + 8 * fq);
#pragma unroll
                for (int j = 0; j < 8; ++j) { const int k0 = 32 * (8 * kb + j) + 8 * fq; const u32x4 xw = xv[j];
                    const f32x4 x0 = (f32x4){bflo(xw.x), bfhi(xw.x), bflo(xw.y), bfhi(xw.y)}, x1 = (f32x4){bflo(xw.z), bfhi(xw.z), bflo(xw.w), bfhi(xw.w)};
                    const f32x4 g0 = *(const LAS f32x4*)(GL + k0), g1 = *(const LAS f32x4*)(GL + k0 + 4);
                    ss += (x0.x * x0.x + x0.y * x0.y) + (x0.z * x0.z + x0.w * x0.w) + (x1.x * x1.x + x1.y * x1.y) + (x1.z * x1.z + x1.w * x1.w);
                    u32x4 hw; hw.x = cvt_pk_bf16(x0.x * g0.x, x0.y * g0.y); hw.y = cvt_pk_bf16(x0.z * g0.z, x0.w * g0.w); hw.z = cvt_pk_bf16(x1.x * g1.x, x1.y * g1.y); hw.w = cvt_pk_bf16(x1.z * g1.z, x1.w * g1.w);
                    *(u32x4*)(hr + k0) = hw; const bf16x8 Af = __builtin_bit_cast(bf16x8, hw);
#pragma unroll
                    for (int n = 0; n < 3; ++n) { const bf16x8 Bf = *(const LAS bf16x8*)(WL + (16 * n + fr) * WROW + k0 * 2); acc[n] = __builtin_amdgcn_mfma_f32_16x16x32_bf16(Bf, Af, acc[n], 0, 0, 0); } } }
            ss += __shfl_xor(ss, 16); ss += __shfl_xor(ss, 32);
            const float rstd = 1.0f / sqrtf(ss * (1.0f / D) + EPS);
            if (fq == 0) RSTD[row] = rstd;
#pragma unroll
            for (int n = 0; n < 3; ++n)
#pragma unroll
                for (int j = 0; j < 4; ++j) SCR[fr * 48 + 16 * n + 4 * fq + j] = acc[n][j] * rstd;
            LDS_WAIT(); asm volatile("" ::: "memory");
            if (lane < 16) { const LAS float* lg = SCR + lane * 48;
                float gl[4]; int gi = 0; float gm;
#pragma unroll
                for (int j = 0; j < 4; ++j) gl[j] = lg[32 + j] + brg[j];
                gm = gl[0];
#pragma unroll
                for (int j = 1; j < 4; ++j) if (gl[j] > gm) { gm = gl[j]; gi = j; }
                float den = 0.f;
#pragma unroll
                for (int j = 0; j < 4; ++j) den += __expf(gl[j] - gm);
                const float gp = 1.0f / den;
                float el[8];
#pragma unroll
                for (int j = 0; j < 8; ++j) el[j] = lg[8 * gi + j] + bre[8 * gi + j];
                int i1 = 0; float v1 = el[0];
#pragma unroll
                for (int j = 1; j < 8; ++j) if (el[j] > v1) { v1 = el[j]; i1 = j; }
                int i2 = -1; float v2 = -3.0e38f;
#pragma unroll
                for (int j = 0; j < 8; ++j) if (j != i1 && el[j] > v2) { v2 = el[j]; i2 = j; }
                const float e21 = __expf(v2 - v1), p1 = 1.0f / (1.0f + e21), p2 = e21 * p1;
                const int e1 = 8 * gi + i1, e2 = 8 * gi + i2; const int lo = i1 < i2 ? i1 : i2, hi = i1 < i2 ? i2 : i1;
                const int p = gi * 28 + (lo * (15 - lo)) / 2 + (hi - lo - 1);
                LAS int* tk = TOK + (16 * mt + lane) * 8;
                tk[0] = e1; tk[1] = e2; tk[2] = __float_as_int(gp * p1); tk[3] = __float_as_int(gp * p2);
                tk[4] = __hip_atomic_fetch_add(HIST + e1, 1, __ATOMIC_RELAXED, __HIP_MEMORY_SCOPE_WORKGROUP); tk[5] = __hip_atomic_fetch_add(HIST + e2, 1, __ATOMIC_RELAXED, __HIP_MEMORY_SCOPE_WORKGROUP); tk[6] = __hip_atomic_fetch_add(HIST + 32 + p, 1, __ATOMIC_RELAXED, __HIP_MEMORY_SCOPE_WORKGROUP); tk[7] = p; }
            LDS_WAIT(); asm volatile("" ::: "memory");
        }
        __syncthreads();
        if (tid < 32) { const int c = HIST[tid]; HIST[144 + tid] = c ? (int)__hip_atomic_fetch_add(ECNT + 64 * tid, (unsigned)c, __ATOMIC_RELAXED, __HIP_MEMORY_SCOPE_AGENT) : 0; }
        else if (tid < 144) { const int j = tid - 32; const int c = HIST[32 + j]; HIST[176 + j] = c ? (int)__hip_atomic_fetch_add(PCNT + 64 * j, (unsigned)c, __ATOMIC_RELAXED, __HIP_MEMORY_SCOPE_AGENT) : 0; }
        __syncthreads();
        if (tid < 256) { const LAS int* tk = TOK + tid * 8; const unsigned tok = (unsigned)(tile * 256 + tid);
            const int e1 = tk[0], e2 = tk[1]; const unsigned h1 = e1 < e2 ? 0u : 1u;
            const size_t s1 = (size_t)e1 * 65536 + HIST[144 + e1] + tk[4], s2 = (size_t)e2 * 65536 + HIST[144 + e2] + tk[5];
            ELT[s1] = tok | (h1 << 31); ELG[s1] = __int_as_float(tk[2]); ELT[s2] = tok | ((1u - h1) << 31); ELG[s2] = __int_as_float(tk[3]);
            PLT[(size_t)tk[7] * 65536 + HIST[176 + tk[7]] + tk[6]] = tok; }
    }
}
__device__ __forceinline__ void build_tables(LAS unsigned char* lds, unsigned* counters, int ng) {
    LAS int* pref = (LAS int*)(lds + TAB_OFF); LAS int* cnt = pref + 130;
    __syncthreads();
    if ((int)threadIdx.x < ng) cnt[threadIdx.x] = (int)__hip_atomic_load(counters + 64 * threadIdx.x, __ATOMIC_RELAXED, __HIP_MEMORY_SCOPE_AGENT);
    __syncthreads();
    if (threadIdx.x == 0) { int s = 0; for (int g = 0; g < ng; ++g) { pref[g] = s; s += (cnt[g] + 255) >> 8; } for (int g = ng; g < 130; ++g) pref[g] = s; }
    __syncthreads();
}

template <bool PASS2> __device__ __forceinline__ void scan_phase(const Args& a, LAS unsigned char* lds, int G, int wave, int lane) {
    const bf16* ZC = (const bf16*)(a.ws + WS_Z); bf16* Y = (bf16*)(a.ws + WS_Y); const bf16* WAX = (const bf16*)(a.ws + WS_WAX); float* CAR = (float*)(a.ws + WS_CAR);
    LAS unsigned char* RAW = lds;
    LAS unsigned char* AT = lds + 34816;
    LAS unsigned char* GT = lds + 67584;
    LAS float* CW = (LAS float*)(lds + 100352);
    const int tid = threadIdx.x, fr = lane & 15, fq = lane >> 4;
    const int cc = tid & 15, rq = tid >> 4;
    for (int unit = blockIdx.x; unit < 1024; unit += G) {
        const int hd = unit & 7, blk = (unit >> 3) & 15, b = unit >> 7;
        const size_t Rbase = (size_t)b * SEQ + blk * 512;
        const int ch = 128 * hd + 16 * wave + fr;
        bf16x8 Br[4], Bi[4];
#pragma unroll
        for (int ks = 0; ks < 4; ++ks) { Br[ks] = *(const bf16x8*)(WAX + (size_t)((hd * 256 + 16 * wave + fr) * 128 + 32 * ks + 8 * fq)); Bi[ks] = *(const bf16x8*)(WAX + (size_t)((hd * 256 + 128 + 16 * wave + fr) * 128 + 32 * ks + 8 * fq)); }
        const float ba = a.in[14][ch], bx = a.in[16][ch];
        const float kl = -8.0f * 1.44269504f * log1pf(__expf(-a.in[17][ch]));
        __syncthreads();
        if (tid < 128) { const int c = 128 * hd + tid;
#pragma unroll
            for (int k = 0; k < 4; ++k) CW[k * 128 + tid] = a.in[11][k * 1024 + c];
            CW[4 * 128 + tid] = a.in[12][c]; }
        float Hs = 0.f, Pa = 1.f;
        if (PASS2) { for (int j = 0; j < blk; ++j) { const f32x2 ab = *(const f32x2*)(CAR + ((size_t)(b * 16 + j) * 1024 + ch) * 2); Hs = ab.x * Hs + ab.y; } }
        u32x4 pr[5], pg[4];
#define SCAN_LOAD(sbn) do { const size_t R0n = Rbase + 128 * (sbn); \
            _Pragma("unroll") for (int p = 0; p < 5; ++p) { const int rr = p * 32 + rq; const int pos = blk * 512 + 128 * (sbn) - 3 + rr; pr[p] = (u32x4){0u, 0u, 0u, 0u}; \
                if (rr < 131 && pos >= 0) pr[p] = *(const u32x4*)(ZC + (R0n + rr - 3) * 2048 + 1024 + 128 * hd + 8 * cc); } \
            if (PASS2) { _Pragma("unroll") for (int p = 0; p < 4; ++p) pg[p] = *(const u32x4*)(ZC + (R0n + p * 32 + rq) * 2048 + 128 * hd + 8 * cc); } } while (0)
        SCAN_LOAD(0);
#pragma unroll 1
        for (int sb = 0; sb < 4; ++sb) {
            const size_t R0 = Rbase + 128 * sb;
#pragma unroll
            for (int p = 0; p < 5; ++p) { const int rr = p * 32 + rq; if (rr < 132) *(LAS u32x4*)(RAW + rr * 256 + cc * 16) = pr[p]; }
            if (PASS2) {
#pragma unroll
                for (int p = 0; p < 4; ++p) { const int row = p * 32 + rq; *(LAS u32x4*)(GT + row * 256 + ((cc ^ p) << 4)) = pg[p]; } }
            __syncthreads();
            if (sb < 3) SCAN_LOAD(sb + 1);
            {
                float cw[5][8];
#pragma unroll
                for (int k = 0; k < 5; ++k) { const f32x4 w0 = *(const LAS f32x4*)(CW + k * 128 + 8 * cc), w1 = *(const LAS f32x4*)(CW + k * 128 + 8 * cc + 4);
                    cw[k][0] = w0.x; cw[k][1] = w0.y; cw[k][2] = w0.z; cw[k][3] = w0.w; cw[k][4] = w1.x; cw[k][5] = w1.y; cw[k][6] = w1.z; cw[k][7] = w1.w; }
                float xw[7][8];
#pragma unroll
                for (int i = 0; i < 7; ++i) { const u32x4 v = *(const LAS u32x4*)(RAW + (4 * rq + i) * 256 + cc * 16);
#pragma unroll
                    for (int j = 0; j < 4; ++j) { xw[i][2 * j] = bflo(v[j]); xw[i][2 * j + 1] = bfhi(v[j]); } }
#pragma unroll
                for (int i = 0; i < 4; ++i) { const int t = 4 * rq + i; float o[8];
#pragma unroll
                    for (int j = 0; j < 8; ++j) o[j] = cw[4][j] + cw[0][j] * xw[i][j] + cw[1][j] * xw[i + 1][j] + cw[2][j] * xw[i + 2][j] + cw[3][j] * xw[i + 3][j];
                    u32x4 w; w.x = cvt_pk_bf16(o[0], o[1]); w.y = cvt_pk_bf16(o[2], o[3]); w.z = cvt_pk_bf16(o[4], o[5]); w.w = cvt_pk_bf16(o[6], o[7]);
                    const int key = (((t >> 5) & 3) << 2) | (t & 3);
                    *(LAS u32x4*)(AT + t * 256 + ((cc ^ key) << 4)) = w; }
            }
            __syncthreads();
            f32x4 ar[8], ai[8];
            const int arow = 32 * (fr >> 2) + (fr & 3);
#pragma unroll
            for (int m = 0; m < 8; ++m) { ar[m] = (f32x4){0.f, 0.f, 0.f, 0.f}; ai[m] = (f32x4){0.f, 0.f, 0.f, 0.f};
#pragma unroll
                for (int ks = 0; ks < 4; ++ks) { const bf16x8 Af = *(const LAS bf16x8*)(AT + (arow + 4 * m) * 256 + (((4 * ks + fq) ^ fr) << 4));
                    ar[m] = __builtin_amdgcn_mfma_f32_16x16x32_bf16(Af, Br[ks], ar[m], 0, 0, 0); ai[m] = __builtin_amdgcn_mfma_f32_16x16x32_bf16(Af, Bi[ks], ai[m], 0, 0, 0); } }
            float av[32], bv[32];
            const int cbase = 2 * wave + (fr >> 3);
#pragma unroll
            for (int m = 0; m < 8; ++m)
#pragma unroll
                for (int i = 0; i < 4; ++i) {
                    const float xr = bf1(*(const LAS unsigned short*)(AT + (32 * fq + 4 * m + i) * 256 + ((cbase ^ ((fq << 2) | i)) << 4) + (fr & 7) * 2));
                    const float r = sigmoidf_(ar[m][i] + ba), ig = sigmoidf_(ai[m][i] + bx);
                    const float aa = __builtin_amdgcn_exp2f(r * kl); float om = 1.0f - aa * aa; om = om > 0.f ? om : 0.f;
                    av[4 * m + i] = aa; bv[4 * m + i] = __builtin_amdgcn_sqrtf(om) * ig * xr; }
            float As = 1.f, Bs = 0.f;
#pragma unroll
            for (int j = 0; j < 32; ++j) { Bs = av[j] * Bs + bv[j]; As *= av[j]; }
            float A1 = As, B1 = Bs;
            { const float Ap = __shfl_up(As, 16), Bp = __shfl_up(Bs, 16); if (fq >= 1) { A1 = Ap * As; B1 = As * Bp + Bs; } }
            float A2 = A1, B2 = B1;
            { const float Ap = __shfl_up(A1, 32), Bp = __shfl_up(B1, 32); if (fq >= 2) { A2 = Ap * A1; B2 = A1 * Bp + B1; } }
            if (PASS2) {
                float Ae = __shfl_up(A2, 16), Be = __shfl_up(B2, 16); if (fq == 0) { Ae = 1.f; Be = 0.f; }
                float h = Ae * Hs + Be;
                LAS unsigned short* gp = (LAS unsigned short*)(GT + (32 * fq) * 256 + ((cbase ^ fq) << 4) + (fr & 7) * 2);
#pragma unroll
                for (int j = 0; j < 32; ++j) { h = av[j] * h + bv[j]; const float gate = bf1(gp[j * 128]); gp[j * 128] = (unsigned short)(cvt_pk_bf16(gate * h, 0.f) & 0xffffu); }
            }
            const float At_ = __shfl(A2, fr + 48), Bt_ = __shfl(B2, fr + 48);
            Hs = At_ * Hs + Bt_; Pa *= At_;
            __syncthreads();
            if (PASS2) {
#pragma unroll
                for (int p = 0; p < 4; ++p) { const int row = p * 32 + rq; *(u32x4*)(Y + (R0 + row) * 1024 + 128 * hd + 8 * cc) = *(const LAS u32x4*)(GT + row * 256 + ((cc ^ p) << 4)); }
                __syncthreads();
            }
        }
#undef SCAN_LOAD
        if (!PASS2 && fq == 0) *(f32x2*)(CAR + ((size_t)(b * 16 + blk) * 1024 + ch) * 2) = (f32x2){Pa, Hs};
    }
}

__global__ void __launch_bounds__(512, 2) fwd(Args args) {
    extern __shared__ __attribute__((aligned(16))) unsigned char lds_raw[];
    LAS unsigned char* lds = (LAS unsigned char*)lds_raw;
    volatile LAS unsigned* MISC = (volatile LAS unsigned*)(lds + MISC_OFF);
    const int tid = threadIdx.x, lane = tid & 63, wave = __builtin_amdgcn_readfirstlane(tid >> 6), G = gridDim.x;
    const int vcu = (G % 8 == 0) ? (int)(blockIdx.x % 8) * (G / 8) + (int)(blockIdx.x / 8) : (int)blockIdx.x;
    unsigned char* ws = args.ws;
    if (tid < 64) MISC[tid] = 0u;
    __syncthreads();
    XcdBarrier bar = xcd_barrier_post((unsigned*)(ws + WS_CTL) + CW_BAR + args.li * XCD_BAR_WORDS, MISC + 8);
    const int lo = args.ph_lo, hi = args.ph_hi;
#define IN(k) (ph_on(k) && lo <= (k) && (k) < hi)
#ifndef PROBE_NOSTORE
#define PROBE_NOSTORE 0
#endif
#define RUN(k, ...) do { if (IN(k)) { const int ST_ON = 1; __VA_ARGS__ } if (IN(k) && ((REP_MASK >> (k)) & 1)) { const int ST_ON = PROBE_NOSTORE ? args.pad : 1; __VA_ARGS__ } } while (0)
#define SEAM(k) do { if (IN(k) && hi > (k) + 1) xcd_barrier(bar); } while (0)
    bf16* H = (bf16*)(ws + WS_H); float* RSTD = (float*)(ws + WS_RSTD); bf16* Z = (bf16*)(ws + WS_Z); bf16* Yb = (bf16*)(ws + WS_Y); bf16* XB = (bf16*)(ws + WS_XB);

    RUN(0, p0_prologue(args, lds, G, wave, lane););
    SEAM(0);
    RUN(1,
        { pg8::DenseOrder S; S.init(M, 2048, G, (int)blockIdx.x, H, 1024, ws + WS_WREST, 1024, 16);
          pg8::EpiZ<false> E{Z, 2048, RSTD, 2, ST_ON}; pg8::gemm_phase<pg8::EpiZ<false>, pg8::DenseOrder, false>(lds, 1024, 1024, 1024, 16, S, E); }
        { pg8::DenseOrder S; S.init(512, M, G, (int)blockIdx.x, ws + WS_WV, 1024, H, 1024, 16);
          pg8::EpiZ<true> E{(bf16*)(ws + WS_VT), M, RSTD, 1 << 30, ST_ON}; pg8::gemm_phase<pg8::EpiZ<true>, pg8::DenseOrder, false>(lds, 1024, 1024, 1024, 16, S, E); }
    );
    SEAM(1);
    RUN(2, p2_spatial(args, lds, G, wave, lane););
    SEAM(2);
    RUN(3, pg8::DenseOrder S; S.init(M, 1024, G, (int)blockIdx.x, Yb, 1024, ws + WS_WO, 1024, 16);
        pg8::EpiRes<true> E{args.in[0], XB}; pg8::gemm_phase<pg8::EpiRes<true>, pg8::DenseOrder, false>(lds, 1024, 1024, 1024, 16, S, E););
    SEAM(3);
#define MOE_LAYER(l, pb) do { \
        if (IN(pb)) route_phase(args, l, lds, G, wave, lane); \
        SEAM(pb); \
        RUN((pb) + 1, \
            build_tables(lds, (unsigned*)(ws + WS_CTL) + CW_ECNT + (l) * 2048, NE); \
            pg8::GroupOrder<false> S; S.pref = (const LAS int*)(lds + TAB_OFF); S.ng = NE; S.G = G; S.c = vcu; S.lane = lane; \
            S.A = (const char*)H; S.W = (const char*)(ws + WS_WGU) + (size_t)(l) * 32 * 1024 * 1024 * 2; S.lists = (const unsigned*)(ws + WS_ELT); S.glists = (const float*)(ws + WS_ELG); \
            pg8::EpiG1 E{Z, RSTD}; pg8::gemm_phase<pg8::EpiG1, pg8::GroupOrder<false>, true>(lds, 1024, 1024, 1024, 16, S, E); \
        ); \
        SEAM((pb) + 1); \
        if (IN((pb) + 2)) { \
            build_tables(lds, (unsigned*)(ws + WS_CTL) + CW_PCNT + (l) * 7168, NPAIR); \
            pg8::GroupOrder<true> S; S.pref = (const LAS int*)(lds + TAB_OFF); S.ng = NPAIR; S.G = G; S.c = vcu; S.lane = lane; \
            S.A = (const char*)Z; S.W = (const char*)(ws + WS_WD) + (size_t)(l) * 32 * 1024 * 512 * 2; S.lists = (const unsigned*)(ws + WS_PLT); S.glists = nullptr; \
            pg8::EpiG2 E{XB}; pg8::gemm_phase<pg8::EpiG2, pg8::GroupOrder<true>, true>(lds, 1024, 512, 1024, 8, S, E); \
        } \
        SEAM((pb) + 2); } while (0)
    MOE_LAYER(0, 4);
    RUN(7, norm_phase(XB, args.in[1] + 1024, H, RSTD, G, wave, lane););
    SEAM(7);
    RUN(8, pg8::DenseOrder S; S.init(M, 2048, G, (int)blockIdx.x, H, 1024, ws + WS_WC, 1024, 16);
        pg8::EpiZ<false> E{Z, 2048, RSTD, 4, ST_ON}; pg8::gemm_phase<pg8::EpiZ<false>, pg8::DenseOrder, false>(lds, 1024, 1024, 1024, 16, S, E););
    SEAM(8);
    RUN(9, scan_phase<false>(args, lds, G, wave, lane););
    SEAM(9);
    RUN(10, scan_phase<true>(args, lds, G, wave, lane););
    SEAM(10);
    if (IN(11)) { pg8::DenseOrder S; S.init(M, 1024, G, (int)blockIdx.x, Yb, 1024, ws + WS_WCO, 1024, 16);
        pg8::EpiRes<false> E{XB, XB}; pg8::gemm_phase<pg8::EpiRes<false>, pg8::DenseOrder, false>(lds, 1024, 1024, 1024, 16, S, E); }
    SEAM(11);
    MOE_LAYER(1, 12);
#undef MOE_LAYER
    if (IN(15)) final_norm_phase(XB, args.out, args.in[3], G, wave, lane);
#undef IN
#undef SEAM
}

extern "C" void kernel_launch(void* const* d_in, const int* in_sizes, int n_in, void* d_out, int out_size, void* d_ws, size_t ws_size, hipStream_t stream) {
    static int grid = 0;
    if (grid == 0) {
        if (n_in != 26 || in_sizes[0] != M * D || out_size != M * D || ws_size < WS_END) { fprintf(stderr, "kernel_launch: unexpected shapes (n_in %d, in0 %d, out %d, ws %zu < %zu); nothing launched\n", n_in, n_in > 0 ? in_sizes[0] : -1, out_size, ws_size, (size_t)WS_END); grid = -1; return; }
        int dev = 0, cus = 0, per_cu = 0;
        if (hipGetDevice(&dev) != hipSuccess || hipDeviceGetAttribute(&cus, hipDeviceAttributeMultiprocessorCount, dev) != hipSuccess) { grid = -1; return; }
        if (hipFuncSetAttribute((const void*)fwd, hipFuncAttributeMaxDynamicSharedMemorySize, LDS_BYTES) != hipSuccess) { fprintf(stderr, "kernel_launch: hipFuncSetAttribute failed\n"); grid = -1; return; }
        if (hipOccupancyMaxActiveBlocksPerMultiprocessor(&per_cu, (const void*)fwd, 512, LDS_BYTES) != hipSuccess || per_cu < 1) fprintf(stderr, "kernel_launch: occupancy query reports %d workgroups per CU\n", per_cu);
        (void)hipGetLastError();
        grid = cus;
    }
    if (grid < 0) return;
    if (hipMemsetAsync((char*)d_ws + WS_CTL, 0, CTL_ZERO_BYTES, stream) != hipSuccess) return;
    Args a{};
    for (int i = 0; i < 26; ++i) a.in[i] = (const float*)d_in[i];
    a.out = (float*)d_out; a.ws = (unsigned char*)d_ws; a.pad = 0;
#if MK_CUTS
    int li = 0;
    for (int k = 0; k < NPH; ++k) { if (!ph_on(k)) continue;
        a.ph_lo = k; a.ph_hi = k + 1; a.li = li++; hipLaunchKernelGGL(fwd, dim3(grid), dim3(512), LDS_BYTES, stream, a); }
#else
    a.ph_lo = 0; a.ph_hi = NPH; a.li = 0;
    hipLaunchKernelGGL(fwd, dim3(grid), dim3(512), LDS_BYTES, stream, a);
#endif
    const hipError_t le = hipPeekAtLastError();
    if (le != hipSuccess) fprintf(stderr, "kernel_launch: launch failed: %s\n", hipGetErrorName(le));
}
```

```cpp
#include <hip/hip_runtime.h>
#include <cstdio>
#include <cstdint>

#ifndef DBG_STOP
#define DBG_STOP 4
#endif
#ifndef REP_MASK
#define REP_MASK 0
#endif
#ifndef MK_CUTS
#define MK_CUTS 0
#endif

#define LAS __attribute__((address_space(3)))
#define GAS __attribute__((address_space(1)))
typedef unsigned short bf16;
typedef short bf16x8 __attribute__((ext_vector_type(8)));
typedef float f32x4 __attribute__((ext_vector_type(4)));
typedef float f32x2 __attribute__((ext_vector_type(2)));
typedef unsigned u32x4 __attribute__((ext_vector_type(4)));
typedef unsigned u32x2 __attribute__((ext_vector_type(2)));

constexpr int D = 1024, NBATCH = 8, SEQ = 8192, M = NBATCH * SEQ;
constexpr int NE = 32, DE = 512, NPAIR = 112;
constexpr float EPS = 1e-6f;
constexpr int NPH = 16;
constexpr int HP = 1088;
#ifdef ONLY_PH
__host__ __device__ constexpr bool ph_on(int k) { return ((ONLY_PH >> k) & 1) != 0; }
#else
__host__ __device__ constexpr bool ph_on(int k) { return (k <= 3) || (k >= 4 && k <= 6 && DBG_STOP >= 2) || (k >= 7 && k <= 11 && DBG_STOP >= 3) || (k >= 12 && k <= 14 && DBG_STOP >= 4) || k == 15; }
#endif

constexpr size_t MiB = 1u << 20;
constexpr size_t WS_CTL = 0, CTL_ZERO_BYTES = 1 * MiB;
constexpr size_t WS_WSB = 1 * MiB;
constexpr size_t WS_WAX = 1 * MiB + 256 * 1024;
constexpr size_t WS_WRT = 2 * MiB;
constexpr size_t WS_RSTD = 3 * MiB;
constexpr size_t WS_CAR = 4 * MiB;
constexpr size_t WS_ELT = 8 * MiB;
constexpr size_t WS_ELG = 16 * MiB;
constexpr size_t WS_PLT = 24 * MiB;
constexpr size_t WS_WREST = 52 * MiB;
constexpr size_t WS_WV = 56 * MiB;
constexpr size_t WS_WO = 57 * MiB;
constexpr size_t WS_WC = 59 * MiB;
constexpr size_t WS_WCO = 63 * MiB;
constexpr size_t WS_WGU = 65 * MiB;
constexpr size_t WS_WD = 193 * MiB;
constexpr size_t WS_H = 257 * MiB;
constexpr size_t WS_Z = 393 * MiB;
constexpr size_t WS_VT = 649 * MiB;
constexpr size_t WS_Y = 713 * MiB;
constexpr size_t WS_XB = 841 * MiB;
constexpr size_t WS_END = 969 * MiB;
constexpr int CW_TMO = 0;
constexpr int CW_ECNT = 8192;
constexpr int CW_PCNT = 12288;
constexpr int CW_BAR = 32768;
constexpr int LDS_BYTES = 147456;
constexpr int TAB_OFF = 131072;
constexpr int MISC_OFF = LDS_BYTES - 256;

__device__ __forceinline__ float bflo(unsigned w) { return __uint_as_float(w << 16); }
__device__ __forceinline__ float bfhi(unsigned w) { return __uint_as_float(w & 0xffff0000u); }
__device__ __forceinline__ float bf1(unsigned short b) { return __uint_as_float(((unsigned)b) << 16); }
__device__ __forceinline__ unsigned cvt_pk_bf16(float lo, float hi) { unsigned r; asm volatile("v_cvt_pk_bf16_f32 %0, %1, %2" : "=v"(r) : "v"(lo), "v"(hi)); return r; }
__device__ __forceinline__ float wave_sum(float v) {
#pragma unroll
    for (int o = 1; o < 64; o <<= 1) v += __shfl_xor(v, o);
    return v;
}
__device__ __forceinline__ float sigmoidf_(float x) { return __builtin_amdgcn_rcpf(1.0f + __builtin_amdgcn_exp2f(-1.44269504f * x)); }
__device__ __forceinline__ float gelu_tanh(float x) { const float z = x * (1.0f + 0.044715f * x * x); return x * __builtin_amdgcn_rcpf(1.0f + __builtin_amdgcn_exp2f(-2.3022082f * z)); }
#define LDS_WAIT() asm volatile("s_waitcnt lgkmcnt(0)" ::: "memory")
#define VM_WAIT() asm volatile("s_waitcnt vmcnt(0)" ::: "memory")

namespace pg8 {
constexpr int BM = 256, BK = 64, HALF = 128, HTB = HALF * BK * 2, STAGE_BYTES = 8 * HTB, NXCD = 8, WGM = 8;
__host__ __device__ __forceinline__ int lds_byte(int r, int c) { const int st = (r >> 4) * 2 + (c >> 5), rr = r & 15, cc = c & 31, ob = rr * 64 + cc * 2; return st * 1024 + (ob ^ (((ob >> 9) & 1) << 5)); }
__host__ __device__ __forceinline__ void stage_rc(int b, int& R, int& C) { const int st = b / 1024, sb = b % 1024, swz = sb ^ (((sb >> 9) & 1) << 5); R = (st >> 1) * 16 + swz / 64; C = (st & 1) * 32 + (swz % 64) / 2; }
__host__ __device__ __forceinline__ int perm32(int rho) { const int n = rho >> 4, i = rho & 15; return 8 * (i >> 2) + 4 * n + (i & 3); }

struct Unit { int pm, pn; const char* A; const char* B0; const char* B1; const unsigned* list; const float* glist; int nvalid; };

template <class Epi, class Sched, bool GATHER>
__device__ __forceinline__ void gemm_phase(LAS unsigned char* lds, const int lda, const int ldb, const int K, const int nth, const Sched& S, const Epi& E) {
    const int tid = threadIdx.x, wid = __builtin_amdgcn_readfirstlane(tid >> 6), lane = tid & 63, wr = wid >> 2, wc = wid & 3, fr = lane & 15, fq = lane >> 4;
    const int nt = K / BK;
    int Rr[2], Cc[2]; unsigned voffB[2];
#pragma unroll
    for (int i = 0; i < 2; ++i) { int R, C; stage_rc(tid * 16 + i * 8192, R, C); Rr[i] = R; Cc[i] = C; const int Rb = Epi::PERM ? ((R & ~31) + perm32(R & 31)) : R; voffB[i] = (unsigned)(Rb * ldb + C) * 2u; }
    const size_t kstep = (size_t)(BK * 2);
    const size_t hstepB = (size_t)HALF * ldb * 2;
    const unsigned ldsw = (unsigned)wid * 1024u;
    const int aoff = lds_byte(wr * 64 + fr, fq * 8), boff = lds_byte(wc * 32 + fr, fq * 8);
#define PG8_SA(b, h) (((b) * 2 + (h)) * HTB)
#define PG8_SB(b, h) ((4 + (b) * 2 + (h)) * HTB)
#define PG8_STAGE(bufoff, gbase, voff) do { _Pragma("unroll") for (int _i = 0; _i < 2; ++_i) \
        __builtin_amdgcn_global_load_lds((const unsigned*)((const char*)(gbase) + (voff)[_i]), (LAS unsigned*)(lds + (bufoff) + ldsw + _i * 8192), 16, 0, 0); } while (0)
#define PG8_LDA(dst, b, h) do { _Pragma("unroll") for (int m = 0; m < 4; ++m) _Pragma("unroll") for (int k = 0; k < 2; ++k) dst[m][k] = *(const LAS bf16x8*)(lds + PG8_SA(b, h) + aoff + m * 2048 + k * 1024); } while (0)
#define PG8_LDB(dst, b, h) do { _Pragma("unroll") for (int n = 0; n < 2; ++n) _Pragma("unroll") for (int k = 0; k < 2; ++k) dst[n][k] = *(const LAS bf16x8*)(lds + PG8_SB(b, h) + boff + n * 2048 + k * 1024); } while (0)
#define PG8_MMA(ai, bj, At, Bt) do { __builtin_amdgcn_s_setprio(1); _Pragma("unroll") for (int m = 0; m < 4; ++m) _Pragma("unroll") for (int n = 0; n < 2; ++n) _Pragma("unroll") for (int k = 0; k < 2; ++k) \
        acc[ai][bj][m][n] = __builtin_amdgcn_mfma_f32_16x16x32_bf16(Bt[n][k], At[m][k], acc[ai][bj][m][n], 0, 0, 0); __builtin_amdgcn_s_setprio(0); } while (0)
#define PG8_WAIT_V(n) asm volatile("s_waitcnt vmcnt(" #n ")" ::: "memory")
#define PG8_WAIT_L(n) asm volatile("s_waitcnt lgkmcnt(" #n ")" ::: "memory")
#define PG8_BAR __builtin_amdgcn_s_barrier()
#define PG8_SCHED __builtin_amdgcn_sched_barrier(0)
    Unit cur, nxt; int ui = 0;
    if (!S.next(0, cur)) return;
    unsigned offc[2][2], offn[2][2], nid[2][2];
#pragma unroll
    for (int h = 0; h < 2; ++h)
#pragma unroll
        for (int i = 0; i < 2; ++i) {
            const int r = Rr[i] + HALF * h;
            if constexpr (GATHER) { const unsigned ent = r < cur.nvalid ? cur.list[r] : 0u; offc[h][i] = (ent & 0x7fffffffu) * (unsigned)(lda * 2) + (unsigned)(Cc[i] * 2); }
            else offc[h][i] = (unsigned)(r * lda + Cc[i]) * 2u;
            offn[h][i] = offc[h][i]; nid[h][i] = 0u;
        }
    f32x4 acc[2][2][4][2];
#pragma unroll
    for (int a = 0; a < 2; ++a)
#pragma unroll
        for (int b = 0; b < 2; ++b)
#pragma unroll
            for (int m = 0; m < 4; ++m)
#pragma unroll
                for (int n = 0; n < 2; ++n) acc[a][b][m][n] = (f32x4){0.f, 0.f, 0.f, 0.f};
    bf16x8 At[4][2], B0[2][2], B1[2][2];
    const char* cA = cur.A; const char* cB0 = cur.B0; const char* cB1 = cur.B1;
    PG8_STAGE(PG8_SB(0, 0), cB0, voffB); PG8_STAGE(PG8_SB(0, 1), cB0 + hstepB, voffB); PG8_STAGE(PG8_SA(0, 0), cA, offc[0]); PG8_STAGE(PG8_SA(0, 1), cA, offc[1]);
    if (wr == 1) PG8_BAR;
    PG8_WAIT_V(2); PG8_BAR;
    PG8_STAGE(PG8_SB(1, 0), cB0 + kstep, voffB); PG8_STAGE(PG8_SA(1, 0), cA + kstep, offc[0]); PG8_STAGE(PG8_SB(1, 1), cB0 + hstepB + kstep, voffB);
    PG8_WAIT_V(6); PG8_BAR;
    for (;;) {
        const bool has_next = S.next(ui + 1, nxt);
        if constexpr (GATHER) {
            if (has_next) {
#pragma unroll
                for (int h = 0; h < 2; ++h)
#pragma unroll
                    for (int i = 0; i < 2; ++i) { const int r = Rr[i] + HALF * h; nid[h][i] = r < nxt.nvalid ? nxt.list[r] : 0u; }
            }
        }
        const char* nA = has_next ? nxt.A : cA; const char* nB0 = has_next ? nxt.B0 : cB0;
        for (int t = 0; t < nt; t += 2) {
            const bool last = (t == nt - 2);
            const char* a1 = cA + (size_t)(t + 1) * kstep;
            const char* a2 = last ? nA : cA + (size_t)(t + 2) * kstep;
            const char* b2 = last ? nB0 : ((t + 2 < nth) ? cB0 + (size_t)(t + 2) * kstep : cB1 + (size_t)(t + 2 - nth) * kstep);
            const char* a3 = a2 + kstep; const char* b3 = b2 + kstep;
            unsigned o2[2][2];
            if constexpr (GATHER) {
                if (last && has_next) {
#pragma unroll
                    for (int h = 0; h < 2; ++h)
#pragma unroll
                        for (int i = 0; i < 2; ++i) offn[h][i] = (nid[h][i] & 0x7fffffffu) * (unsigned)(lda * 2) + (unsigned)(Cc[i] * 2);
                }
#pragma unroll
                for (int h = 0; h < 2; ++h)
#pragma unroll
                    for (int i = 0; i < 2; ++i) o2[h][i] = (last && has_next) ? offn[h][i] : offc[h][i];
            } else {
#pragma unroll
                for (int h = 0; h < 2; ++h)
#pragma unroll
                    for (int i = 0; i < 2; ++i) o2[h][i] = offc[h][i];
            }
            PG8_LDB(B0, 0, 0); PG8_LDB(B1, 0, 1); PG8_SCHED; PG8_LDA(At, 0, 0); PG8_STAGE(PG8_SA(1, 1), a1, offc[1]);
            PG8_WAIT_V(8); PG8_WAIT_L(0); PG8_BAR; PG8_MMA(0, 0, At, B0); PG8_MMA(0, 1, At, B1); PG8_BAR; PG8_SCHED;
            PG8_LDA(At, 0, 1); PG8_STAGE(PG8_SB(0, 0), b2, voffB); PG8_STAGE(PG8_SB(0, 1), b2 + hstepB, voffB); PG8_STAGE(PG8_SA(0, 0), a2, o2[0]);
            PG8_WAIT_V(8); PG8_WAIT_L(0); PG8_BAR; PG8_MMA(1, 0, At, B0); PG8_MMA(1, 1, At, B1); PG8_BAR; PG8_SCHED;
            PG8_LDB(B0, 1, 0); PG8_LDB(B1, 1, 1); PG8_SCHED; PG8_LDA(At, 1, 0); PG8_STAGE(PG8_SA(0, 1), a2, o2[1]);
            PG8_WAIT_V(8); PG8_WAIT_L(0); PG8_BAR; PG8_MMA(0, 0, At, B0); PG8_MMA(0, 1, At, B1); PG8_BAR; PG8_SCHED;
            PG8_LDA(At, 1, 1); PG8_STAGE(PG8_SB(1, 0), b3, voffB); PG8_STAGE(PG8_SB(1, 1), b3 + hstepB, voffB); PG8_STAGE(PG8_SA(1, 0), a3, o2[0]);
            PG8_WAIT_V(8); PG8_WAIT_L(0); PG8_BAR; PG8_MMA(1, 0, At, B0); PG8_MMA(1, 1, At, B1); PG8_BAR; PG8_SCHED;
        }
        if (wr == 0) PG8_BAR;
        E(acc, cur, wr, wc, fr, fq);
        if (!has_next) break;
#pragma unroll
        for (int a = 0; a < 2; ++a)
#pragma unroll
            for (int b = 0; b < 2; ++b)
#pragma unroll
                for (int m = 0; m < 4; ++m)
#pragma unroll
                    for (int n = 0; n < 2; ++n) acc[a][b][m][n] = (f32x4){0.f, 0.f, 0.f, 0.f};
        cur = nxt; cA = nA; cB0 = nB0; cB1 = nxt.B1; ++ui;
        if constexpr (GATHER) {
#pragma unroll
            for (int h = 0; h < 2; ++h)
#pragma unroll
                for (int i = 0; i < 2; ++i) offc[h][i] = offn[h][i];
        }
        if (wr == 1) PG8_BAR;
    }
    PG8_WAIT_V(0);
    PG8_BAR;
#undef PG8_SA
#undef PG8_SB
#undef PG8_STAGE
#undef PG8_LDA
#undef PG8_LDB
#undef PG8_MMA
#undef PG8_WAIT_V
#undef PG8_WAIT_L
#undef PG8_BAR
#undef PG8_SCHED
}

struct DenseOrder {
    int nM, nN, nwg, G, c; const char* A; const char* B; size_t tA, tB, b1off;
    __device__ __forceinline__ void init(int Mr, int N, int G_, int c_, const void* A_, int lda, const void* B_, int ldb, int nth) {
        nM = Mr / BM; nN = N / BM; nwg = nM * nN; G = G_; c = c_; A = (const char*)A_; B = (const char*)B_; tA = (size_t)BM * lda * 2; tB = (size_t)BM * ldb * 2; b1off = (size_t)nth * BK * 2; }
    __device__ __forceinline__ bool next(int i, Unit& u) const {
        const long L = (long)i * G + c; if (L >= nwg) return false;
        int wgid = (int)L; { const int q = nwg / NXCD, r = nwg % NXCD, xcd = wgid % NXCD, off = wgid / NXCD; wgid = (xcd < r ? xcd * (q + 1) : r * (q + 1) + (xcd - r) * q) + off; }
        const int nig = WGM * nN, gid = wgid / nig, fm = gid * WGM, gsz = (nM - fm) < WGM ? (nM - fm) : WGM;
        u.pm = fm + ((wgid % nig) % gsz); u.pn = (wgid % nig) / gsz;
        u.A = A + (size_t)u.pm * tA; u.B0 = B + (size_t)u.pn * tB; u.B1 = u.B0 + b1off; u.list = nullptr; u.glist = nullptr; u.nvalid = BM; return true;
    }
};
__device__ __forceinline__ int find_group(const LAS int* pref, int n, int rt, int lane) {
    const int j0 = lane, j1 = lane + 64;
    const bool f0 = j0 < n && pref[j0] <= rt && rt < pref[j0 + 1];
    const bool f1 = j1 < n && pref[j1] <= rt && rt < pref[j1 + 1];
    const unsigned long long m0 = __ballot(f0), m1 = __ballot(f1);
    return m0 ? (int)__builtin_ctzll(m0) : 64 + (int)__builtin_ctzll(m1 | (1ull << 63));
}
template <bool PAIR> struct GroupOrder {
    static constexpr size_t WSTRIDE = PAIR ? (size_t)1024 * 512 * 2 : (size_t)1024 * 1024 * 2, TB = PAIR ? (size_t)256 * 512 * 2 : (size_t)256 * 1024 * 2;
    const LAS int* pref; int ng, G, c, lane;
    const char* A; const char* W; const unsigned* lists; const float* glists;
    __device__ __forceinline__ bool next(int i, Unit& u) const {
        const LAS int* cnt = pref + 130;
        const long L = (long)i * G + c; const int total = __builtin_amdgcn_readfirstlane(pref[ng]);
        if (L >= 4L * total) return false;
        const int rt = (int)(L >> 2); u.pn = (int)(L & 3);
        const int g = __builtin_amdgcn_readfirstlane(find_group(pref, ng, rt, lane));
        const int tr = rt - __builtin_amdgcn_readfirstlane(pref[g]); const int cg = __builtin_amdgcn_readfirstlane(cnt[g]);
        u.pm = tr; u.nvalid = (cg - tr * BM) < BM ? (cg - tr * BM) : BM;
        u.list = lists + (size_t)g * 65536 + (size_t)tr * BM; u.glist = PAIR ? nullptr : glists + (size_t)g * 65536 + (size_t)tr * BM;
        u.A = A;
        if (PAIR) { const int grp = g / 28; int pi = g % 28, lo = 0; while (pi >= 7 - lo) { pi -= 7 - lo; ++lo; } const int hi = lo + 1 + pi;
            u.B0 = W + (size_t)(grp * 8 + lo) * WSTRIDE + (size_t)u.pn * TB; u.B1 = W + (size_t)(grp * 8 + hi) * WSTRIDE + (size_t)u.pn * TB; }
        else { u.B0 = W + (size_t)g * WSTRIDE + (size_t)u.pn * TB; u.B1 = u.B0; }
        return true;
    }
};

template <bool SCALE_COL> struct EpiZ {
    static constexpr bool PERM = true;
    bf16* O; int ldc; const float* rstd; int gelu_lt; int st_on;
    __device__ __forceinline__ void operator()(const f32x4 (&acc)[2][2][4][2], const Unit& u, int wr, int wc, int fr, int fq) const {
        if (!st_on) return;
        const int row0 = u.pm * BM + wr * 64 + fr, col0 = u.pn * BM + wc * 32 + 8 * fq; const bool act = u.pn < gelu_lt;
        f32x4 cs[2][2];
#pragma unroll
        for (int bj = 0; bj < 2; ++bj)
#pragma unroll
            for (int n = 0; n < 2; ++n) cs[bj][n] = SCALE_COL ? *(const f32x4*)(rstd + col0 + bj * HALF + 4 * n) : (f32x4){1.f, 1.f, 1.f, 1.f};
#pragma unroll
        for (int ai = 0; ai < 2; ++ai)
#pragma unroll
            for (int m = 0; m < 4; ++m) { const int r = row0 + ai * HALF + m * 16; const float rs = SCALE_COL ? 1.0f : rstd[r]; bf16* rowp = O + (size_t)r * ldc + col0;
#pragma unroll
                for (int bj = 0; bj < 2; ++bj) { f32x4 v0 = acc[ai][bj][m][0] * cs[bj][0] * rs, v1 = acc[ai][bj][m][1] * cs[bj][1] * rs;
                    if (act) {
#pragma unroll
                        for (int j = 0; j < 4; ++j) { v0[j] = gelu_tanh(v0[j]); v1[j] = gelu_tanh(v1[j]); } }
                    u32x4 w; w.x = cvt_pk_bf16(v0[0], v0[1]); w.y = cvt_pk_bf16(v0[2], v0[3]); w.z = cvt_pk_bf16(v1[0], v1[1]); w.w = cvt_pk_bf16(v1[2], v1[3]);
                    if (st_on) *(u32x4*)(rowp + bj * HALF) = w; } }
    }
};
template <bool BASE_F32> struct EpiRes {
    static constexpr bool PERM = true;
    const void* __restrict__ base; bf16* __restrict__ out;
    __device__ __forceinline__ void operator()(f32x4 (&acc)[2][2][4][2], const Unit& u, int wr, int wc, int fr, int fq) const {
        const int row0 = u.pm * BM + wr * 64 + fr, col0 = u.pn * BM + wc * 32 + 8 * fq;
#pragma unroll
        for (int ai = 0; ai < 2; ++ai)
#pragma unroll
            for (int m = 0; m < 4; ++m) { const size_t off = (size_t)(row0 + ai * HALF + m * 16) * 1024 + col0;
#pragma unroll
                for (int bj = 0; bj < 2; ++bj) {
                    if (BASE_F32) { const float* bp = (const float*)base + off + bj * HALF; acc[ai][bj][m][0] += *(const f32x4*)bp; acc[ai][bj][m][1] += *(const f32x4*)(bp + 4); }
                    else { const u32x4 w = *(const u32x4*)((const bf16*)base + off + bj * HALF);
                        acc[ai][bj][m][0] += (f32x4){bflo(w.x), bfhi(w.x), bflo(w.y), bfhi(w.y)}; acc[ai][bj][m][1] += (f32x4){bflo(w.z), bfhi(w.z), bflo(w.w), bfhi(w.w)}; } } }
        asm volatile("" ::: "memory");
#pragma unroll
        for (int ai = 0; ai < 2; ++ai)
#pragma unroll
            for (int m = 0; m < 4; ++m) { const size_t off = (size_t)(row0 + ai * HALF + m * 16) * 1024 + col0;
#pragma unroll
                for (int bj = 0; bj < 2; ++bj) { const f32x4 v0 = acc[ai][bj][m][0], v1 = acc[ai][bj][m][1];
                    u32x4 w; w.x = cvt_pk_bf16(v0[0], v0[1]); w.y = cvt_pk_bf16(v0[2], v0[3]); w.z = cvt_pk_bf16(v1[0], v1[1]); w.w = cvt_pk_bf16(v1[2], v1[3]);
                    *(u32x4*)(out + off + bj * HALF) = w; } }
    }
};
struct EpiG1 {
    static constexpr bool PERM = true;
    bf16* HID; const float* rstd;
    __device__ __forceinline__ void operator()(const f32x4 (&acc)[2][2][4][2], const Unit& u, int wr, int wc, int fr, int fq) const {
        const int col0 = u.pn * HALF + wc * 32 + 8 * fq;
#pragma unroll
        for (int ai = 0; ai < 2; ++ai)
#pragma unroll
            for (int m = 0; m < 4; ++m) { const int rl = ai * HALF + wr * 64 + m * 16 + fr;
                if (rl < u.nvalid) { const unsigned ent = u.list[rl]; const unsigned tok = ent & 0x7fffffffu, half = ent >> 31; const float gt = u.glist[rl], rs = rstd[tok];
                    float o[8];
#pragma unroll
                    for (int n = 0; n < 2; ++n)
#pragma unroll
                        for (int j = 0; j < 4; ++j) { const float g = acc[ai][0][m][n][j] * rs, up = acc[ai][1][m][n][j] * rs; o[4 * n + j] = g * sigmoidf_(g) * up * gt; }
                    u32x4 w; w.x = cvt_pk_bf16(o[0], o[1]); w.y = cvt_pk_bf16(o[2], o[3]); w.z = cvt_pk_bf16(o[4], o[5]); w.w = cvt_pk_bf16(o[6], o[7]);
                    *(u32x4*)(HID + (size_t)tok * 1024 + half * 512 + col0) = w; } }
    }
};
struct EpiG2 {
    static constexpr bool PERM = true;
    bf16* out;
    __device__ __forceinline__ void operator()(f32x4 (&acc)[2][2][4][2], const Unit& u, int wr, int wc, int fr, int fq) const {
        const int col0 = u.pn * BM + wc * 32 + 8 * fq;
        unsigned tokv[2][4];
#pragma unroll
        for (int ai = 0; ai < 2; ++ai)
#pragma unroll
            for (int m = 0; m < 4; ++m) { const int rl = ai * HALF + wr * 64 + m * 16 + fr; tokv[ai][m] = rl < u.nvalid ? (u.list[rl] & 0x7fffffffu) : 0xffffffffu; }
#pragma unroll
        for (int ai = 0; ai < 2; ++ai)
#pragma unroll
            for (int m = 0; m < 4; ++m) if (tokv[ai][m] != 0xffffffffu) { const bf16* __restrict__ p = out + (size_t)tokv[ai][m] * 1024 + col0;
#pragma unroll
                for (int bj = 0; bj < 2; ++bj) { const u32x4 w = *(const u32x4*)(p + bj * HALF);
                    acc[ai][bj][m][0] += (f32x4){bflo(w.x), bfhi(w.x), bflo(w.y), bfhi(w.y)}; acc[ai][bj][m][1] += (f32x4){bflo(w.z), bfhi(w.z), bflo(w.w), bfhi(w.w)}; } }
        asm volatile("" ::: "memory");
#pragma unroll
        for (int ai = 0; ai < 2; ++ai)
#pragma unroll
            for (int m = 0; m < 4; ++m) if (tokv[ai][m] != 0xffffffffu) { bf16* __restrict__ p = out + (size_t)tokv[ai][m] * 1024 + col0;
#pragma unroll
                for (int bj = 0; bj < 2; ++bj) { const f32x4 v0 = acc[ai][bj][m][0], v1 = acc[ai][bj][m][1];
                    u32x4 w; w.x = cvt_pk_bf16(v0[0], v0[1]); w.y = cvt_pk_bf16(v0[2], v0[3]); w.z = cvt_pk_bf16(v1[0], v1[1]); w.w = cvt_pk_bf16(v1[2], v1[3]);
                    *(u32x4*)(p + bj * HALF) = w; } }
    }
};
}

#define XB_TMO      128
#define XB_XCNT(j)  (256  + 64 * (j))
#define XB_XSUB(j)  (1280 + 64 * (j))
#define XB_XGEN(j)  (2304 + 64 * (j))
#define XB_TOP      3328
#define XB_TOPGEN   3392
#define XCD_BAR_WORDS 3456
#define XB_SPIN_CAP (1u << 18)
__device__ __forceinline__ unsigned xb_ld(unsigned* p)              { return __hip_atomic_load(p, __ATOMIC_RELAXED, __HIP_MEMORY_SCOPE_AGENT); }
__device__ __forceinline__ unsigned xb_add(unsigned* p, unsigned v) { return __hip_atomic_fetch_add(p, v, __ATOMIC_RELAXED, __HIP_MEMORY_SCOPE_AGENT); }
__device__ __forceinline__ unsigned xb_xcc_id() { return (unsigned)__builtin_amdgcn_s_getreg((3 << 11) | 20) & 0xFu; }
#define XB_SPIN(cond, bar) do { unsigned _sp = 0; while (cond) { __builtin_amdgcn_s_sleep(1); \
    if ((++_sp & 255u) == 0u) { if (xb_ld(&(bar)[XB_TMO])) break; if (_sp > XB_SPIN_CAP) { atomicAdd(&(bar)[XB_TMO], 1u); break; } } } } while (0)
struct XcdBarrier { unsigned* bar; unsigned x; volatile LAS unsigned* st; };
__device__ __forceinline__ XcdBarrier xcd_barrier_post(unsigned* bar, volatile LAS unsigned* st) {
    XcdBarrier b; b.bar = bar; b.x = xb_xcc_id(); b.st = st;
    if (threadIdx.x == 0) (void)xb_add(&bar[XB_XCNT(b.x)], 1u);
    return b;
}
__device__ __forceinline__ void xcd_barrier_complete(unsigned* bar, unsigned x, unsigned& nloc, unsigned& nx) {
    const unsigned G = gridDim.x * gridDim.y * gridDim.z;
    unsigned sum, cnt, mine, sp = 0u;
    for (;;) {
        sum = 0u; cnt = 0u; mine = 0u;
#pragma unroll
        for (unsigned j = 0; j < 16; ++j) { const unsigned c = xb_ld(&bar[XB_XCNT(j)]); sum += c; cnt += (c > 0u) ? 1u : 0u; mine = (j == x) ? c : mine; }
        if (sum == G) break;
        __builtin_amdgcn_s_sleep(1);
        if ((++sp & 255u) == 0u) { if (xb_ld(&bar[XB_TMO])) break; if (sp > XB_SPIN_CAP) { atomicAdd(&bar[XB_TMO], 1u); break; } }
    }
    nloc = mine > 0u ? mine : 1u; nx = cnt > 0u ? cnt : 1u;
}
__device__ __forceinline__ void xcd_barrier(const XcdBarrier& b) {
    asm volatile("s_waitcnt vmcnt(0)" ::: "memory");
    __syncthreads();
    if (threadIdx.x == 0) {
        unsigned* bar = b.bar;
        __builtin_amdgcn_s_waitcnt(0);
        unsigned nloc = b.st[0], nx = b.st[1];
        if (nloc == 0u) { xcd_barrier_complete(bar, b.x, nloc, nx); b.st[0] = nloc; b.st[1] = nx; }
        const unsigned old = xb_add(&bar[XB_XSUB(b.x)], 1u);
        const unsigned gen = old / nloc;
        if (old + 1u == (gen + 1u) * nloc) {
            __builtin_amdgcn_fence(__ATOMIC_RELEASE, "agent");
            asm volatile("s_waitcnt vmcnt(0)" ::: "memory");
            const unsigned og = xb_add(&bar[XB_TOP], 1u);
            const unsigned tg = og / nx;
            if (og + 1u == (tg + 1u) * nx) xb_add(&bar[XB_TOPGEN], 1u);
            else XB_SPIN(xb_ld(&bar[XB_TOPGEN]) == tg, bar);
            __builtin_amdgcn_fence(__ATOMIC_ACQUIRE, "agent");
            xb_add(&bar[XB_XGEN(b.x)], 1u);
            asm volatile("s_waitcnt vmcnt(0)" ::: "memory");
        } else {
            XB_SPIN(xb_ld(&bar[XB_XGEN(b.x)]) == gen, bar);
            __builtin_amdgcn_fence(__ATOMIC_ACQUIRE, "agent");
            asm volatile("s_waitcnt vmcnt(0)" ::: "memory");
        }
    }
    __syncthreads();
}

__device__ __forceinline__ void tr_item(const float* W, int ldw, int k0, int n0, bf16* WT, int ldt, int rd0, LAS float* scr, int lane) {
#pragma unroll 8
    for (int i = 0; i < 32; ++i) { const int kk = 2 * i + (lane >> 5); scr[kk * 33 + (lane & 31)] = W[(size_t)(k0 + kk) * ldw + n0 + (lane & 31)]; }
    LDS_WAIT(); asm volatile("" ::: "memory");
    const int c = lane & 7;
#pragma unroll
    for (int j = 0; j < 4; ++j) { const int n = (lane >> 3) + 8 * j; const LAS float* s = scr + (8 * c) * 33 + n;
        u32x4 o; o.x = cvt_pk_bf16(s[0 * 33], s[1 * 33]); o.y = cvt_pk_bf16(s[2 * 33], s[3 * 33]); o.z = cvt_pk_bf16(s[4 * 33], s[5 * 33]); o.w = cvt_pk_bf16(s[6 * 33], s[7 * 33]);
        *(u32x4*)(WT + (size_t)(rd0 + n) * ldt + k0 + 8 * c) = o; }
    LDS_WAIT(); asm volatile("" ::: "memory");
}
__device__ __forceinline__ void norm_row(const float* xrow, const float* g, bf16* hrow, float* rstd_out, int lane) {
    const f32x4* xr = (const f32x4*)xrow + lane; const f32x4* gr = (const f32x4*)g + lane;
    f32x4 v[4]; float s = 0.f;
#pragma unroll
    for (int j = 0; j < 4; ++j) { v[j] = xr[64 * j]; s += (v[j].x * v[j].x + v[j].y * v[j].y) + (v[j].z * v[j].z + v[j].w * v[j].w); }
    s = wave_sum(s);
    if (lane == 0) *rstd_out = 1.0f / sqrtf(s * (1.0f / D) + EPS);
    u32x2* o8 = (u32x2*)hrow + lane;
#pragma unroll
    for (int j = 0; j < 4; ++j) { const f32x4 gv = gr[64 * j]; u32x2 w; w.x = cvt_pk_bf16(v[j].x * gv.x, v[j].y * gv.y); w.y = cvt_pk_bf16(v[j].z * gv.z, v[j].w * gv.w); o8[64 * j] = w; }
}

struct Args { const float* in[26]; float* out; unsigned char* ws; int ph_lo, ph_hi, li, pad; };

__device__ __forceinline__ void p0_prologue(const Args& a, LAS unsigned char* lds, int G, int wave, int lane) {
    unsigned char* ws = a.ws;
    LAS float* scr = (LAS float*)(lds + wave * 16384);
    const int gw = blockIdx.x * 8 + wave, NGW = G * 8;
    constexpr int I_IN = 16 * 80, I_OUT = 16 * 32, I_CIN = 16 * 64, I_CO = 16 * 32, I_AX = 8 * 2 * 8, I_MOE = 64 * 768, I_RT = 2 * 16;
    constexpr int NITEMS = I_IN + I_OUT + I_CIN + I_CO + I_AX + I_MOE + I_RT;
    for (int it = gw; it < NITEMS; it += NGW) {
        int r = it;
        if (r < I_IN) { const int kb = r / 80, nb = r % 80, n0 = 32 * nb;
            if (n0 < 512) tr_item(a.in[4], 2560, 64 * kb, n0, (bf16*)(ws + WS_WREST), 1024, n0, scr, lane);
            else if (n0 < 1024) tr_item(a.in[4], 2560, 64 * kb, n0, (bf16*)(ws + WS_WV), 1024, n0 - 512, scr, lane);
            else tr_item(a.in[4], 2560, 64 * kb, n0, (bf16*)(ws + WS_WREST), 1024, n0 - 512, scr, lane);
            continue; } r -= I_IN;
        if (r < I_OUT) { tr_item(a.in[9], 1024, 64 * (r / 32), 32 * (r % 32), (bf16*)(ws + WS_WO), 1024, 32 * (r % 32), scr, lane); continue; } r -= I_OUT;
        if (r < I_CIN) { tr_item(a.in[10], 2048, 64 * (r / 64), 32 * (r % 64), (bf16*)(ws + WS_WC), 1024, 32 * (r % 64), scr, lane); continue; } r -= I_CIN;
        if (r < I_CO) { tr_item(a.in[18], 1024, 64 * (r / 32), 32 * (r % 32), (bf16*)(ws + WS_WCO), 1024, 32 * (r % 32), scr, lane); continue; } r -= I_CO;
        if (r < I_AX) { const int h = r / 16, gate = (r / 8) & 1, kb = (r / 4) & 1, nb = r & 3;
            tr_item((gate ? a.in[15] : a.in[13]) + (size_t)h * 16384, 128, 64 * kb, 32 * nb, (bf16*)(ws + WS_WAX) + (size_t)h * 256 * 128, 128, gate * 128 + 32 * nb, scr, lane); continue; } r -= I_AX;
        if (r < I_MOE) { const int le = r / 768, q = r % 768;
            if (q < 512) { const int up = q / 256, qq = q % 256, kb = qq / 16, nb = qq % 16, n0 = 32 * nb;
                tr_item((up ? a.in[24] : a.in[23]) + (size_t)le * 1024 * 512, 512, 64 * kb, n0, (bf16*)(ws + WS_WGU) + (size_t)le * 1024 * 1024, 1024, (n0 / 128) * 256 + up * 128 + (n0 % 128), scr, lane); }
            else { const int qq = q - 512, kb = qq / 32, nb = qq % 32;
                tr_item(a.in[25] + (size_t)le * 512 * 1024, 1024, 64 * kb, 32 * nb, (bf16*)(ws + WS_WD) + (size_t)le * 1024 * 512, 512, 32 * nb, scr, lane); }
            continue; } r -= I_MOE;
        { const int l = r / 16, kb = r % 16; tr_item(a.in[21] + (size_t)l * 1024 * 32, 32, 64 * kb, 0, (bf16*)(ws + WS_WRT) + (size_t)l * 48 * 1024, 1024, 0, scr, lane); }
    }
    const int gt = blockIdx.x * 512 + threadIdx.x, NGT = G * 512;
    for (int i = gt; i < 2 * 16 * 1024; i += NGT) {
        const int l = i / 16384, n = (i / 1024) & 15, k = i & 1023;
        const float v = n < 4 ? a.in[19][(size_t)l * 4096 + k * 4 + n] : 0.f;
        ((bf16*)(ws + WS_WRT))[(size_t)l * 48 * 1024 + (size_t)(32 + n) * 1024 + k] = (bf16)(cvt_pk_bf16(v, 0.f) & 0xffffu); }
    for (int i = gt; i < 4 * 128 * 128; i += NGT) {
        const int t = (i >> 7) & 127, s = i & 127; const float v = s <= t ? a.in[6][i] : 0.f;
        ((bf16*)(ws + WS_WSB))[i] = (bf16)(cvt_pk_bf16(v, 0.f) & 0xffffu); }
    for (int m = gw; m < M; m += NGW) norm_row(a.in[0] + (size_t)m * D, a.in[1], (bf16*)(ws + WS_H) + (size_t)m * HP, (float*)(ws + WS_RSTD) + m, lane);
}
__device__ __forceinline__ void norm_phase(const bf16* xb, const float* g, bf16* H, float* rstd, int G, int wave, int lane) {
    const int gw = blockIdx.x * 8 + wave, NGW = G * 8;
    for (int m = gw; m < M; m += NGW) {
        const u32x4* xr = (const u32x4*)(xb + (size_t)m * D) + lane; u32x4* hr = (u32x4*)(H + (size_t)m * HP) + lane;
        u32x4 v[2]; float s = 0.f;
#pragma unroll
        for (int j = 0; j < 2; ++j) { v[j] = xr[64 * j];
#pragma unroll
            for (int k = 0; k < 4; ++k) { const float lo = bflo(v[j][k]), hi = bfhi(v[j][k]); s += lo * lo + hi * hi; } }
        s = wave_sum(s);
        if (lane == 0) rstd[m] = 1.0f / sqrtf(s * (1.0f / D) + EPS);
#pragma unroll
        for (int j = 0; j < 2; ++j) { const f32x4 g0 = *(const f32x4*)(g + 8 * lane + 512 * j), g1 = *(const f32x4*)(g + 8 * lane + 512 * j + 4); u32x4 o;
            o.x = cvt_pk_bf16(bflo(v[j].x) * g0.x, bfhi(v[j].x) * g0.y); o.y = cvt_pk_bf16(bflo(v[j].y) * g0.z, bfhi(v[j].y) * g0.w);
            o.z = cvt_pk_bf16(bflo(v[j].z) * g1.x, bfhi(v[j].z) * g1.y); o.w = cvt_pk_bf16(bflo(v[j].w) * g1.z, bfhi(v[j].w) * g1.w); hr[64 * j] = o; }
    }
}
__device__ __forceinline__ void final_norm_phase(const bf16* xb, float* out, const float* g, int G, int wave, int lane) {
    const int gw = blockIdx.x * 8 + wave, NGW = G * 8;
    for (int m = gw; m < M; m += NGW) {
        const u32x4* xr = (const u32x4*)(xb + (size_t)m * D) + lane; float* orow = out + (size_t)m * D;
        u32x4 v[2]; float s = 0.f;
#pragma unroll
        for (int j = 0; j < 2; ++j) { v[j] = xr[64 * j];
#pragma unroll
            for (int k = 0; k < 4; ++k) { const float lo = bflo(v[j][k]), hi = bfhi(v[j][k]); s += lo * lo + hi * hi; } }
        const float rs = 1.0f / sqrtf(wave_sum(s) * (1.0f / D) + EPS);
#pragma unroll
        for (int j = 0; j < 2; ++j) { const f32x4 g0 = *(const f32x4*)(g + 8 * lane + 512 * j), g1 = *(const f32x4*)(g + 8 * lane + 512 * j + 4);
            *(f32x4*)(orow + 8 * lane + 512 * j) = (f32x4){bflo(v[j].x) * rs * g0.x, bfhi(v[j].x) * rs * g0.y, bflo(v[j].y) * rs * g0.z, bfhi(v[j].y) * rs * g0.w};
            *(f32x4*)(orow + 8 * lane + 512 * j + 4) = (f32x4){bflo(v[j].z) * rs * g1.x, bfhi(v[j].z) * rs * g1.y, bflo(v[j].w) * rs * g1.z, bfhi(v[j].w) * rs * g1.w}; }
    }
}

__device__ __forceinline__ void p2_spatial(const Args& a, LAS unsigned char* lds, int G, int wave, int lane) {
    const bf16* ZR = (const bf16*)(a.ws + WS_Z); const bf16* VT = (const bf16*)(a.ws + WS_VT); bf16* Y = (bf16*)(a.ws + WS_Y); const bf16* WSB = (const bf16*)(a.ws + WS_WSB);
    LAS unsigned char* T = lds;
    LAS float* MU = (LAS float*)(lds + 131072); LAS float* RS = MU + 128; LAS float* PART = (LAS float*)(lds + 131072 + 1024);
    const int tid = threadIdx.x, fr = lane & 15, fq = lane >> 4;
    for (int unit = blockIdx.x; unit < M / 128; unit += G) {
        const size_t row0 = (size_t)unit * 128;
        {
            const int cg = tid & 63, rg = tid >> 6, c0 = 8 * cg; const size_t R = row0 + 16 * rg;
            float w0[8], w1[8], w2[8], p2v[8], p1v[8];
#pragma unroll
            for (int j = 0; j < 8; ++j) { w0[j] = a.in[8][c0 + j]; w1[j] = a.in[8][512 + c0 + j]; w2[j] = a.in[8][1024 + c0 + j]; p2v[j] = 0.f; p1v[j] = 0.f; }
            if ((R & (SEQ - 1)) != 0) {
                const u32x4 gc2 = *(const u32x4*)(ZR + (R - 2) * 2048 + 1024 + c0), xb2 = *(const u32x4*)(ZR + (R - 2) * 2048 + 1536 + c0);
                const u32x4 gc1 = *(const u32x4*)(ZR + (R - 1) * 2048 + 1024 + c0), xb1 = *(const u32x4*)(ZR + (R - 1) * 2048 + 1536 + c0);
#pragma unroll
                for (int j = 0; j < 4; ++j) { p2v[2 * j] = bflo(gc2[j]) * bflo(xb2[j]); p2v[2 * j + 1] = bfhi(gc2[j]) * bfhi(xb2[j]); p1v[2 * j] = bflo(gc1[j]) * bflo(xb1[j]); p1v[2 * j + 1] = bfhi(gc1[j]) * bfhi(xb1[j]); }
            }
#pragma unroll 4
            for (int r = 0; r < 16; ++r) { const bf16* zr = ZR + (R + r) * 2048 + c0;
                const u32x4 gb = *(const u32x4*)(zr + 512), gc = *(const u32x4*)(zr + 1024), xb = *(const u32x4*)(zr + 1536);
                float cx[8], y[8];
#pragma unroll
                for (int j = 0; j < 4; ++j) { cx[2 * j] = bflo(gc[j]) * bflo(xb[j]); cx[2 * j + 1] = bfhi(gc[j]) * bfhi(xb[j]); }
#pragma unroll
                for (int j = 0; j < 8; ++j) { const float gbj = (j & 1) ? bfhi(gb[j >> 1]) : bflo(gb[j >> 1]); y[j] = gbj * (w0[j] * p2v[j] + w1[j] * p1v[j] + w2[j] * cx[j]); p2v[j] = p1v[j]; p1v[j] = cx[j]; }
                u32x4 o; o.x = cvt_pk_bf16(y[0], y[1]); o.y = cvt_pk_bf16(y[2], y[3]); o.z = cvt_pk_bf16(y[4], y[5]); o.w = cvt_pk_bf16(y[6], y[7]);
                *(u32x4*)(Y + (R + r) * 1024 + 512 + c0) = o; }
        }
#pragma unroll 4
        for (int p = 0; p < 16; ++p) { const int row = p * 32 + (tid >> 4), ch = tid & 15;
            const u32x4 v = *(const u32x4*)(VT + (size_t)row * M + row0 + ch * 8);
            *(LAS u32x4*)(T + row * 256 + ((ch ^ (row & 15)) << 4)) = v; }
        __syncthreads();
        const int sg = tid & 15, dg = tid >> 4;
        {   float s[8], q[8];
#pragma unroll
            for (int j = 0; j < 8; ++j) { s[j] = 0.f; q[j] = 0.f; }
#pragma unroll 4
            for (int rr = 0; rr < 16; ++rr) { const u32x4 v = *(const LAS u32x4*)(T + (16 * dg + rr) * 256 + ((sg ^ rr) << 4));
#pragma unroll
                for (int j = 0; j < 4; ++j) { const float lo = bflo(v[j]), hi = bfhi(v[j]); s[2 * j] += lo; q[2 * j] += lo * lo; s[2 * j + 1] += hi; q[2 * j + 1] += hi * hi; } }
#pragma unroll
            for (int j = 0; j < 8; ++j) { s[j] += __shfl_xor(s[j], 16); s[j] += __shfl_xor(s[j], 32); q[j] += __shfl_xor(q[j], 16); q[j] += __shfl_xor(q[j], 32); }
            if (lane < 16) {
#pragma unroll
                for (int j = 0; j < 8; ++j) { PART[(wave * 128 + 8 * sg + j) * 2] = s[j]; PART[(wave * 128 + 8 * sg + j) * 2 + 1] = q[j]; } }
        }
        __syncthreads();
        if (tid < 128) { float s = 0.f, q = 0.f;
#pragma unroll
            for (int w = 0; w < 8; ++w) { s += PART[(w * 128 + tid) * 2]; q += PART[(w * 128 + tid) * 2 + 1]; }
            const float mean = s * (1.0f / 512.0f); float var = q * (1.0f / 512.0f) - mean * mean; var = var > 0.f ? var : 0.f;
            MU[tid] = mean; RS[tid] = 1.0f / sqrtf(var + EPS); }
        __syncthreads();
        {   float mu8[8], rs8[8];
#pragma unroll
            for (int j = 0; j < 8; ++j) { mu8[j] = MU[8 * sg + j]; rs8[j] = RS[8 * sg + j]; }
#pragma unroll 4
            for (int rr = 0; rr < 16; ++rr) { const int row = 16 * dg + rr; const float gd = a.in[5][row]; LAS u32x4* pp = (LAS u32x4*)(T + row * 256 + ((sg ^ rr) << 4)); const u32x4 v = *pp; u32x4 o;
#pragma unroll
                for (int j = 0; j < 4; ++j) o[j] = cvt_pk_bf16((bflo(v[j]) - mu8[2 * j]) * rs8[2 * j] * gd, (bfhi(v[j]) - mu8[2 * j + 1]) * rs8[2 * j + 1] * gd);
                *pp = o; }
        }
        __syncthreads();
        {   const int hh = wave >> 1, rh = wave & 1;
#pragma unroll 1
            for (int nh = 0; nh < 2; ++nh) {
                f32x4 acc[4][4];
#pragma unroll
                for (int m = 0; m < 4; ++m)
#pragma unroll
                    for (int n = 0; n < 4; ++n) acc[m][n] = (f32x4){0.f, 0.f, 0.f, 0.f};
#pragma unroll
                for (int ks = 0; ks < 4; ++ks) { bf16x8 Af[4];
#pragma unroll
                    for (int m = 0; m < 4; ++m) Af[m] = *(const bf16x8*)(WSB + (size_t)((hh * 128 + 64 * rh + 16 * m + fr) * 128 + 32 * ks + 8 * fq));
#pragma unroll
                    for (int n = 0; n < 4; ++n) { const bf16x8 Bf = *(const LAS bf16x8*)(T + (hh * 128 + 64 * nh + 16 * n + fr) * 256 + (((4 * ks + fq) ^ fr) << 4));
#pragma unroll
                        for (int m = 0; m < 4; ++m) acc[m][n] = __builtin_amdgcn_mfma_f32_16x16x32_bf16(Bf, Af[m], acc[m][n], 0, 0, 0); } }
#pragma unroll
                for (int m = 0; m < 4; ++m) { const int t = 64 * rh + 16 * m + fr; const size_t R = row0 + t; const float bias = a.in[7][hh * 128 + t];
#pragma unroll
                    for (int n = 0; n < 4; ++n) { const int d = hh * 128 + 64 * nh + 16 * n + 4 * fq; const u32x2 u4 = *(const u32x2*)(ZR + R * 2048 + d);
                        u32x2 o; o.x = cvt_pk_bf16(bflo(u4.x) * (acc[m][n][0] + bias), bfhi(u4.x) * (acc[m][n][1] + bias)); o.y = cvt_pk_bf16(bflo(u4.y) * (acc[m][n][2] + bias), bfhi(u4.y) * (acc[m][n][3] + bias));
                        *(u32x2*)(Y + R * 1024 + d) = o; } }
            }
        }
        __syncthreads();
    }
}

__device__ __forceinline__ void route_phase(const Args& a, int l, LAS unsigned char* lds, int G, int wave, int lane) {
    const bf16* X = (const bf16*)(a.ws + WS_XB); bf16* H = (bf16*)(a.ws + WS_H); float* RSTD = (float*)(a.ws + WS_RSTD);
    const bf16* WRT = (const bf16*)(a.ws + WS_WRT) + (size_t)l * 48 * 1024; const float* gvec = a.in[2] + l * 1024;
    const float* brg = a.in[20] + l * 4; const float* bre = a.in[22] + l * 32;
    unsigned* ECNT = (unsigned*)(a.ws + WS_CTL) + CW_ECNT + l * 2048; unsigned* PCNT = (unsigned*)(a.ws + WS_CTL) + CW_PCNT + l * 7168;
    unsigned* ELT = (unsigned*)(a.ws + WS_ELT); float* ELG = (float*)(a.ws + WS_ELG); unsigned* PLT = (unsigned*)(a.ws + WS_PLT);
    constexpr int WROW = 2064;
    LAS unsigned char* WL = lds; LAS float* GL = (LAS float*)(lds + 99072); LAS float* SCR = (LAS float*)(lds + 103168) + wave * 768;
    LAS int* TOK = (LAS int*)(lds + 127744);
    LAS int* HIST = (LAS int*)(lds + 135936);
    const int tid = threadIdx.x, fr = lane & 15, fq = lane >> 4;
    for (int tile = blockIdx.x; tile < M / 256; tile += G) {
        __syncthreads();
        for (int i = tid; i < 48 * 128; i += 512) { const int row = i >> 7, ch = i & 127; *(LAS u32x4*)(WL + row * WROW + ch * 16) = *(const u32x4*)(WRT + (size_t)row * 1024 + ch * 8); }
        if (tid < 256) *(LAS f32x4*)(GL + 4 * tid) = *(const f32x4*)(gvec + 4 * tid);
        if (tid < 288) HIST[tid] = 0;
        __syncthreads();
        for (int mt = 2 * wave; mt < 2 * wave + 2; ++mt) {
            const size_t row = (size_t)tile * 256 + 16 * mt + fr; const bf16* xr = X + row * D; bf16* hr = H + row * HP;
            f32x4 acc[3]; acc[0] = acc[1] = acc[2] = (f32x4){0.f, 0.f, 0.f, 0.f}; float ss = 0.f;
#pragma unroll 1
            for (int kb = 0; kb < 4; ++kb) {
                u32x4 xv[8];
#pragma unroll
                for (int j = 0; j < 8; ++j) xv[j] = *(const u32x4*)(xr + 32 * (8 * kb + j) + 8 * fq);
#pragma unroll
                for (int j = 0; j < 8; ++j) { const int k0 = 32 * (8 * kb + j) + 8 * fq; const u32x4 xw = xv[j];
                    const f32x4 x0 = (f32x4){bflo(xw.x), bfhi(xw.x), bflo(xw.y), bfhi(xw.y)}, x1 = (f32x4){bflo(xw.z), bfhi(xw.z), bflo(xw.w), bfhi(xw.w)};
                    const f32x4 g0 = *(const LAS f32x4*)(GL + k0), g1 = *(const LAS f32x4*)(GL + k0 + 4);
                    ss += (x0.x * x0.x + x0.y * x0.y) + (x0.z * x0.z + x0.w * x0.w) + (x1.x * x1.x + x1.y * x1.y) + (x1.z * x1.z + x1.w * x1.w);
                    u32x4 hw; hw.x = cvt_pk_bf16(x0.x * g0.x, x0.y * g0.y); hw.y = cvt_pk_bf16(x0.z * g0.z, x0.w * g0.w); hw.z = cvt_pk_bf16(x1.x * g1.x, x1.y * g1.y); hw.w = cvt_pk_bf16(x1.z * g1.z, x1.w * g1.w);
                    *(u32x4*)(hr + k0) = hw; const bf16x8 Af = __builtin_bit_cast(bf16x8, hw);
#pragma unroll
                    for (int n = 0; n < 3; ++n) { const bf16x8 Bf = *(const LAS bf16x8*)(WL + (16 * n + fr) * WROW + k0 * 2); acc[n] = __builtin_amdgcn_mfma_f32_16x16x32_bf16(Bf, Af, acc[n], 0, 0, 0); } } }
            ss += __shfl_xor(ss, 16); ss += __shfl_xor(ss, 32);
            const float rstd = 1.0f / sqrtf(ss * (1.0f / D) + EPS);
            if (fq == 0) RSTD[row] = rstd;
#pragma unroll
            for (int n = 0; n < 3; ++n)
#pragma unroll
                for (int j = 0; j < 4; ++j) SCR[fr * 48 + 16 * n + 4 * fq + j] = acc[n][j] * rstd;
            LDS_WAIT(); asm volatile("" ::: "memory");
            if (lane < 16) { const LAS float* lg = SCR + lane * 48;
                float gl[4]; int gi = 0; float gm;
#pragma unroll
                for (int j = 0; j < 4; ++j) gl[j] = lg[32 + j] + brg[j];
                gm = gl[0];
#pragma unroll
                for (int j = 1; j < 4; ++j) if (gl[j] > gm) { gm = gl[j]; gi = j; }
                float den = 0.f;
#pragma unroll
                for (int j = 0; j < 4; ++j) den += __expf(gl[j] - gm);
                const float gp = 1.0f / den;
                float el[8];
#pragma unroll
                for (int j = 0; j < 8; ++j) el[j] = lg[8 * gi + j] + bre[8 * gi + j];
                int i1 = 0; float v1 = el[0];
#pragma unroll
                for (int j = 1; j < 8; ++j) if (el[j] > v1) { v1 = el[j]; i1 = j; }
                int i2 = -1; float v2 = -3.0e38f;
#pragma unroll
                for (int j = 0; j < 8; ++j) if (j != i1 && el[j] > v2) { v2 = el[j]; i2 = j; }
                const float e21 = __expf(v2 - v1), p1 = 1.0f / (1.0f + e21), p2 = e21 * p1;
                const int e1 = 8 * gi + i1, e2 = 8 * gi + i2; const int lo = i1 < i2 ? i1 : i2, hi = i1 < i2 ? i2 : i1;
                const int p = gi * 28 + (lo * (15 - lo)) / 2 + (hi - lo - 1);
                LAS int* tk = TOK + (16 * mt + lane) * 8;
                tk[0] = e1; tk[1] = e2; tk[2] = __float_as_int(gp * p1); tk[3] = __float_as_int(gp * p2);
                tk[4] = __hip_atomic_fetch_add(HIST + e1, 1, __ATOMIC_RELAXED, __HIP_MEMORY_SCOPE_WORKGROUP); tk[5] = __hip_atomic_fetch_add(HIST + e2, 1, __ATOMIC_RELAXED, __HIP_MEMORY_SCOPE_WORKGROUP); tk[6] = __hip_atomic_fetch_add(HIST + 32 + p, 1, __ATOMIC_RELAXED, __HIP_MEMORY_SCOPE_WORKGROUP); tk[7] = p; }
            LDS_WAIT(); asm volatile("" ::: "memory");
        }
        __syncthreads();
        if (tid < 32) { const int c = HIST[tid]; HIST[144 + tid] = c ? (int)__hip_atomic_fetch_add(ECNT + 64 * tid, (unsigned)c, __ATOMIC_RELAXED, __HIP_MEMORY_SCOPE_AGENT) : 0; }
        else if (tid < 144) { const int j = tid - 32; const int c = HIST[32 + j]; HIST[176 + j] = c ? (int)__hip_atomic_fetch_add(PCNT + 64 * j, (unsigned)c, __ATOMIC_RELAXED, __HIP_MEMORY_SCOPE_AGENT) : 0; }
        __syncthreads();
        if (tid < 256) { const LAS int* tk = TOK + tid * 8; const unsigned tok = (unsigned)(tile * 256 + tid);
            const int e1 = tk[0], e2 = tk[1]; const unsigned h1 = e1 < e2 ? 0u : 1u;
            const size_t s1 = (size_t)e1 * 65536 + HIST[144 + e1] + tk[4], s2 = (size_t)e2 * 65536 + HIST[144 + e2] + tk[5];
            ELT[s1] = tok | (h1 << 31); ELG[s1] = __int_as_float(tk[2]); ELT[s2] = tok | ((1u - h1) << 31); ELG[s2] = __int_as_float(tk[3]);
            PLT[(size_t)tk[7] * 65536 + HIST[176 + tk[7]] + tk[6]] = tok; }
    }
}
__device__ __forceinline__ void build_tables(LAS unsigned char* lds, unsigned* counters, int ng) {
    LAS int* pref = (LAS int*)(lds + TAB_OFF); LAS int* cnt = pref + 130;
    __syncthreads();
    if ((int)threadIdx.x < ng) cnt[threadIdx.x] = (int)__hip_atomic_load(counters + 64 * threadIdx.x, __ATOMIC_RELAXED, __HIP_MEMORY_SCOPE_AGENT);
    __syncthreads();
    if (threadIdx.x == 0) { int s = 0; for (int g = 0; g < ng; ++g) { pref[g] = s; s += (cnt[g] + 255) >> 8; } for (int g = ng; g < 130; ++g) pref[g] = s; }
    __syncthreads();
}

template <bool PASS2> __device__ __forceinline__ void scan_phase(const Args& a, LAS unsigned char* lds, int G, int wave, int lane) {
    const bf16* ZC = (const bf16*)(a.ws + WS_Z); bf16* Y = (bf16*)(a.ws + WS_Y); const bf16* WAX = (const bf16*)(a.ws + WS_WAX); float* CAR = (float*)(a.ws + WS_CAR);
    LAS unsigned char* RAW = lds;
    LAS unsigned char* AT = lds + 34816;
    LAS unsigned char* GT = lds + 67584;
    LAS float* CW = (LAS float*)(lds + 100352);
    const int tid = threadIdx.x, fr = lane & 15, fq = lane >> 4;
    const int cc = tid & 15, rq = tid >> 4;
    for (int unit = blockIdx.x; unit < 1024; unit += G) {
        const int hd = unit & 7, blk = (unit >> 3) & 15, b = unit >> 7;
        const size_t Rbase = (size_t)b * SEQ + blk * 512;
        const int ch = 128 * hd + 16 * wave + fr;
        bf16x8 Br[4], Bi[4];
#pragma unroll
        for (int ks = 0; ks < 4; ++ks) { Br[ks] = *(const bf16x8*)(WAX + (size_t)((hd * 256 + 16 * wave + fr) * 128 + 32 * ks + 8 * fq)); Bi[ks] = *(const bf16x8*)(WAX + (size_t)((hd * 256 + 128 + 16 * wave + fr) * 128 + 32 * ks + 8 * fq)); }
        const float ba = a.in[14][ch], bx = a.in[16][ch];
        const float kl = -8.0f * 1.44269504f * log1pf(__expf(-a.in[17][ch]));
        __syncthreads();
        if (tid < 128) { const int c = 128 * hd + tid;
#pragma unroll
            for (int k = 0; k < 4; ++k) CW[k * 128 + tid] = a.in[11][k * 1024 + c];
            CW[4 * 128 + tid] = a.in[12][c]; }
        float Hs = 0.f, Pa = 1.f;
        if (PASS2) { for (int j = 0; j < blk; ++j) { const f32x2 ab = *(const f32x2*)(CAR + ((size_t)(b * 16 + j) * 1024 + ch) * 2); Hs = ab.x * Hs + ab.y; } }
        u32x4 pr[5], pg[4];
#define SCAN_LOAD(sbn) do { const size_t R0n = Rbase + 128 * (sbn); \
            _Pragma("unroll") for (int p = 0; p < 5; ++p) { const int rr = p * 32 + rq; const int pos = blk * 512 + 128 * (sbn) - 3 + rr; pr[p] = (u32x4){0u, 0u, 0u, 0u}; \
                if (rr < 131 && pos >= 0) pr[p] = *(const u32x4*)(ZC + (R0n + rr - 3) * 2048 + 1024 + 128 * hd + 8 * cc); } \
            if (PASS2) { _Pragma("unroll") for (int p = 0; p < 4; ++p) pg[p] = *(const u32x4*)(ZC + (R0n + p * 32 + rq) * 2048 + 128 * hd + 8 * cc); } } while (0)
        SCAN_LOAD(0);
#pragma unroll 1
        for (int sb = 0; sb < 4; ++sb) {
            const size_t R0 = Rbase + 128 * sb;
#pragma unroll
            for (int p = 0; p < 5; ++p) { const int rr = p * 32 + rq; if (rr < 132) *(LAS u32x4*)(RAW + rr * 256 + cc * 16) = pr[p]; }
            if (PASS2) {
#pragma unroll
                for (int p = 0; p < 4; ++p) { const int row = p * 32 + rq; *(LAS u32x4*)(GT + row * 256 + ((cc ^ p) << 4)) = pg[p]; } }
            __syncthreads();
            if (sb < 3) SCAN_LOAD(sb + 1);
            {
                float cw[5][8];
#pragma unroll
                for (int k = 0; k < 5; ++k) { const f32x4 w0 = *(const LAS f32x4*)(CW + k * 128 + 8 * cc), w1 = *(const LAS f32x4*)(CW + k * 128 + 8 * cc + 4);
                    cw[k][0] = w0.x; cw[k][1] = w0.y; cw[k][2] = w0.z; cw[k][3] = w0.w; cw[k][4] = w1.x; cw[k][5] = w1.y; cw[k][6] = w1.z; cw[k][7] = w1.w; }
                float xw[7][8];
#pragma unroll
                for (int i = 0; i < 7; ++i) { const u32x4 v = *(const LAS u32x4*)(RAW + (4 * rq + i) * 256 + cc * 16);
#pragma unroll
                    for (int j = 0; j < 4; ++j) { xw[i][2 * j] = bflo(v[j]); xw[i][2 * j + 1] = bfhi(v[j]); } }
#pragma unroll
                for (int i = 0; i < 4; ++i) { const int t = 4 * rq + i; float o[8];
#pragma unroll
                    for (int j = 0; j < 8; ++j) o[j] = cw[4][j] + cw[0][j] * xw[i][j] + cw[1][j] * xw[i + 1][j] + cw[2][j] * xw[i + 2][j] + cw[3][j] * xw[i + 3][j];
                    u32x4 w; w.x = cvt_pk_bf16(o[0], o[1]); w.y = cvt_pk_bf16(o[2], o[3]); w.z = cvt_pk_bf16(o[4], o[5]); w.w = cvt_pk_bf16(o[6], o[7]);
                    const int key = (((t >> 5) & 3) << 2) | (t & 3);
                    *(LAS u32x4*)(AT + t * 256 + ((cc ^ key) << 4)) = w; }
            }
            __syncthreads();
            f32x4 ar[8], ai[8];
            const int arow = 32 * (fr >> 2) + (fr & 3);
#pragma unroll
            for (int m = 0; m < 8; ++m) { ar[m] = (f32x4){0.f, 0.f, 0.f, 0.f}; ai[m] = (f32x4){0.f, 0.f, 0.f, 0.f};
#pragma unroll
                for (int ks = 0; ks < 4; ++ks) { const bf16x8 Af = *(const LAS bf16x8*)(AT + (arow + 4 * m) * 256 + (((4 * ks + fq) ^ fr) << 4));
                    ar[m] = __builtin_amdgcn_mfma_f32_16x16x32_bf16(Af, Br[ks], ar[m], 0, 0, 0); ai[m] = __builtin_amdgcn_mfma_f32_16x16x32_bf16(Af, Bi[ks], ai[m], 0, 0, 0); } }
            float av[32], bv[32];
            const int cbase = 2 * wave + (fr >> 3);
#pragma unroll
            for (int m = 0; m < 8; ++m)
#pragma unroll
                for (int i = 0; i < 4; ++i) {
                    const float xr = bf1(*(const LAS unsigned short*)(AT + (32 * fq + 4 * m + i) * 256 + ((cbase ^ ((fq << 2) | i)) << 4) + (fr & 7) * 2));
                    const float r = sigmoidf_(ar[m][i] + ba), ig = sigmoidf_(ai[m][i] + bx);
                    const float aa = __builtin_amdgcn_exp2f(r * kl); float om = 1.0f - aa * aa; om = om > 0.f ? om : 0.f;
                    av[4 * m + i] = aa; bv[4 * m + i] = __builtin_amdgcn_sqrtf(om) * ig * xr; }
            float As = 1.f, Bs = 0.f;
#pragma unroll
            for (int j = 0; j < 32; ++j) { Bs = av[j] * Bs + bv[j]; As *= av[j]; }
            float A1 = As, B1 = Bs;
            { const float Ap = __shfl_up(As, 16), Bp = __shfl_up(Bs, 16); if (fq >= 1) { A1 = Ap * As; B1 = As * Bp + Bs; } }
            float A2 = A1, B2 = B1;
            { const float Ap = __shfl_up(A1, 32), Bp = __shfl_up(B1, 32); if (fq >= 2) { A2 = Ap * A1; B2 = A1 * Bp + B1; } }
            if (PASS2) {
                float Ae = __shfl_up(A2, 16), Be = __shfl_up(B2, 16); if (fq == 0) { Ae = 1.f; Be = 0.f; }
                float h = Ae * Hs + Be;
                LAS unsigned short* gp = (LAS unsigned short*)(GT + (32 * fq) * 256 + ((cbase ^ fq) << 4) + (fr & 7) * 2);
#pragma unroll
                for (int j = 0; j < 32; ++j) { h = av[j] * h + bv[j]; const float gate = bf1(gp[j * 128]); gp[j * 128] = (unsigned short)(cvt_pk_bf16(gate * h, 0.f) & 0xffffu); }
            }
            const float At_ = __shfl(A2, fr + 48), Bt_ = __shfl(B2, fr + 48);
            Hs = At_ * Hs + Bt_; Pa *= At_;
            __syncthreads();
            if (PASS2) {
#pragma unroll
                for (int p = 0; p < 4; ++p) { const int row = p * 32 + rq; *(u32x4*)(Y + (R0 + row) * 1024 + 128 * hd + 8 * cc) = *(const LAS u32x4*)(GT + row * 256 + ((cc ^ p) << 4)); }
                __syncthreads();
            }
        }
#undef SCAN_LOAD
        if (!PASS2 && fq == 0) *(f32x2*)(CAR + ((size_t)(b * 16 + blk) * 1024 + ch) * 2) = (f32x2){Pa, Hs};
    }
}

__global__ void __launch_bounds__(512, 2) fwd(Args args) {
    extern __shared__ __attribute__((aligned(16))) unsigned char lds_raw[];
    LAS unsigned char* lds = (LAS unsigned char*)lds_raw;
    volatile LAS unsigned* MISC = (volatile LAS unsigned*)(lds + MISC_OFF);
    const int tid = threadIdx.x, lane = tid & 63, wave = __builtin_amdgcn_readfirstlane(tid >> 6), G = gridDim.x;
    const int vcu = (G % 8 == 0) ? (int)(blockIdx.x % 8) * (G / 8) + (int)(blockIdx.x / 8) : (int)blockIdx.x;
    unsigned char* ws = args.ws;
    if (tid < 64) MISC[tid] = 0u;
    __syncthreads();
    XcdBarrier bar = xcd_barrier_post((unsigned*)(ws + WS_CTL) + CW_BAR + args.li * XCD_BAR_WORDS, MISC + 8);
    const int lo = args.ph_lo, hi = args.ph_hi;
#define IN(k) (ph_on(k) && lo <= (k) && (k) < hi)
#ifndef PROBE_NOSTORE
#define PROBE_NOSTORE 0
#endif
#define RUN(k, ...) do { if (IN(k)) { const int ST_ON = 1; __VA_ARGS__ } if (IN(k) && ((REP_MASK >> (k)) & 1)) { const int ST_ON = PROBE_NOSTORE ? args.pad : 1; __VA_ARGS__ } } while (0)
#define SEAM(k) do { if (IN(k) && hi > (k) + 1) xcd_barrier(bar); } while (0)
    bf16* H = (bf16*)(ws + WS_H); float* RSTD = (float*)(ws + WS_RSTD); bf16* Z = (bf16*)(ws + WS_Z); bf16* Yb = (bf16*)(ws + WS_Y); bf16* XB = (bf16*)(ws + WS_XB);

    RUN(0, p0_prologue(args, lds, G, wave, lane););
    SEAM(0);
    RUN(1,
        { pg8::DenseOrder S; S.init(M, 2048, G, (int)blockIdx.x, H, HP, ws + WS_WREST, 1024, 16);
          pg8::EpiZ<false> E{Z, 2048, RSTD, 2, ST_ON}; pg8::gemm_phase<pg8::EpiZ<false>, pg8::DenseOrder, false>(lds, HP, 1024, 1024, 16, S, E); }
        { pg8::DenseOrder S; S.init(512, M, G, (int)blockIdx.x, ws + WS_WV, 1024, H, HP, 16);
          pg8::EpiZ<true> E{(bf16*)(ws + WS_VT), M, RSTD, 1 << 30, ST_ON}; pg8::gemm_phase<pg8::EpiZ<true>, pg8::DenseOrder, false>(lds, 1024, HP, 1024, 16, S, E); }
    );
    SEAM(1);
    RUN(2, p2_spatial(args, lds, G, wave, lane););
    SEAM(2);
    RUN(3, pg8::DenseOrder S; S.init(M, 1024, G, (int)blockIdx.x, Yb, 1024, ws + WS_WO, 1024, 16);
        pg8::EpiRes<true> E{args.in[0], XB}; pg8::gemm_phase<pg8::EpiRes<true>, pg8::DenseOrder, false>(lds, 1024, 1024, 1024, 16, S, E););
    SEAM(3);
#define MOE_LAYER(l, pb) do { \
        if (IN(pb)) route_phase(args, l, lds, G, wave, lane); \
        SEAM(pb); \
        RUN((pb) + 1, \
            build_tables(lds, (unsigned*)(ws + WS_CTL) + CW_ECNT + (l) * 2048, NE); \
            pg8::GroupOrder<false> S; S.pref = (const LAS int*)(lds + TAB_OFF); S.ng = NE; S.G = G; S.c = vcu; S.lane = lane; \
            S.A = (const char*)H; S.W = (const char*)(ws + WS_WGU) + (size_t)(l) * 32 * 1024 * 1024 * 2; S.lists = (const unsigned*)(ws + WS_ELT); S.glists = (const float*)(ws + WS_ELG); \
            pg8::EpiG1 E{Z, RSTD}; pg8::gemm_phase<pg8::EpiG1, pg8::GroupOrder<false>, true>(lds, HP, 1024, 1024, 16, S, E); \
        ); \
        SEAM((pb) + 1); \
        if (IN((pb) + 2)) { \
            build_tables(lds, (unsigned*)(ws + WS_CTL) + CW_PCNT + (l) * 7168, NPAIR); \
            pg8::GroupOrder<true> S; S.pref = (const LAS int*)(lds + TAB_OFF); S.ng = NPAIR; S.G = G; S.c = vcu; S.lane = lane; \
            S.A = (const char*)Z; S.W = (const char*)(ws + WS_WD) + (size_t)(l) * 32 * 1024 * 512 * 2; S.lists = (const unsigned*)(ws + WS_PLT); S.glists = nullptr; \
            pg8::EpiG2 E{XB}; pg8::gemm_phase<pg8::EpiG2, pg8::GroupOrder<true>, true>(lds, 1024, 512, 1024, 8, S, E); \
        } \
        SEAM((pb) + 2); } while (0)
    MOE_LAYER(0, 4);
    RUN(7, norm_phase(XB, args.in[1] + 1024, H, RSTD, G, wave, lane););
    SEAM(7);
    RUN(8, pg8::DenseOrder S; S.init(M, 2048, G, (int)blockIdx.x, H, HP, ws + WS_WC, 1024, 16);
        pg8::EpiZ<false> E{Z, 2048, RSTD, 4, ST_ON}; pg8::gemm_phase<pg8::EpiZ<false>, pg8::DenseOrder, false>(lds, HP, 1024, 1024, 16, S, E););
    SEAM(8);
    RUN(9, scan_phase<false>(args, lds, G, wave, lane););
    SEAM(9);
    RUN(10, scan_phase<true>(args, lds, G, wave, lane););
    SEAM(10);
    if (IN(11)) { pg8::DenseOrder S; S.init(M, 1024, G, (int)blockIdx.x, Yb, 1024, ws + WS_WCO, 1024, 16);
        pg8::EpiRes<false> E{XB, XB}; pg8::gemm_phase<pg8::EpiRes<false>, pg8::DenseOrder, false>(lds, 1024, 1024, 1024, 16, S, E); }
    SEAM(11);
    MOE_LAYER(1, 12);
#undef MOE_LAYER
    if (IN(15)) final_norm_phase(XB, args.out, args.in[3], G, wave, lane);
#undef IN
#undef SEAM
}

extern "C" void kernel_launch(void* const* d_in, const int* in_sizes, int n_in, void* d_out, int out_size, void* d_ws, size_t ws_size, hipStream_t stream) {
    static int grid = 0;
    if (grid == 0) {
        if (n_in != 26 || in_sizes[0] != M * D || out_size != M * D || ws_size < WS_END) { fprintf(stderr, "kernel_launch: unexpected shapes (n_in %d, in0 %d, out %d, ws %zu < %zu); nothing launched\n", n_in, n_in > 0 ? in_sizes[0] : -1, out_size, ws_size, (size_t)WS_END); grid = -1; return; }
        int dev = 0, cus = 0, per_cu = 0;
        if (hipGetDevice(&dev) != hipSuccess || hipDeviceGetAttribute(&cus, hipDeviceAttributeMultiprocessorCount, dev) != hipSuccess) { grid = -1; return; }
        if (hipFuncSetAttribute((const void*)fwd, hipFuncAttributeMaxDynamicSharedMemorySize, LDS_BYTES) != hipSuccess) { fprintf(stderr, "kernel_launch: hipFuncSetAttribute failed\n"); grid = -1; return; }
        if (hipOccupancyMaxActiveBlocksPerMultiprocessor(&per_cu, (const void*)fwd, 512, LDS_BYTES) != hipSuccess || per_cu < 1) fprintf(stderr, "kernel_launch: occupancy query reports %d workgroups per CU\n", per_cu);
        (void)hipGetLastError();
        grid = cus;
    }
    if (grid < 0) return;
    if (hipMemsetAsync((char*)d_ws + WS_CTL, 0, CTL_ZERO_BYTES, stream) != hipSuccess) return;
    Args a{};
    for (int i = 0; i < 26; ++i) a.in[i] = (const float*)d_in[i];
    a.out = (float*)d_out; a.ws = (unsigned char*)d_ws; a.pad = 0;
#if MK_CUTS
    int li = 0;
    for (int k = 0; k < NPH; ++k) { if (!ph_on(k)) continue;
        a.ph_lo = k; a.ph_hi = k + 1; a.li = li++; hipLaunchKernelGGL(fwd, dim3(grid), dim3(512), LDS_BYTES, stream, a); }
#else
    a.ph_lo = 0; a.ph_hi = NPH; a.li = 0;
    hipLaunchKernelGGL(fwd, dim3(grid), dim3(512), LDS_BYTES, stream, a);
#endif
    const hipError_t le = hipPeekAtLastError();
    if (le != hipSuccess) fprintf(stderr, "kernel_launch: launch failed: %s\n", hipGetErrorName(le));
}
```

```cpp
#include <hip/hip_runtime.h>
#include <cstdio>
#include <cstdint>

#ifndef DBG_STOP
#define DBG_STOP 4
#endif
#ifndef REP_MASK
#define REP_MASK 0
#endif
#ifndef MK_CUTS
#define MK_CUTS 0
#endif

#define LAS __attribute__((address_space(3)))
#define GAS __attribute__((address_space(1)))
typedef unsigned short bf16;
typedef short bf16x8 __attribute__((ext_vector_type(8)));
typedef float f32x4 __attribute__((ext_vector_type(4)));
typedef float f32x2 __attribute__((ext_vector_type(2)));
typedef unsigned u32x4 __attribute__((ext_vector_type(4)));
typedef unsigned u32x2 __attribute__((ext_vector_type(2)));

constexpr int D = 1024, NBATCH = 8, SEQ = 8192, M = NBATCH * SEQ;
constexpr int NE = 32, DE = 512, NPAIR = 112;
constexpr float EPS = 1e-6f;
constexpr int NPH = 16;
constexpr int HP = 1088;
#ifdef ONLY_PH
__host__ __device__ constexpr bool ph_on(int k) { return ((ONLY_PH >> k) & 1) != 0; }
#else
__host__ __device__ constexpr bool ph_on(int k) { return (k <= 3) || (k >= 4 && k <= 6 && DBG_STOP >= 2) || (k >= 7 && k <= 11 && DBG_STOP >= 3) || (k >= 12 && k <= 14 && DBG_STOP >= 4) || k == 15; }
#endif

constexpr size_t MiB = 1u << 20;
constexpr size_t WS_CTL = 0, CTL_ZERO_BYTES = 1 * MiB;
constexpr size_t WS_WSB = 1 * MiB;
constexpr size_t WS_WAX = 1 * MiB + 256 * 1024;
constexpr size_t WS_WRT = 2 * MiB;
constexpr size_t WS_RSTD = 3 * MiB;
constexpr size_t WS_CAR = 4 * MiB;
constexpr size_t WS_ELT = 8 * MiB;
constexpr size_t WS_ELG = 16 * MiB;
constexpr size_t WS_PLT = 24 * MiB;
constexpr size_t WS_WREST = 52 * MiB;
constexpr size_t WS_WV = 56 * MiB;
constexpr size_t WS_WO = 57 * MiB;
constexpr size_t WS_WC = 59 * MiB;
constexpr size_t WS_WCO = 63 * MiB;
constexpr size_t WS_WGU = 65 * MiB;
constexpr size_t WS_WD = 193 * MiB;
constexpr size_t WS_H = 257 * MiB;
constexpr size_t WS_Z = 393 * MiB;
constexpr size_t WS_VT = 649 * MiB;
constexpr size_t WS_Y = 713 * MiB;
constexpr size_t WS_XB = 841 * MiB;
constexpr size_t WS_END = 969 * MiB;
constexpr int CW_TMO = 0;
constexpr int CW_ECNT = 8192;
constexpr int CW_PCNT = 12288;
constexpr int CW_BAR = 32768;
constexpr int LDS_BYTES = 147456;
constexpr int TAB_OFF = 131072;
constexpr int MISC_OFF = LDS_BYTES - 256;

__device__ __forceinline__ float bflo(unsigned w) { return __uint_as_float(w << 16); }
__device__ __forceinline__ float bfhi(unsigned w) { return __uint_as_float(w & 0xffff0000u); }
__device__ __forceinline__ float bf1(unsigned short b) { return __uint_as_float(((unsigned)b) << 16); }
__device__ __forceinline__ unsigned cvt_pk_bf16(float lo, float hi) { unsigned r; asm volatile("v_cvt_pk_bf16_f32 %0, %1, %2" : "=v"(r) : "v"(lo), "v"(hi)); return r; }
__device__ __forceinline__ float wave_sum(float v) {
#pragma unroll
    for (int o = 1; o < 64; o <<= 1) v += __shfl_xor(v, o);
    return v;
}
__device__ __forceinline__ float sigmoidf_(float x) { return __builtin_amdgcn_rcpf(1.0f + __builtin_amdgcn_exp2f(-1.44269504f * x)); }
__device__ __forceinline__ float gelu_tanh(float x) { const float z = x * (1.0f + 0.044715f * x * x); return x * __builtin_amdgcn_rcpf(1.0f + __builtin_amdgcn_exp2f(-2.3022082f * z)); }
#define LDS_WAIT() asm volatile("s_waitcnt lgkmcnt(0)" ::: "memory")
#define VM_WAIT() asm volatile("s_waitcnt vmcnt(0)" ::: "memory")

namespace pg8 {
constexpr int BM = 256, BK = 64, HALF = 128, HTB = HALF * BK * 2, STAGE_BYTES = 8 * HTB, NXCD = 8, WGM = 8;
__host__ __device__ __forceinline__ int lds_byte(int r, int c) { const int st = (r >> 4) * 2 + (c >> 5), rr = r & 15, cc = c & 31, ob = rr * 64 + cc * 2; return st * 1024 + (ob ^ (((ob >> 9) & 1) << 5)); }
__host__ __device__ __forceinline__ void stage_rc(int b, int& R, int& C) { const int st = b / 1024, sb = b % 1024, swz = sb ^ (((sb >> 9) & 1) << 5); R = (st >> 1) * 16 + swz / 64; C = (st & 1) * 32 + (swz % 64) / 2; }
__host__ __device__ __forceinline__ int perm32(int rho) { const int n = rho >> 4, i = rho & 15; return 8 * (i >> 2) + 4 * n + (i & 3); }

struct Unit { int pm, pn; const char* A; const char* B0; const char* B1; const unsigned* list; const float* glist; int nvalid; };

template <class Epi, class Sched, bool GATHER>
__device__ __forceinline__ void gemm_phase(LAS unsigned char* lds, const int lda, const int ldb, const int K, const int nth, const Sched& S, const Epi& E) {
    const int tid = threadIdx.x, wid = __builtin_amdgcn_readfirstlane(tid >> 6), lane = tid & 63, wr = wid >> 2, wc = wid & 3, fr = lane & 15, fq = lane >> 4;
    const int nt = K / BK;
    int Rr[2], Cc[2]; unsigned voffB[2];
#pragma unroll
    for (int i = 0; i < 2; ++i) { int R, C; stage_rc(tid * 16 + i * 8192, R, C); Rr[i] = R; Cc[i] = C; const int Rb = Epi::PERM ? ((R & ~31) + perm32(R & 31)) : R; voffB[i] = (unsigned)(Rb * ldb + C) * 2u; }
    const size_t kstep = (size_t)(BK * 2);
    const size_t hstepB = (size_t)HALF * ldb * 2;
    const unsigned ldsw = (unsigned)wid * 1024u;
    const int aoff = lds_byte(wr * 64 + fr, fq * 8), boff = lds_byte(wc * 32 + fr, fq * 8);
#define PG8_SA(b, h) (((b) * 2 + (h)) * HTB)
#define PG8_SB(b, h) ((4 + (b) * 2 + (h)) * HTB)
#define PG8_STAGE(bufoff, gbase, voff) do { _Pragma("unroll") for (int _i = 0; _i < 2; ++_i) \
        __builtin_amdgcn_global_load_lds((const unsigned*)((const char*)(gbase) + (voff)[_i]), (LAS unsigned*)(lds + (bufoff) + ldsw + _i * 8192), 16, 0, 0); } while (0)
#define PG8_LDA(dst, b, h) do { _Pragma("unroll") for (int m = 0; m < 4; ++m) _Pragma("unroll") for (int k = 0; k < 2; ++k) dst[m][k] = *(const LAS bf16x8*)(lds + PG8_SA(b, h) + aoff + m * 2048 + k * 1024); } while (0)
#define PG8_LDB(dst, b, h) do { _Pragma("unroll") for (int n = 0; n < 2; ++n) _Pragma("unroll") for (int k = 0; k < 2; ++k) dst[n][k] = *(const LAS bf16x8*)(lds + PG8_SB(b, h) + boff + n * 2048 + k * 1024); } while (0)
#define PG8_MMA(ai, bj, At, Bt) do { __builtin_amdgcn_s_setprio(1); _Pragma("unroll") for (int m = 0; m < 4; ++m) _Pragma("unroll") for (int n = 0; n < 2; ++n) _Pragma("unroll") for (int k = 0; k < 2; ++k) \
        acc[ai][bj][m][n] = __builtin_amdgcn_mfma_f32_16x16x32_bf16(Bt[n][k], At[m][k], acc[ai][bj][m][n], 0, 0, 0); __builtin_amdgcn_s_setprio(0); } while (0)
#define PG8_WAIT_V(n) asm volatile("s_waitcnt vmcnt(" #n ")" ::: "memory")
#define PG8_WAIT_L(n) asm volatile("s_waitcnt lgkmcnt(" #n ")" ::: "memory")
#define PG8_BAR __builtin_amdgcn_s_barrier()
#define PG8_SCHED __builtin_amdgcn_sched_barrier(0)
    Unit cur, nxt; int ui = 0;
    if (!S.next(0, cur)) return;
    unsigned offc[2][2], offn[2][2], nid[2][2];
#pragma unroll
    for (int h = 0; h < 2; ++h)
#pragma unroll
        for (int i = 0; i < 2; ++i) {
            const int r = Rr[i] + HALF * h;
            if constexpr (GATHER) { const unsigned ent = r < cur.nvalid ? cur.list[r] : 0u; offc[h][i] = (ent & 0x7fffffffu) * (unsigned)(lda * 2) + (unsigned)(Cc[i] * 2); }
            else offc[h][i] = (unsigned)(r * lda + Cc[i]) * 2u;
            offn[h][i] = offc[h][i]; nid[h][i] = 0u;
        }
    f32x4 acc[2][2][4][2];
#pragma unroll
    for (int a = 0; a < 2; ++a)
#pragma unroll
        for (int b = 0; b < 2; ++b)
#pragma unroll
            for (int m = 0; m < 4; ++m)
#pragma unroll
                for (int n = 0; n < 2; ++n) acc[a][b][m][n] = (f32x4){0.f, 0.f, 0.f, 0.f};
    bf16x8 At[4][2], B0[2][2], B1[2][2];
    const char* cA = cur.A; const char* cB0 = cur.B0; const char* cB1 = cur.B1;
    PG8_STAGE(PG8_SB(0, 0), cB0, voffB); PG8_STAGE(PG8_SB(0, 1), cB0 + hstepB, voffB); PG8_STAGE(PG8_SA(0, 0), cA, offc[0]); PG8_STAGE(PG8_SA(0, 1), cA, offc[1]);
    if (wr == 1) PG8_BAR;
    PG8_WAIT_V(2); PG8_BAR;
    PG8_STAGE(PG8_SB(1, 0), cB0 + kstep, voffB); PG8_STAGE(PG8_SA(1, 0), cA + kstep, offc[0]); PG8_STAGE(PG8_SB(1, 1), cB0 + hstepB + kstep, voffB);
    PG8_WAIT_V(6); PG8_BAR;
    for (;;) {
        const bool has_next = S.next(ui + 1, nxt);
        if constexpr (GATHER) {
            if (has_next) {
#pragma unroll
                for (int h = 0; h < 2; ++h)
#pragma unroll
                    for (int i = 0; i < 2; ++i) { const int r = Rr[i] + HALF * h; nid[h][i] = r < nxt.nvalid ? nxt.list[r] : 0u; }
            }
        }
        const char* nA = has_next ? nxt.A : cA; const char* nB0 = has_next ? nxt.B0 : cB0;
        for (int t = 0; t < nt; t += 2) {
            const bool last = (t == nt - 2);
            const char* a1 = cA + (size_t)(t + 1) * kstep;
            const char* a2 = last ? nA : cA + (size_t)(t + 2) * kstep;
            const char* b2 = last ? nB0 : ((t + 2 < nth) ? cB0 + (size_t)(t + 2) * kstep : cB1 + (size_t)(t + 2 - nth) * kstep);
            const char* a3 = a2 + kstep; const char* b3 = b2 + kstep;
            unsigned o2[2][2];
            if constexpr (GATHER) {
                if (last && has_next) {
#pragma unroll
                    for (int h = 0; h < 2; ++h)
#pragma unroll
                        for (int i = 0; i < 2; ++i) offn[h][i] = (nid[h][i] & 0x7fffffffu) * (unsigned)(lda * 2) + (unsigned)(Cc[i] * 2);
                }
#pragma unroll
                for (int h = 0; h < 2; ++h)
#pragma unroll
                    for (int i = 0; i < 2; ++i) o2[h][i] = (last && has_next) ? offn[h][i] : offc[h][i];
            } else {
#pragma unroll
                for (int h = 0; h < 2; ++h)
#pragma unroll
                    for (int i = 0; i < 2; ++i) o2[h][i] = offc[h][i];
            }
            PG8_LDB(B0, 0, 0); PG8_LDB(B1, 0, 1); PG8_SCHED; PG8_LDA(At, 0, 0); PG8_STAGE(PG8_SA(1, 1), a1, offc[1]);
            PG8_WAIT_V(8); PG8_WAIT_L(0); PG8_BAR; PG8_MMA(0, 0, At, B0); PG8_MMA(0, 1, At, B1); PG8_BAR; PG8_SCHED;
            PG8_LDA(At, 0, 1); PG8_STAGE(PG8_SB(0, 0), b2, voffB); PG8_STAGE(PG8_SB(0, 1), b2 + hstepB, voffB); PG8_STAGE(PG8_SA(0, 0), a2, o2[0]);
            PG8_WAIT_V(8); PG8_WAIT_L(0); PG8_BAR; PG8_MMA(1, 0, At, B0); PG8_MMA(1, 1, At, B1); PG8_BAR; PG8_SCHED;
            PG8_LDB(B0, 1, 0); PG8_LDB(B1, 1, 1); PG8_SCHED; PG8_LDA(At, 1, 0); PG8_STAGE(PG8_SA(0, 1), a2, o2[1]);
            PG8_WAIT_V(8); PG8_WAIT_L(0); PG8_BAR; PG8_MMA(0, 0, At, B0); PG8_MMA(0, 1, At, B1); PG8_BAR; PG8_SCHED;
            PG8_LDA(At, 1, 1); PG8_STAGE(PG8_SB(1, 0), b3, voffB); PG8_STAGE(PG8_SB(1, 1), b3 + hstepB, voffB); PG8_STAGE(PG8_SA(1, 0), a3, o2[0]);
            PG8_WAIT_V(8); PG8_WAIT_L(0); PG8_BAR; PG8_MMA(1, 0, At, B0); PG8_MMA(1, 1, At, B1); PG8_BAR; PG8_SCHED;
        }
        if (wr == 0) PG8_BAR;
        E(acc, cur, wr, wc, fr, fq);
        if (!has_next) break;
#pragma unroll
        for (int a = 0; a < 2; ++a)
#pragma unroll
            for (int b = 0; b < 2; ++b)
#pragma unroll
                for (int m = 0; m < 4; ++m)
#pragma unroll
                    for (int n = 0; n < 2; ++n) acc[a][b][m][n] = (f32x4){0.f, 0.f, 0.f, 0.f};
        cur = nxt; cA = nA; cB0 = nB0; cB1 = nxt.B1; ++ui;
        if constexpr (GATHER) {
#pragma unroll
            for (int h = 0; h < 2; ++h)
#pragma unroll
                for (int i = 0; i < 2; ++i) offc[h][i] = offn[h][i];
        }
        if (wr == 1) PG8_BAR;
    }
    PG8_WAIT_V(0);
    PG8_BAR;
#undef PG8_SA
#undef PG8_SB
#undef PG8_STAGE
#undef PG8_LDA
#undef PG8_LDB
#undef PG8_MMA
#undef PG8_WAIT_V
#undef PG8_WAIT_L
#undef PG8_BAR
#undef PG8_SCHED
}

struct DenseOrder {
    int nM, nN, nwg, G, c, same_tile = 0; const char* A; const char* B; size_t tA, tB, b1off;
    __device__ __forceinline__ void init(int Mr, int N, int G_, int c_, const void* A_, int lda, const void* B_, int ldb, int nth) {
        nM = Mr / BM; nN = N / BM; nwg = nM * nN; G = G_; c = c_; A = (const char*)A_; B = (const char*)B_; tA = (size_t)BM * lda * 2; tB = (size_t)BM * ldb * 2; b1off = (size_t)nth * BK * 2; }
    __device__ __forceinline__ bool next(int i, Unit& u) const {
        const long L = (long)i * G + c; if (L >= nwg) return false;
        int wgid = (int)L; { const int q = nwg / NXCD, r = nwg % NXCD, xcd = wgid % NXCD, off = wgid / NXCD; wgid = (xcd < r ? xcd * (q + 1) : r * (q + 1) + (xcd - r) * q) + off; }
        const int nig = WGM * nN, gid = wgid / nig, fm = gid * WGM, gsz = (nM - fm) < WGM ? (nM - fm) : WGM;
        u.pm = fm + ((wgid % nig) % gsz); u.pn = (wgid % nig) / gsz;
        u.A = A + (same_tile ? 0 : (size_t)u.pm * tA); u.B0 = B + (same_tile ? 0 : (size_t)u.pn * tB); u.B1 = u.B0 + b1off; u.list = nullptr; u.glist = nullptr; u.nvalid = BM; return true;
    }
};
__device__ __forceinline__ int find_group(const LAS int* pref, int n, int rt, int lane) {
    const int j0 = lane, j1 = lane + 64;
    const bool f0 = j0 < n && pref[j0] <= rt && rt < pref[j0 + 1];
    const bool f1 = j1 < n && pref[j1] <= rt && rt < pref[j1 + 1];
    const unsigned long long m0 = __ballot(f0), m1 = __ballot(f1);
    return m0 ? (int)__builtin_ctzll(m0) : 64 + (int)__builtin_ctzll(m1 | (1ull << 63));
}
template <bool PAIR> struct GroupOrder {
    static constexpr size_t WSTRIDE = PAIR ? (size_t)1024 * 512 * 2 : (size_t)1024 * 1024 * 2, TB = PAIR ? (size_t)256 * 512 * 2 : (size_t)256 * 1024 * 2;
    const LAS int* pref; int ng, G, c, lane;
    const char* A; const char* W; const unsigned* lists; const float* glists;
    __device__ __forceinline__ bool next(int i, Unit& u) const {
        const LAS int* cnt = pref + 130;
        const long L = (long)i * G + c; const int total = __builtin_amdgcn_readfirstlane(pref[ng]);
        if (L >= 4L * total) return false;
        const int rt = (int)(L >> 2); u.pn = (int)(L & 3);
        const int g = __builtin_amdgcn_readfirstlane(find_group(pref, ng, rt, lane));
        const int tr = rt - __builtin_amdgcn_readfirstlane(pref[g]); const int cg = __builtin_amdgcn_readfirstlane(cnt[g]);
        u.pm = tr; u.nvalid = (cg - tr * BM) < BM ? (cg - tr * BM) : BM;
        u.list = lists + (size_t)g * 65536 + (size_t)tr * BM; u.glist = PAIR ? nullptr : glists + (size_t)g * 65536 + (size_t)tr * BM;
        u.A = A;
        if (PAIR) { const int grp = g / 28; int pi = g % 28, lo = 0; while (pi >= 7 - lo) { pi -= 7 - lo; ++lo; } const int hi = lo + 1 + pi;
            u.B0 = W + (size_t)(grp * 8 + lo) * WSTRIDE + (size_t)u.pn * TB; u.B1 = W + (size_t)(grp * 8 + hi) * WSTRIDE + (size_t)u.pn * TB; }
        else { u.B0 = W + (size_t)g * WSTRIDE + (size_t)u.pn * TB; u.B1 = u.B0; }
        return true;
    }
};

struct EpiZ {
    static constexpr bool PERM = true;
    bf16* O; int ldc; int gelu_lt; int st_on;
    __device__ __forceinline__ void operator()(const f32x4 (&acc)[2][2][4][2], const Unit& u, int wr, int wc, int fr, int fq) const {
        if (!st_on) return;
        const int row0 = u.pm * BM + wr * 64 + fr, col0 = u.pn * BM + wc * 32 + 8 * fq; const bool act = u.pn < gelu_lt;
#pragma unroll
        for (int ai = 0; ai < 2; ++ai)
#pragma unroll
            for (int m = 0; m < 4; ++m) { bf16* rowp = O + (size_t)(row0 + ai * HALF + m * 16) * ldc + col0;
#pragma unroll
                for (int bj = 0; bj < 2; ++bj) { f32x4 v0 = acc[ai][bj][m][0], v1 = acc[ai][bj][m][1];
                    if (act) {
#pragma unroll
                        for (int j = 0; j < 4; ++j) { v0[j] = gelu_tanh(v0[j]); v1[j] = gelu_tanh(v1[j]); } }
                    u32x4 w; w.x = cvt_pk_bf16(v0[0], v0[1]); w.y = cvt_pk_bf16(v0[2], v0[3]); w.z = cvt_pk_bf16(v1[0], v1[1]); w.w = cvt_pk_bf16(v1[2], v1[3]);
                    *(u32x4*)(rowp + bj * HALF) = w; } }
    }
};
template <bool BASE_F32> struct EpiRes {
    static constexpr bool PERM = true;
    const void* __restrict__ base; bf16* __restrict__ out;
    __device__ __forceinline__ void operator()(f32x4 (&acc)[2][2][4][2], const Unit& u, int wr, int wc, int fr, int fq) const {
        const int row0 = u.pm * BM + wr * 64 + fr, col0 = u.pn * BM + wc * 32 + 8 * fq;
#pragma unroll
        for (int ai = 0; ai < 2; ++ai)
#pragma unroll
            for (int m = 0; m < 4; ++m) { const size_t off = (size_t)(row0 + ai * HALF + m * 16) * 1024 + col0;
#pragma unroll
                for (int bj = 0; bj < 2; ++bj) {
                    if (BASE_F32) { const float* bp = (const float*)base + off + bj * HALF; acc[ai][bj][m][0] += *(const f32x4*)bp; acc[ai][bj][m][1] += *(const f32x4*)(bp + 4); }
                    else { const u32x4 w = *(const u32x4*)((const bf16*)base + off + bj * HALF);
                        acc[ai][bj][m][0] += (f32x4){bflo(w.x), bfhi(w.x), bflo(w.y), bfhi(w.y)}; acc[ai][bj][m][1] += (f32x4){bflo(w.z), bfhi(w.z), bflo(w.w), bfhi(w.w)}; } } }
        asm volatile("" ::: "memory");
#pragma unroll
        for (int ai = 0; ai < 2; ++ai)
#pragma unroll
            for (int m = 0; m < 4; ++m) { const size_t off = (size_t)(row0 + ai * HALF + m * 16) * 1024 + col0;
#pragma unroll
                for (int bj = 0; bj < 2; ++bj) { const f32x4 v0 = acc[ai][bj][m][0], v1 = acc[ai][bj][m][1];
                    u32x4 w; w.x = cvt_pk_bf16(v0[0], v0[1]); w.y = cvt_pk_bf16(v0[2], v0[3]); w.z = cvt_pk_bf16(v1[0], v1[1]); w.w = cvt_pk_bf16(v1[2], v1[3]);
                    *(u32x4*)(out + off + bj * HALF) = w; } }
    }
};
struct EpiG1 {
    static constexpr bool PERM = true;
    bf16* HID;
    __device__ __forceinline__ void operator()(const f32x4 (&acc)[2][2][4][2], const Unit& u, int wr, int wc, int fr, int fq) const {
        const int col0 = u.pn * HALF + wc * 32 + 8 * fq;
#pragma unroll
        for (int ai = 0; ai < 2; ++ai)
#pragma unroll
            for (int m = 0; m < 4; ++m) { const int rl = ai * HALF + wr * 64 + m * 16 + fr;
                if (rl < u.nvalid) { const unsigned ent = u.list[rl]; const unsigned tok = ent & 0x7fffffffu, half = ent >> 31; const float gt = u.glist[rl];
                    float o[8];
#pragma unroll
                    for (int n = 0; n < 2; ++n)
#pragma unroll
                        for (int j = 0; j < 4; ++j) { const float g = acc[ai][0][m][n][j], up = acc[ai][1][m][n][j]; o[4 * n + j] = g * sigmoidf_(g) * up * gt; }
                    u32x4 w; w.x = cvt_pk_bf16(o[0], o[1]); w.y = cvt_pk_bf16(o[2], o[3]); w.z = cvt_pk_bf16(o[4], o[5]); w.w = cvt_pk_bf16(o[6], o[7]);
                    *(u32x4*)(HID + (size_t)tok * 1024 + half * 512 + col0) = w; } }
    }
};
struct EpiG2 {
    static constexpr bool PERM = true;
    bf16* out;
    __device__ __forceinline__ void operator()(f32x4 (&acc)[2][2][4][2], const Unit& u, int wr, int wc, int fr, int fq) const {
        const int col0 = u.pn * BM + wc * 32 + 8 * fq;
        unsigned tokv[2][4];
#pragma unroll
        for (int ai = 0; ai < 2; ++ai)
#pragma unroll
            for (int m = 0; m < 4; ++m) { const int rl = ai * HALF + wr * 64 + m * 16 + fr; tokv[ai][m] = rl < u.nvalid ? (u.list[rl] & 0x7fffffffu) : 0xffffffffu; }
#pragma unroll
        for (int ai = 0; ai < 2; ++ai)
#pragma unroll
            for (int m = 0; m < 4; ++m) if (tokv[ai][m] != 0xffffffffu) { const bf16* __restrict__ p = out + (size_t)tokv[ai][m] * 1024 + col0;
#pragma unroll
                for (int bj = 0; bj < 2; ++bj) { const u32x4 w = *(const u32x4*)(p + bj * HALF);
                    acc[ai][bj][m][0] += (f32x4){bflo(w.x), bfhi(w.x), bflo(w.y), bfhi(w.y)}; acc[ai][bj][m][1] += (f32x4){bflo(w.z), bfhi(w.z), bflo(w.w), bfhi(w.w)}; } }
        asm volatile("" ::: "memory");
#pragma unroll
        for (int ai = 0; ai < 2; ++ai)
#pragma unroll
            for (int m = 0; m < 4; ++m) if (tokv[ai][m] != 0xffffffffu) { bf16* __restrict__ p = out + (size_t)tokv[ai][m] * 1024 + col0;
#pragma unroll
                for (int bj = 0; bj < 2; ++bj) { const f32x4 v0 = acc[ai][bj][m][0], v1 = acc[ai][bj][m][1];
                    u32x4 w; w.x = cvt_pk_bf16(v0[0], v0[1]); w.y = cvt_pk_bf16(v0[2], v0[3]); w.z = cvt_pk_bf16(v1[0], v1[1]); w.w = cvt_pk_bf16(v1[2], v1[3]);
                    *(u32x4*)(p + bj * HALF) = w; } }
    }
};
}

#define XB_TMO      128
#define XB_XCNT(j)  (256  + 64 * (j))
#define XB_XSUB(j)  (1280 + 64 * (j))
#define XB_XGEN(j)  (2304 + 64 * (j))
#define XB_TOP      3328
#define XB_TOPGEN   3392
#define XCD_BAR_WORDS 3456
#define XB_SPIN_CAP (1u << 18)
__device__ __forceinline__ unsigned xb_ld(unsigned* p)              { return __hip_atomic_load(p, __ATOMIC_RELAXED, __HIP_MEMORY_SCOPE_AGENT); }
__device__ __forceinline__ unsigned xb_add(unsigned* p, unsigned v) { return __hip_atomic_fetch_add(p, v, __ATOMIC_RELAXED, __HIP_MEMORY_SCOPE_AGENT); }
__device__ __forceinline__ unsigned xb_xcc_id() { return (unsigned)__builtin_amdgcn_s_getreg((3 << 11) | 20) & 0xFu; }
#define XB_SPIN(cond, bar) do { unsigned _sp = 0; while (cond) { __builtin_amdgcn_s_sleep(1); \
    if ((++_sp & 255u) == 0u) { if (xb_ld(&(bar)[XB_TMO])) break; if (_sp > XB_SPIN_CAP) { atomicAdd(&(bar)[XB_TMO], 1u); break; } } } } while (0)
struct XcdBarrier { unsigned* bar; unsigned x; volatile LAS unsigned* st; };
__device__ __forceinline__ XcdBarrier xcd_barrier_post(unsigned* bar, volatile LAS unsigned* st) {
    XcdBarrier b; b.bar = bar; b.x = xb_xcc_id(); b.st = st;
    if (threadIdx.x == 0) (void)xb_add(&bar[XB_XCNT(b.x)], 1u);
    return b;
}
__device__ __forceinline__ void xcd_barrier_complete(unsigned* bar, unsigned x, unsigned& nloc, unsigned& nx) {
    const unsigned G = gridDim.x * gridDim.y * gridDim.z;
    unsigned sum, cnt, mine, sp = 0u;
    for (;;) {
        sum = 0u; cnt = 0u; mine = 0u;
#pragma unroll
        for (unsigned j = 0; j < 16; ++j) { const unsigned c = xb_ld(&bar[XB_XCNT(j)]); sum += c; cnt += (c > 0u) ? 1u : 0u; mine = (j == x) ? c : mine; }
        if (sum == G) break;
        __builtin_amdgcn_s_sleep(1);
        if ((++sp & 255u) == 0u) { if (xb_ld(&bar[XB_TMO])) break; if (sp > XB_SPIN_CAP) { atomicAdd(&bar[XB_TMO], 1u); break; } }
    }
    nloc = mine > 0u ? mine : 1u; nx = cnt > 0u ? cnt : 1u;
}
__device__ __forceinline__ void xcd_barrier(const XcdBarrier& b) {
    asm volatile("s_waitcnt vmcnt(0)" ::: "memory");
    __syncthreads();
    if (threadIdx.x == 0) {
        unsigned* bar = b.bar;
        __builtin_amdgcn_s_waitcnt(0);
        unsigned nloc = b.st[0], nx = b.st[1];
        if (nloc == 0u) { xcd_barrier_complete(bar, b.x, nloc, nx); b.st[0] = nloc; b.st[1] = nx; }
        const unsigned old = xb_add(&bar[XB_XSUB(b.x)], 1u);
        const unsigned gen = old / nloc;
        if (old + 1u == (gen + 1u) * nloc) {
            __builtin_amdgcn_fence(__ATOMIC_RELEASE, "agent");
            asm volatile("s_waitcnt vmcnt(0)" ::: "memory");
            const unsigned og = xb_add(&bar[XB_TOP], 1u);
            const unsigned tg = og / nx;
            if (og + 1u == (tg + 1u) * nx) xb_add(&bar[XB_TOPGEN], 1u);
            else XB_SPIN(xb_ld(&bar[XB_TOPGEN]) == tg, bar);
            __builtin_amdgcn_fence(__ATOMIC_ACQUIRE, "agent");
            xb_add(&bar[XB_XGEN(b.x)], 1u);
            asm volatile("s_waitcnt vmcnt(0)" ::: "memory");
        } else {
            XB_SPIN(xb_ld(&bar[XB_XGEN(b.x)]) == gen, bar);
            __builtin_amdgcn_fence(__ATOMIC_ACQUIRE, "agent");
            asm volatile("s_waitcnt vmcnt(0)" ::: "memory");
        }
    }
    __syncthreads();
}

__device__ __forceinline__ void tr_item(const float* W, int ldw, int k0, int n0, bf16* WT, int ldt, int rd0, LAS float* scr, int lane) {
    float wv[32];
#pragma unroll
    for (int i = 0; i < 32; ++i) wv[i] = W[(size_t)(k0 + 2 * i + (lane >> 5)) * ldw + n0 + (lane & 31)];
#pragma unroll
    for (int i = 0; i < 32; ++i) scr[(2 * i + (lane >> 5)) * 33 + (lane & 31)] = wv[i];
    LDS_WAIT(); asm volatile("" ::: "memory");
    const int c = lane & 7;
#pragma unroll
    for (int j = 0; j < 4; ++j) { const int n = (lane >> 3) + 8 * j; const LAS float* s = scr + (8 * c) * 33 + n;
        u32x4 o; o.x = cvt_pk_bf16(s[0 * 33], s[1 * 33]); o.y = cvt_pk_bf16(s[2 * 33], s[3 * 33]); o.z = cvt_pk_bf16(s[4 * 33], s[5 * 33]); o.w = cvt_pk_bf16(s[6 * 33], s[7 * 33]);
        *(u32x4*)(WT + (size_t)(rd0 + n) * ldt + k0 + 8 * c) = o; }
    LDS_WAIT(); asm volatile("" ::: "memory");
}
__device__ __forceinline__ void norm_row(const float* xrow, const float* g, bf16* hrow, int lane) {
    const f32x4* xr = (const f32x4*)xrow + lane; const f32x4* gr = (const f32x4*)g + lane;
    f32x4 v[4]; float s = 0.f;
#pragma unroll
    for (int j = 0; j < 4; ++j) { v[j] = xr[64 * j]; s += (v[j].x * v[j].x + v[j].y * v[j].y) + (v[j].z * v[j].z + v[j].w * v[j].w); }
    const float rs = 1.0f / sqrtf(wave_sum(s) * (1.0f / D) + EPS);
    u32x2* o8 = (u32x2*)hrow + lane;
#pragma unroll
    for (int j = 0; j < 4; ++j) { const f32x4 gv = gr[64 * j] * rs; u32x2 w; w.x = cvt_pk_bf16(v[j].x * gv.x, v[j].y * gv.y); w.y = cvt_pk_bf16(v[j].z * gv.z, v[j].w * gv.w); o8[64 * j] = w; }
}

struct Args { const float* in[26]; float* out; unsigned char* ws; int ph_lo, ph_hi, li, pad; };

__device__ __forceinline__ void p0_prologue(const Args& a, LAS unsigned char* lds, int G, int wave, int lane) {
    unsigned char* ws = a.ws;
    LAS float* scr = (LAS float*)(lds + wave * 16384);
    const int gw = blockIdx.x * 8 + wave, NGW = G * 8;
    constexpr int I_IN = 16 * 80, I_OUT = 16 * 32, I_CIN = 16 * 64, I_CO = 16 * 32, I_AX = 8 * 2 * 8, I_MOE = 64 * 768, I_RT = 2 * 16;
    constexpr int NITEMS = I_IN + I_OUT + I_CIN + I_CO + I_AX + I_MOE + I_RT;
    for (int it = gw; it < NITEMS; it += NGW) {
        int r = it;
        if (r < I_IN) { const int kb = r / 80, nb = r % 80, n0 = 32 * nb;
            if (n0 < 512) tr_item(a.in[4], 2560, 64 * kb, n0, (bf16*)(ws + WS_WREST), 1024, n0, scr, lane);
            else if (n0 < 1024) tr_item(a.in[4], 2560, 64 * kb, n0, (bf16*)(ws + WS_WV), 1024, n0 - 512, scr, lane);
            else tr_item(a.in[4], 2560, 64 * kb, n0, (bf16*)(ws + WS_WREST), 1024, n0 - 512, scr, lane);
            continue; } r -= I_IN;
        if (r < I_OUT) { tr_item(a.in[9], 1024, 64 * (r / 32), 32 * (r % 32), (bf16*)(ws + WS_WO), 1024, 32 * (r % 32), scr, lane); continue; } r -= I_OUT;
        if (r < I_CIN) { tr_item(a.in[10], 2048, 64 * (r / 64), 32 * (r % 64), (bf16*)(ws + WS_WC), 1024, 32 * (r % 64), scr, lane); continue; } r -= I_CIN;
        if (r < I_CO) { tr_item(a.in[18], 1024, 64 * (r / 32), 32 * (r % 32), (bf16*)(ws + WS_WCO), 1024, 32 * (r % 32), scr, lane); continue; } r -= I_CO;
        if (r < I_AX) { const int h = r / 16, gate = (r / 8) & 1, kb = (r / 4) & 1, nb = r & 3;
            tr_item((gate ? a.in[15] : a.in[13]) + (size_t)h * 16384, 128, 64 * kb, 32 * nb, (bf16*)(ws + WS_WAX) + (size_t)h * 256 * 128, 128, gate * 128 + 32 * nb, scr, lane); continue; } r -= I_AX;
        if (r < I_MOE) { const int le = r / 768, q = r % 768;
            if (q < 512) { const int up = q / 256, qq = q % 256, kb = qq / 16, nb = qq % 16, n0 = 32 * nb;
                tr_item((up ? a.in[24] : a.in[23]) + (size_t)le * 1024 * 512, 512, 64 * kb, n0, (bf16*)(ws + WS_WGU) + (size_t)le * 1024 * 1024, 1024, (n0 / 128) * 256 + up * 128 + (n0 % 128), scr, lane); }
            else { const int qq = q - 512, kb = qq / 32, nb = qq % 32;
                tr_item(a.in[25] + (size_t)le * 512 * 1024, 1024, 64 * kb, 32 * nb, (bf16*)(ws + WS_WD) + (size_t)le * 1024 * 512, 512, 32 * nb, scr, lane); }
            continue; } r -= I_MOE;
        { const int l = r / 16, kb = r % 16; tr_item(a.in[21] + (size_t)l * 1024 * 32, 32, 64 * kb, 0, (bf16*)(ws + WS_WRT) + (size_t)l * 48 * 1024, 1024, 0, scr, lane); }
    }
    const int gt = blockIdx.x * 512 + threadIdx.x, NGT = G * 512;
    for (int i = gt; i < 2 * 16 * 1024; i += NGT) {
        const int l = i / 16384, n = (i / 1024) & 15, k = i & 1023;
        const float v = n < 4 ? a.in[19][(size_t)l * 4096 + k * 4 + n] : 0.f;
        ((bf16*)(ws + WS_WRT))[(size_t)l * 48 * 1024 + (size_t)(32 + n) * 1024 + k] = (bf16)(cvt_pk_bf16(v, 0.f) & 0xffffu); }
    for (int i = gt; i < 4 * 128 * 128; i += NGT) {
        const int t = (i >> 7) & 127, s = i & 127; const float v = s <= t ? a.in[6][i] : 0.f;
        ((bf16*)(ws + WS_WSB))[i] = (bf16)(cvt_pk_bf16(v, 0.f) & 0xffffu); }
    for (int m = gw; m < M; m += NGW) norm_row(a.in[0] + (size_t)m * D, a.in[1], (bf16*)(ws + WS_H) + (size_t)m * HP, lane);
}
__device__ __forceinline__ void norm_phase(const bf16* xb, const float* g, bf16* H, int G, int wave, int lane) {
    const int gw = blockIdx.x * 8 + wave, NGW = G * 8;
    for (int m = gw; m < M; m += NGW) {
        const u32x4* xr = (const u32x4*)(xb + (size_t)m * D) + lane; u32x4* hr = (u32x4*)(H + (size_t)m * HP) + lane;
        u32x4 v[2]; float s = 0.f;
#pragma unroll
        for (int j = 0; j < 2; ++j) { v[j] = xr[64 * j];
#pragma unroll
            for (int k = 0; k < 4; ++k) { const float lo = bflo(v[j][k]), hi = bfhi(v[j][k]); s += lo * lo + hi * hi; } }
        const float rs = 1.0f / sqrtf(wave_sum(s) * (1.0f / D) + EPS);
#pragma unroll
        for (int j = 0; j < 2; ++j) { const f32x4 g0 = *(const f32x4*)(g + 8 * lane + 512 * j) * rs, g1 = *(const f32x4*)(g + 8 * lane + 512 * j + 4) * rs; u32x4 o;
            o.x = cvt_pk_bf16(bflo(v[j].x) * g0.x, bfhi(v[j].x) * g0.y); o.y = cvt_pk_bf16(bflo(v[j].y) * g0.z, bfhi(v[j].y) * g0.w);
            o.z = cvt_pk_bf16(bflo(v[j].z) * g1.x, bfhi(v[j].z) * g1.y); o.w = cvt_pk_bf16(bflo(v[j].w) * g1.z, bfhi(v[j].w) * g1.w); hr[64 * j] = o; }
    }
}
__device__ __forceinline__ void final_norm_phase(const bf16* xb, float* out, const float* g, int G, int wave, int lane) {
    const int gw = blockIdx.x * 8 + wave, NGW = G * 8;
    for (int m = gw; m < M; m += NGW) {
        const u32x4* xr = (const u32x4*)(xb + (size_t)m * D) + lane; float* orow = out + (size_t)m * D;
        u32x4 v[2]; float s = 0.f;
#pragma unroll
        for (int j = 0; j < 2; ++j) { v[j] = xr[64 * j];
#pragma unroll
            for (int k = 0; k < 4; ++k) { const float lo = bflo(v[j][k]), hi = bfhi(v[j][k]); s += lo * lo + hi * hi; } }
        const float rs = 1.0f / sqrtf(wave_sum(s) * (1.0f / D) + EPS);
#pragma unroll
        for (int j = 0; j < 2; ++j) { const f32x4 g0 = *(const f32x4*)(g + 8 * lane + 512 * j), g1 = *(const f32x4*)(g + 8 * lane + 512 * j + 4);
            *(f32x4*)(orow + 8 * lane + 512 * j) = (f32x4){bflo(v[j].x) * rs * g0.x, bfhi(v[j].x) * rs * g0.y, bflo(v[j].y) * rs * g0.z, bfhi(v[j].y) * rs * g0.w};
            *(f32x4*)(orow + 8 * lane + 512 * j + 4) = (f32x4){bflo(v[j].z) * rs * g1.x, bfhi(v[j].z) * rs * g1.y, bflo(v[j].w) * rs * g1.z, bfhi(v[j].w) * rs * g1.w}; }
    }
}

__device__ __forceinline__ void p2_spatial(const Args& a, LAS unsigned char* lds, int G, int wave, int lane) {
    const bf16* ZR = (const bf16*)(a.ws + WS_Z); const bf16* VT = (const bf16*)(a.ws + WS_VT); bf16* Y = (bf16*)(a.ws + WS_Y); const bf16* WSB = (const bf16*)(a.ws + WS_WSB);
    LAS unsigned char* T = lds;
    LAS float* MU = (LAS float*)(lds + 131072); LAS float* RS = MU + 128; LAS float* PART = (LAS float*)(lds + 131072 + 1024);
    const int tid = threadIdx.x, fr = lane & 15, fq = lane >> 4;
    for (int unit = blockIdx.x; unit < M / 128; unit += G) {
        const size_t row0 = (size_t)unit * 128;
        {
            const int cg = tid & 63, rg = tid >> 6, c0 = 8 * cg; const size_t R = row0 + 16 * rg;
            float w0[8], w1[8], w2[8], p2v[8], p1v[8];
#pragma unroll
            for (int j = 0; j < 8; ++j) { w0[j] = a.in[8][c0 + j]; w1[j] = a.in[8][512 + c0 + j]; w2[j] = a.in[8][1024 + c0 + j]; p2v[j] = 0.f; p1v[j] = 0.f; }
            if ((R & (SEQ - 1)) != 0) {
                const u32x4 gc2 = *(const u32x4*)(ZR + (R - 2) * 2048 + 1024 + c0), xb2 = *(const u32x4*)(ZR + (R - 2) * 2048 + 1536 + c0);
                const u32x4 gc1 = *(const u32x4*)(ZR + (R - 1) * 2048 + 1024 + c0), xb1 = *(const u32x4*)(ZR + (R - 1) * 2048 + 1536 + c0);
#pragma unroll
                for (int j = 0; j < 4; ++j) { p2v[2 * j] = bflo(gc2[j]) * bflo(xb2[j]); p2v[2 * j + 1] = bfhi(gc2[j]) * bfhi(xb2[j]); p1v[2 * j] = bflo(gc1[j]) * bflo(xb1[j]); p1v[2 * j + 1] = bfhi(gc1[j]) * bfhi(xb1[j]); }
            }
#pragma unroll 4
            for (int r = 0; r < 16; ++r) { const bf16* zr = ZR + (R + r) * 2048 + c0;
                const u32x4 gb = *(const u32x4*)(zr + 512), gc = *(const u32x4*)(zr + 1024), xb = *(const u32x4*)(zr + 1536);
                float cx[8], y[8];
#pragma unroll
                for (int j = 0; j < 4; ++j) { cx[2 * j] = bflo(gc[j]) * bflo(xb[j]); cx[2 * j + 1] = bfhi(gc[j]) * bfhi(xb[j]); }
#pragma unroll
                for (int j = 0; j < 8; ++j) { const float gbj = (j & 1) ? bfhi(gb[j >> 1]) : bflo(gb[j >> 1]); y[j] = gbj * (w0[j] * p2v[j] + w1[j] * p1v[j] + w2[j] * cx[j]); p2v[j] = p1v[j]; p1v[j] = cx[j]; }
                u32x4 o; o.x = cvt_pk_bf16(y[0], y[1]); o.y = cvt_pk_bf16(y[2], y[3]); o.z = cvt_pk_bf16(y[4], y[5]); o.w = cvt_pk_bf16(y[6], y[7]);
                *(u32x4*)(Y + (R + r) * 1024 + 512 + c0) = o; }
        }
#pragma unroll 4
        for (int p = 0; p < 16; ++p) { const int row = p * 32 + (tid >> 4), ch = tid & 15;
            const u32x4 v = *(const u32x4*)(VT + (size_t)row * M + row0 + ch * 8);
            *(LAS u32x4*)(T + row * 256 + ((ch ^ (row & 15)) << 4)) = v; }
        __syncthreads();
        const int sg = tid & 15, dg = tid >> 4;
        {   float s[8], q[8];
#pragma unroll
            for (int j = 0; j < 8; ++j) { s[j] = 0.f; q[j] = 0.f; }
#pragma unroll 4
            for (int rr = 0; rr < 16; ++rr) { const u32x4 v = *(const LAS u32x4*)(T + (16 * dg + rr) * 256 + ((sg ^ rr) << 4));
#pragma unroll
                for (int j = 0; j < 4; ++j) { const float lo = bflo(v[j]), hi = bfhi(v[j]); s[2 * j] += lo; q[2 * j] += lo * lo; s[2 * j + 1] += hi; q[2 * j + 1] += hi * hi; } }
#pragma unroll
            for (int j = 0; j < 8; ++j) { s[j] += __shfl_xor(s[j], 16); s[j] += __shfl_xor(s[j], 32); q[j] += __shfl_xor(q[j], 16); q[j] += __shfl_xor(q[j], 32); }
            if (lane < 16) {
#pragma unroll
                for (int j = 0; j < 8; ++j) { PART[(wave * 128 + 8 * sg + j) * 2] = s[j]; PART[(wave * 128 + 8 * sg + j) * 2 + 1] = q[j]; } }
        }
        __syncthreads();
        if (tid < 128) { float s = 0.f, q = 0.f;
#pragma unroll
            for (int w = 0; w < 8; ++w) { s += PART[(w * 128 + tid) * 2]; q += PART[(w * 128 + tid) * 2 + 1]; }
            const float mean = s * (1.0f / 512.0f); float var = q * (1.0f / 512.0f) - mean * mean; var = var > 0.f ? var : 0.f;
            MU[tid] = mean; RS[tid] = 1.0f / sqrtf(var + EPS); }
        __syncthreads();
        {   float mu8[8], rs8[8];
#pragma unroll
            for (int j = 0; j < 8; ++j) { mu8[j] = MU[8 * sg + j]; rs8[j] = RS[8 * sg + j]; }
#pragma unroll 4
            for (int rr = 0; rr < 16; ++rr) { const int row = 16 * dg + rr; const float gd = a.in[5][row]; LAS u32x4* pp = (LAS u32x4*)(T + row * 256 + ((sg ^ rr) << 4)); const u32x4 v = *pp; u32x4 o;
#pragma unroll
                for (int j = 0; j < 4; ++j) o[j] = cvt_pk_bf16((bflo(v[j]) - mu8[2 * j]) * rs8[2 * j] * gd, (bfhi(v[j]) - mu8[2 * j + 1]) * rs8[2 * j + 1] * gd);
                *pp = o; }
        }
        __syncthreads();
        {   const int hh = wave >> 1, rh = wave & 1;
#pragma unroll 1
            for (int nh = 0; nh < 2; ++nh) {
                f32x4 acc[4][4];
#pragma unroll
                for (int m = 0; m < 4; ++m)
#pragma unroll
                    for (int n = 0; n < 4; ++n) acc[m][n] = (f32x4){0.f, 0.f, 0.f, 0.f};
#pragma unroll
                for (int ks = 0; ks < 4; ++ks) { bf16x8 Af[4];
#pragma unroll
                    for (int m = 0; m < 4; ++m) Af[m] = *(const bf16x8*)(WSB + (size_t)((hh * 128 + 64 * rh + 16 * m + fr) * 128 + 32 * ks + 8 * fq));
#pragma unroll
                    for (int n = 0; n < 4; ++n) { const bf16x8 Bf = *(const LAS bf16x8*)(T + (hh * 128 + 64 * nh + 16 * n + fr) * 256 + (((4 * ks + fq) ^ fr) << 4));
#pragma unroll
                        for (int m = 0; m < 4; ++m) acc[m][n] = __builtin_amdgcn_mfma_f32_16x16x32_bf16(Bf, Af[m], acc[m][n], 0, 0, 0); } }
#pragma unroll
                for (int m = 0; m < 4; ++m) { const int t = 64 * rh + 16 * m + fr; const size_t R = row0 + t; const float bias = a.in[7][hh * 128 + t];
#pragma unroll
                    for (int n = 0; n < 4; ++n) { const int d = hh * 128 + 64 * nh + 16 * n + 4 * fq; const u32x2 u4 = *(const u32x2*)(ZR + R * 2048 + d);
                        u32x2 o; o.x = cvt_pk_bf16(bflo(u4.x) * (acc[m][n][0] + bias), bfhi(u4.x) * (acc[m][n][1] + bias)); o.y = cvt_pk_bf16(bflo(u4.y) * (acc[m][n][2] + bias), bfhi(u4.y) * (acc[m][n][3] + bias));
                        *(u32x2*)(Y + R * 1024 + d) = o; } }
            }
        }
        __syncthreads();
    }
}

__device__ __forceinline__ void route_phase(const Args& a, int l, LAS unsigned char* lds, int G, int wave, int lane) {
    const bf16* X = (const bf16*)(a.ws + WS_XB); bf16* H = (bf16*)(a.ws + WS_H);
    const bf16* WRT = (const bf16*)(a.ws + WS_WRT) + (size_t)l * 48 * 1024; const float* gvec = a.in[2] + l * 1024;
    const float* brg = a.in[20] + l * 4; const float* bre = a.in[22] + l * 32;
    unsigned* ECNT = (unsigned*)(a.ws + WS_CTL) + CW_ECNT + l * 2048; unsigned* PCNT = (unsigned*)(a.ws + WS_CTL) + CW_PCNT + l * 7168;
    unsigned* ELT = (unsigned*)(a.ws + WS_ELT); float* ELG = (float*)(a.ws + WS_ELG); unsigned* PLT = (unsigned*)(a.ws + WS_PLT);
    constexpr int WROW = 2064;
    LAS unsigned char* WL = lds; LAS float* GL = (LAS float*)(lds + 99072); LAS float* SCR = (LAS float*)(lds + 103168) + wave * 768;
    LAS int* TOK = (LAS int*)(lds + 127744);
    LAS int* HIST = (LAS int*)(lds + 135936);
    const int tid = threadIdx.x, fr = lane & 15, fq = lane >> 4;
    for (int tile = blockIdx.x; tile < M / 256; tile += G) {
        __syncthreads();
        for (int i = tid; i < 48 * 128; i += 512) { const int row = i >> 7, ch = i & 127; *(LAS u32x4*)(WL + row * WROW + ch * 16) = *(const u32x4*)(WRT + (size_t)row * 1024 + ch * 8); }
        if (tid < 256) *(LAS f32x4*)(GL + 4 * tid) = *(const f32x4*)(gvec + 4 * tid);
        if (tid < 288) HIST[tid] = 0;
        __syncthreads();
        for (int mt = 2 * wave; mt < 2 * wave + 2; ++mt) {
            const size_t row = (size_t)tile * 256 + 16 * mt + fr; const bf16* xr = X + row * D; bf16* hr = H + row * HP;
            f32x4 acc[3]; acc[0] = acc[1] = acc[2] = (f32x4){0.f, 0.f, 0.f, 0.f}; float ss = 0.f;
#pragma unroll 1
            for (int kb = 0; kb < 4; ++kb) {
                u32x4 xv[8];
#pragma unroll
                for (int j = 0; j < 8; ++j) xv[j] = *(const u32x4*)(xr + 32 * (8 * kb + j) + 8 * fq);
#pragma unroll
                for (int j = 0; j < 8; ++j) { const int k0 = 32 * (8 * kb + j) + 8 * fq; const u32x4 xw = xv[j];
                    const f32x4 x0 = (f32x4){bflo(xw.x), bfhi(xw.x), bflo(xw.y), bfhi(xw.y)}, x1 = (f32x4){bflo(xw.z), bfhi(xw.z), bflo(xw.w), bfhi(xw.w)};
                    const f32x4 g0 = *(const LAS f32x4*)(GL + k0), g1 = *(const LAS f32x4*)(GL + k0 + 4);
                    ss += (x0.x * x0.x + x0.y * x0.y) + (x0.z * x0.z + x0.w * x0.w) + (x1.x * x1.x + x1.y * x1.y) + (x1.z * x1.z + x1.w * x1.w);
                    u32x4 hw; hw.x = cvt_pk_bf16(x0.x * g0.x, x0.y * g0.y); hw.y = cvt_pk_bf16(x0.z * g0.z, x0.w * g0.w); hw.z = cvt_pk_bf16(x1.x * g1.x, x1.y * g1.y); hw.w = cvt_pk_bf16(x1.z * g1.z, x1.w * g1.w);
                    const bf16x8 Af = __builtin_bit_cast(bf16x8, hw);
#pragma unroll
                    for (int n = 0; n < 3; ++n) { const bf16x8 Bf = *(const LAS bf16x8*)(WL + (16 * n + fr) * WROW + k0 * 2); acc[n] = __builtin_amdgcn_mfma_f32_16x16x32_bf16(Bf, Af, acc[n], 0, 0, 0); } } }
            ss += __shfl_xor(ss, 16); ss += __shfl_xor(ss, 32);
            const float rstd = 1.0f / sqrtf(ss * (1.0f / D) + EPS);
#pragma unroll 1
            for (int kb = 0; kb < 4; ++kb) {
                u32x4 xv[8];
#pragma unroll
                for (int j = 0; j < 8; ++j) xv[j] = *(const u32x4*)(xr + 32 * (8 * kb + j) + 8 * fq);
#pragma unroll
                for (int j = 0; j < 8; ++j) { const int k0 = 32 * (8 * kb + j) + 8 * fq; const u32x4 xw = xv[j];
                    const f32x4 g0 = *(const LAS f32x4*)(GL + k0) * rstd, g1 = *(const LAS f32x4*)(GL + k0 + 4) * rstd; u32x4 hw;
                    hw.x = cvt_pk_bf16(bflo(xw.x) * g0.x, bfhi(xw.x) * g0.y); hw.y = cvt_pk_bf16(bflo(xw.y) * g0.z, bfhi(xw.y) * g0.w);
                    hw.z = cvt_pk_bf16(bflo(xw.z) * g1.x, bfhi(xw.z) * g1.y); hw.w = cvt_pk_bf16(bflo(xw.w) * g1.z, bfhi(xw.w) * g1.w);
                    *(u32x4*)(hr + k0) = hw; } }
#pragma unroll
            for (int n = 0; n < 3; ++n)
#pragma unroll
                for (int j = 0; j < 4; ++j) SCR[fr * 48 + 16 * n + 4 * fq + j] = acc[n][j] * rstd;
            LDS_WAIT(); asm volatile("" ::: "memory");
            if (lane < 16) { const LAS float* lg = SCR + lane * 48;
                float gl[4]; int gi = 0; float gm;
#pragma unroll
                for (int j = 0; j < 4; ++j) gl[j] = lg[32 + j] + brg[j];
                gm = gl[0];
#pragma unroll
                for (int j = 1; j < 4; ++j) if (gl[j] > gm) { gm = gl[j]; gi = j; }
                float den = 0.f;
#pragma unroll
                for (int j = 0; j < 4; ++j) den += __expf(gl[j] - gm);
                const float gp = 1.0f / den;
                float el[8];
#pragma unroll
                for (int j = 0; j < 8; ++j) el[j] = lg[8 * gi + j] + bre[8 * gi + j];
                int i1 = 0; float v1 = el[0];
#pragma unroll
                for (int j = 1; j < 8; ++j) if (el[j] > v1) { v1 = el[j]; i1 = j; }
                int i2 = -1; float v2 = -3.0e38f;
#pragma unroll
                for (int j = 0; j < 8; ++j) if (j != i1 && el[j] > v2) { v2 = el[j]; i2 = j; }
                const float e21 = __expf(v2 - v1), p1 = 1.0f / (1.0f + e21), p2 = e21 * p1;
                const int e1 = 8 * gi + i1, e2 = 8 * gi + i2; const int lo = i1 < i2 ? i1 : i2, hi = i1 < i2 ? i2 : i1;
                const int p = gi * 28 + (lo * (15 - lo)) / 2 + (hi - lo - 1);
                LAS int* tk = TOK + (16 * mt + lane) * 8;
                tk[0] = e1; tk[1] = e2; tk[2] = __float_as_int(gp * p1); tk[3] = __float_as_int(gp * p2);
                tk[4] = __hip_atomic_fetch_add(HIST + e1, 1, __ATOMIC_RELAXED, __HIP_MEMORY_SCOPE_WORKGROUP); tk[5] = __hip_atomic_fetch_add(HIST + e2, 1, __ATOMIC_RELAXED, __HIP_MEMORY_SCOPE_WORKGROUP); tk[6] = __hip_atomic_fetch_add(HIST + 32 + p, 1, __ATOMIC_RELAXED, __HIP_MEMORY_SCOPE_WORKGROUP); tk[7] = p; }
            LDS_WAIT(); asm volatile("" ::: "memory");
        }
        __syncthreads();
        if (tid < 32) { const int c = HIST[tid]; HIST[144 + tid] = c ? (int)__hip_atomic_fetch_add(ECNT + 64 * tid, (unsigned)c, __ATOMIC_RELAXED, __HIP_MEMORY_SCOPE_AGENT) : 0; }
        else if (tid < 144) { const int j = tid - 32; const int c = HIST[32 + j]; HIST[176 + j] = c ? (int)__hip_atomic_fetch_add(PCNT + 64 * j, (unsigned)c, __ATOMIC_RELAXED, __HIP_MEMORY_SCOPE_AGENT) : 0; }
        __syncthreads();
        if (tid < 256) { const LAS int* tk = TOK + tid * 8; const unsigned tok = (unsigned)(tile * 256 + tid);
            const int e1 = tk[0], e2 = tk[1]; const unsigned h1 = e1 < e2 ? 0u : 1u;
            const size_t s1 = (size_t)e1 * 65536 + HIST[144 + e1] + tk[4], s2 = (size_t)e2 * 65536 + HIST[144 + e2] + tk[5];
            ELT[s1] = tok | (h1 << 31); ELG[s1] = __int_as_float(tk[2]); ELT[s2] = tok | ((1u - h1) << 31); ELG[s2] = __int_as_float(tk[3]);
            PLT[(size_t)tk[7] * 65536 + HIST[176 + tk[7]] + tk[6]] = tok; }
    }
}
__device__ __forceinline__ void build_tables(LAS unsigned char* lds, unsigned* counters, int ng) {
    LAS int* pref = (LAS int*)(lds + TAB_OFF); LAS int* cnt = pref + 130;
    __syncthreads();
    if ((int)threadIdx.x < ng) cnt[threadIdx.x] = (int)__hip_atomic_load(counters + 64 * threadIdx.x, __ATOMIC_RELAXED, __HIP_MEMORY_SCOPE_AGENT);
    __syncthreads();
    if (threadIdx.x == 0) { int s = 0; for (int g = 0; g < ng; ++g) { pref[g] = s; s += (cnt[g] + 255) >> 8; } for (int g = ng; g < 130; ++g) pref[g] = s; }
    __syncthreads();
}

template <bool PASS2> __device__ __forceinline__ void scan_phase(const Args& a, LAS unsigned char* lds, int G, int wave, int lane) {
    const bf16* ZC = (const bf16*)(a.ws + WS_Z); bf16* Y = (bf16*)(a.ws + WS_Y); const bf16* WAX = (const bf16*)(a.ws + WS_WAX); float* CAR = (float*)(a.ws + WS_CAR);
    LAS unsigned char* RAW = lds;
    LAS unsigned char* AT = lds + 34816;
    LAS unsigned char* GT = lds + 67584;
    LAS float* CW = (LAS float*)(lds + 100352);
    const int tid = threadIdx.x, fr = lane & 15, fq = lane >> 4;
    const int cc = tid & 15, rq = tid >> 4;
    for (int unit = blockIdx.x; unit < 1024; unit += G) {
        const int hd = unit & 7, blk = (unit >> 3) & 15, b = unit >> 7;
        const size_t Rbase = (size_t)b * SEQ + blk * 512;
        const int ch = 128 * hd + 16 * wave + fr;
        bf16x8 Br[4], Bi[4];
#pragma unroll
        for (int ks = 0; ks < 4; ++ks) { Br[ks] = *(const bf16x8*)(WAX + (size_t)((hd * 256 + 16 * wave + fr) * 128 + 32 * ks + 8 * fq)); Bi[ks] = *(const bf16x8*)(WAX + (size_t)((hd * 256 + 128 + 16 * wave + fr) * 128 + 32 * ks + 8 * fq)); }
        const float ba = a.in[14][ch], bx = a.in[16][ch];
        const float kl = -8.0f * 1.44269504f * log1pf(__expf(-a.in[17][ch]));
        __syncthreads();
        if (tid < 128) { const int c = 128 * hd + tid;
#pragma unroll
            for (int k = 0; k < 4; ++k) CW[k * 128 + tid] = a.in[11][k * 1024 + c];
            CW[4 * 128 + tid] = a.in[12][c]; }
        float Hs = 0.f, Pa = 1.f;
        if (PASS2) { for (int j = 0; j < blk; ++j) { const f32x2 ab = *(const f32x2*)(CAR + ((size_t)(b * 16 + j) * 1024 + ch) * 2); Hs = ab.x * Hs + ab.y; } }
        u32x4 pr[5], pg[4];
#define SCAN_LOAD(sbn) do { const size_t R0n = Rbase + 128 * (sbn); \
            _Pragma("unroll") for (int p = 0; p < 5; ++p) { const int rr = p * 32 + rq; const int pos = blk * 512 + 128 * (sbn) - 3 + rr; pr[p] = (u32x4){0u, 0u, 0u, 0u}; \
                if (rr < 131 && pos >= 0) pr[p] = *(const u32x4*)(ZC + (R0n + rr - 3) * 2048 + 1024 + 128 * hd + 8 * cc); } \
            if (PASS2) { _Pragma("unroll") for (int p = 0; p < 4; ++p) pg[p] = *(const u32x4*)(ZC + (R0n + p * 32 + rq) * 2048 + 128 * hd + 8 * cc); } } while (0)
        SCAN_LOAD(0);
#pragma unroll 1
        for (int sb = 0; sb < 4; ++sb) {
            const size_t R0 = Rbase + 128 * sb;
#pragma unroll
            for (int p = 0; p < 5; ++p) { const int rr = p * 32 + rq; if (rr < 132) *(LAS u32x4*)(RAW + rr * 256 + cc * 16) = pr[p]; }
            if (PASS2) {
#pragma unroll
                for (int p = 0; p < 4; ++p) { const int row = p * 32 + rq; *(LAS u32x4*)(GT + row * 256 + ((cc ^ p) << 4)) = pg[p]; } }
            __syncthreads();
            if (sb < 3) SCAN_LOAD(sb + 1);
            {
                float cw[5][8];
#pragma unroll
                for (int k = 0; k < 5; ++k) { const f32x4 w0 = *(const LAS f32x4*)(CW + k * 128 + 8 * cc), w1 = *(const LAS f32x4*)(CW + k * 128 + 8 * cc + 4);
                    cw[k][0] = w0.x; cw[k][1] = w0.y; cw[k][2] = w0.z; cw[k][3] = w0.w; cw[k][4] = w1.x; cw[k][5] = w1.y; cw[k][6] = w1.z; cw[k][7] = w1.w; }
                float xw[7][8];
#pragma unroll
                for (int i = 0; i < 7; ++i) { const u32x4 v = *(const LAS u32x4*)(RAW + (4 * rq + i) * 256 + cc * 16);
#pragma unroll
                    for (int j = 0; j < 4; ++j) { xw[i][2 * j] = bflo(v[j]); xw[i][2 * j + 1] = bfhi(v[j]); } }
#pragma unroll
                for (int i = 0; i < 4; ++i) { const int t = 4 * rq + i; float o[8];
#pragma unroll
                    for (int j = 0; j < 8; ++j) o[j] = cw[4][j] + cw[0][j] * xw[i][j] + cw[1][j] * xw[i + 1][j] + cw[2][j] * xw[i + 2][j] + cw[3][j] * xw[i + 3][j];
                    u32x4 w; w.x = cvt_pk_bf16(o[0], o[1]); w.y = cvt_pk_bf16(o[2], o[3]); w.z = cvt_pk_bf16(o[4], o[5]); w.w = cvt_pk_bf16(o[6], o[7]);
                    const int key = (((t >> 5) & 3) << 2) | (t & 3);
                    *(LAS u32x4*)(AT + t * 256 + ((cc ^ key) << 4)) = w; }
            }
            __syncthreads();
            f32x4 ar[8], ai[8];
            const int arow = 32 * (fr >> 2) + (fr & 3);
#pragma unroll
            for (int m = 0; m < 8; ++m) { ar[m] = (f32x4){0.f, 0.f, 0.f, 0.f}; ai[m] = (f32x4){0.f, 0.f, 0.f, 0.f};
#pragma unroll
                for (int ks = 0; ks < 4; ++ks) { const bf16x8 Af = *(const LAS bf16x8*)(AT + (arow + 4 * m) * 256 + (((4 * ks + fq) ^ fr) << 4));
                    ar[m] = __builtin_amdgcn_mfma_f32_16x16x32_bf16(Af, Br[ks], ar[m], 0, 0, 0); ai[m] = __builtin_amdgcn_mfma_f32_16x16x32_bf16(Af, Bi[ks], ai[m], 0, 0, 0); } }
            float av[32], bv[32];
            const int cbase = 2 * wave + (fr >> 3);
#pragma unroll
            for (int m = 0; m < 8; ++m)
#pragma unroll
                for (int i = 0; i < 4; ++i) {
                    const float xr = bf1(*(const LAS unsigned short*)(AT + (32 * fq + 4 * m + i) * 256 + ((cbase ^ ((fq << 2) | i)) << 4) + (fr & 7) * 2));
                    const float r = sigmoidf_(ar[m][i] + ba), ig = sigmoidf_(ai[m][i] + bx);
                    const float aa = __builtin_amdgcn_exp2f(r * kl); float om = 1.0f - aa * aa; om = om > 0.f ? om : 0.f;
                    av[4 * m + i] = aa; bv[4 * m + i] = __builtin_amdgcn_sqrtf(om) * ig * xr; }
            float As = 1.f, Bs = 0.f;
#pragma unroll
            for (int j = 0; j < 32; ++j) { Bs = av[j] * Bs + bv[j]; As *= av[j]; }
            float A1 = As, B1 = Bs;
            { const float Ap = __shfl_up(As, 16), Bp = __shfl_up(Bs, 16); if (fq >= 1) { A1 = Ap * As; B1 = As * Bp + Bs; } }
            float A2 = A1, B2 = B1;
            { const float Ap = __shfl_up(A1, 32), Bp = __shfl_up(B1, 32); if (fq >= 2) { A2 = Ap * A1; B2 = A1 * Bp + B1; } }
            if (PASS2) {
                float Ae = __shfl_up(A2, 16), Be = __shfl_up(B2, 16); if (fq == 0) { Ae = 1.f; Be = 0.f; }
                float h = Ae * Hs + Be;
                LAS unsigned short* gp = (LAS unsigned short*)(GT + (32 * fq) * 256 + ((cbase ^ fq) << 4) + (fr & 7) * 2);
#pragma unroll
                for (int j = 0; j < 32; ++j) { h = av[j] * h + bv[j]; const float gate = bf1(gp[j * 128]); gp[j * 128] = (unsigned short)(cvt_pk_bf16(gate * h, 0.f) & 0xffffu); }
            }
            const float At_ = __shfl(A2, fr + 48), Bt_ = __shfl(B2, fr + 48);
            Hs = At_ * Hs + Bt_; Pa *= At_;
            __syncthreads();
            if (PASS2) {
#pragma unroll
                for (int p = 0; p < 4; ++p) { const int row = p * 32 + rq; *(u32x4*)(Y + (R0 + row) * 1024 + 128 * hd + 8 * cc) = *(const LAS u32x4*)(GT + row * 256 + ((cc ^ p) << 4)); }
                __syncthreads();
            }
        }
#undef SCAN_LOAD
        if (!PASS2 && fq == 0) *(f32x2*)(CAR + ((size_t)(b * 16 + blk) * 1024 + ch) * 2) = (f32x2){Pa, Hs};
    }
}

__global__ void __launch_bounds__(512, 2) fwd(Args args) {
    extern __shared__ __attribute__((aligned(16))) unsigned char lds_raw[];
    LAS unsigned char* lds = (LAS unsigned char*)lds_raw;
    volatile LAS unsigned* MISC = (volatile LAS unsigned*)(lds + MISC_OFF);
    const int tid = threadIdx.x, lane = tid & 63, wave = __builtin_amdgcn_readfirstlane(tid >> 6), G = gridDim.x;
    const int vcu = (G % 8 == 0) ? (int)(blockIdx.x % 8) * (G / 8) + (int)(blockIdx.x / 8) : (int)blockIdx.x;
    unsigned char* ws = args.ws;
    if (tid < 64) MISC[tid] = 0u;
    __syncthreads();
    XcdBarrier bar = xcd_barrier_post((unsigned*)(ws + WS_CTL) + CW_BAR + args.li * XCD_BAR_WORDS, MISC + 8);
    const int lo = args.ph_lo, hi = args.ph_hi;
#define IN(k) (ph_on(k) && lo <= (k) && (k) < hi)
#ifndef PROBE_NOSTORE
#define PROBE_NOSTORE 0
#endif
#define RUN(k, ...) do { if (IN(k)) { const int ST_ON = 1; __VA_ARGS__ } if (IN(k) && ((REP_MASK >> (k)) & 1)) { const int ST_ON = PROBE_NOSTORE ? args.pad : 1; __VA_ARGS__ } } while (0)
#define SEAM(k) do { if (IN(k) && hi > (k) + 1) xcd_barrier(bar); } while (0)
    bf16* H = (bf16*)(ws + WS_H); bf16* Z = (bf16*)(ws + WS_Z); bf16* Yb = (bf16*)(ws + WS_Y); bf16* XB = (bf16*)(ws + WS_XB);

    RUN(0, p0_prologue(args, lds, G, wave, lane););
    SEAM(0);
    RUN(1,
        { pg8::DenseOrder S; S.init(M, 2048, G, (int)blockIdx.x, H, HP, ws + WS_WREST, 1024, 16); S.same_tile = !ST_ON;
          pg8::EpiZ E{Z, 2048, 2, ST_ON}; pg8::gemm_phase<pg8::EpiZ, pg8::DenseOrder, false>(lds, HP, 1024, 1024, 16, S, E); }
        { pg8::DenseOrder S; S.init(512, M, G, (int)blockIdx.x, ws + WS_WV, 1024, H, HP, 16); S.same_tile = !ST_ON;
          pg8::EpiZ E{(bf16*)(ws + WS_VT), M, 1 << 30, ST_ON}; pg8::gemm_phase<pg8::EpiZ, pg8::DenseOrder, false>(lds, 1024, HP, 1024, 16, S, E); }
    );
    SEAM(1);
    RUN(2, p2_spatial(args, lds, G, wave, lane););
    SEAM(2);
    RUN(3, pg8::DenseOrder S; S.init(M, 1024, G, (int)blockIdx.x, Yb, 1024, ws + WS_WO, 1024, 16);
        pg8::EpiRes<true> E{args.in[0], XB}; pg8::gemm_phase<pg8::EpiRes<true>, pg8::DenseOrder, false>(lds, 1024, 1024, 1024, 16, S, E););
    SEAM(3);
#define MOE_LAYER(l, pb) do { \
        if (IN(pb)) route_phase(args, l, lds, G, wave, lane); \
        SEAM(pb); \
        RUN((pb) + 1, \
            build_tables(lds, (unsigned*)(ws + WS_CTL) + CW_ECNT + (l) * 2048, NE); \
            pg8::GroupOrder<false> S; S.pref = (const LAS int*)(lds + TAB_OFF); S.ng = NE; S.G = G; S.c = vcu; S.lane = lane; \
            S.A = (const char*)H; S.W = (const char*)(ws + WS_WGU) + (size_t)(l) * 32 * 1024 * 1024 * 2; S.lists = (const unsigned*)(ws + WS_ELT); S.glists = (const float*)(ws + WS_ELG); \
            pg8::EpiG1 E{Z}; pg8::gemm_phase<pg8::EpiG1, pg8::GroupOrder<false>, true>(lds, HP, 1024, 1024, 16, S, E); \
        ); \
        SEAM((pb) + 1); \
        if (IN((pb) + 2)) { \
            build_tables(lds, (unsigned*)(ws + WS_CTL) + CW_PCNT + (l) * 7168, NPAIR); \
            pg8::GroupOrder<true> S; S.pref = (const LAS int*)(lds + TAB_OFF); S.ng = NPAIR; S.G = G; S.c = vcu; S.lane = lane; \
            S.A = (const char*)Z; S.W = (const char*)(ws + WS_WD) + (size_t)(l) * 32 * 1024 * 512 * 2; S.lists = (const unsigned*)(ws + WS_PLT); S.glists = nullptr; \
            pg8::EpiG2 E{XB}; pg8::gemm_phase<pg8::EpiG2, pg8::GroupOrder<true>, true>(lds, 1024, 512, 1024, 8, S, E); \
        } \
        SEAM((pb) + 2); } while (0)
    MOE_LAYER(0, 4);
    RUN(7, norm_phase(XB, args.in[1] + 1024, H, G, wave, lane););
    SEAM(7);
    RUN(8, pg8::DenseOrder S; S.init(M, 2048, G, (int)blockIdx.x, H, HP, ws + WS_WC, 1024, 16);
        pg8::EpiZ E{Z, 2048, 4, ST_ON}; pg8::gemm_phase<pg8::EpiZ, pg8::DenseOrder, false>(lds, HP, 1024, 1024, 16, S, E););
    SEAM(8);
    RUN(9, scan_phase<false>(args, lds, G, wave, lane););
    SEAM(9);
    RUN(10, scan_phase<true>(args, lds, G, wave, lane););
    SEAM(10);
    if (IN(11)) { pg8::DenseOrder S; S.init(M, 1024, G, (int)blockIdx.x, Yb, 1024, ws + WS_WCO, 1024, 16);
        pg8::EpiRes<false> E{XB, XB}; pg8::gemm_phase<pg8::EpiRes<false>, pg8::DenseOrder, false>(lds, 1024, 1024, 1024, 16, S, E); }
    SEAM(11);
    MOE_LAYER(1, 12);
#undef MOE_LAYER
    if (IN(15)) final_norm_phase(XB, args.out, args.in[3], G, wave, lane);
#undef IN
#undef SEAM
}

extern "C" void kernel_launch(void* const* d_in, const int* in_sizes, int n_in, void* d_out, int out_size, void* d_ws, size_t ws_size, hipStream_t stream) {
    static int grid = 0;
    if (grid == 0) {
        if (n_in != 26 || in_sizes[0] != M * D || out_size != M * D || ws_size < WS_END) { fprintf(stderr, "kernel_launch: unexpected shapes (n_in %d, in0 %d, out %d, ws %zu < %zu); nothing launched\n", n_in, n_in > 0 ? in_sizes[0] : -1, out_size, ws_size, (size_t)WS_END); grid = -1; return; }
        int dev = 0, cus = 0, per_cu = 0;
        if (hipGetDevice(&dev) != hipSuccess || hipDeviceGetAttribute(&cus, hipDeviceAttributeMultiprocessorCount, dev) != hipSuccess) { grid = -1; return; }
        if (hipFuncSetAttribute((const void*)fwd, hipFuncAttributeMaxDynamicSharedMemorySize, LDS_BYTES) != hipSuccess) { fprintf(stderr, "kernel_launch: hipFuncSetAttribute failed\n"); grid = -1; return; }
        if (hipOccupancyMaxActiveBlocksPerMultiprocessor(&per_cu, (const void*)fwd, 512, LDS_BYTES) != hipSuccess || per_cu < 1) fprintf(stderr, "kernel_launch: occupancy query reports %d workgroups per CU\n", per_cu);
        (void)hipGetLastError();
        grid = cus;
    }
    if (grid < 0) return;
    if (hipMemsetAsync((char*)d_ws + WS_CTL, 0, CTL_ZERO_BYTES, stream) != hipSuccess) return;
    Args a{};
    for (int i = 0; i < 26; ++i) a.in[i] = (const float*)d_in[i];
    a.out = (float*)d_out; a.ws = (unsigned char*)d_ws; a.pad = 0;
#if MK_CUTS
    int li = 0;
    for (int k = 0; k < NPH; ++k) { if (!ph_on(k)) continue;
        a.ph_lo = k; a.ph_hi = k + 1; a.li = li++; hipLaunchKernelGGL(fwd, dim3(grid), dim3(512), LDS_BYTES, stream, a); }
#else
    a.ph_lo = 0; a.ph_hi = NPH; a.li = 0;
    hipLaunchKernelGGL(fwd, dim3(grid), dim3(512), LDS_BYTES, stream, a);
#endif
    const hipError_t le = hipPeekAtLastError();
    if (le != hipSuccess) fprintf(stderr, "kernel_launch: launch failed: %s\n", hipGetErrorName(le));
}
```

```cpp
#include <hip/hip_runtime.h>
#include <cstdio>
#include <cstdint>

#ifndef DBG_STOP
#define DBG_STOP 4
#endif
#ifndef REP_MASK
#define REP_MASK 0
#endif
#ifndef PROBE_PHASE
#define PROBE_PHASE -1
#endif
#ifndef PROBE_FP8
#define PROBE_FP8 0
#endif
#ifndef PROBE_CLOCK
#define PROBE_CLOCK 0
#endif
#ifndef MK_CUTS
#define MK_CUTS 0
#endif

#define LAS __attribute__((address_space(3)))
#define GAS __attribute__((address_space(1)))
typedef unsigned short bf16;
typedef short bf16x8 __attribute__((ext_vector_type(8)));
typedef float f32x4 __attribute__((ext_vector_type(4)));
typedef float f32x2 __attribute__((ext_vector_type(2)));
typedef unsigned u32x4 __attribute__((ext_vector_type(4)));
typedef unsigned u32x2 __attribute__((ext_vector_type(2)));

constexpr int D = 1024, NBATCH = 8, SEQ = 8192, M = NBATCH * SEQ;
constexpr int NE = 32, DE = 512, NPAIR = 112;
constexpr float EPS = 1e-6f;
constexpr int NPH = 16;
constexpr int HP = 1088;
#ifdef ONLY_PH
__host__ __device__ constexpr bool ph_on(int k) { return ((ONLY_PH >> k) & 1) != 0; }
#else
__host__ __device__ constexpr bool ph_on(int k) { return (k <= 3) || (k >= 4 && k <= 6 && DBG_STOP >= 2) || (k >= 7 && k <= 11 && DBG_STOP >= 3) || (k >= 12 && k <= 14 && DBG_STOP >= 4) || k == 15; }
#endif

constexpr size_t MiB = 1u << 20;
constexpr size_t WS_CTL = 0, CTL_ZERO_BYTES = 192 * 1024;
constexpr size_t WS_WSB = 1 * MiB;
constexpr size_t WS_WAX = 1 * MiB + 256 * 1024;
constexpr size_t WS_WRT = 2 * MiB;
constexpr size_t WS_SH = 3 * MiB;
constexpr size_t WS_SWC = 4 * MiB;
constexpr size_t WS_SWR = 4 * MiB + 64 * 1024;
constexpr size_t WS_SWV = 4 * MiB + 128 * 1024;
constexpr size_t WS_ELT = 8 * MiB;
constexpr size_t WS_ELG = 16 * MiB;
constexpr size_t WS_PLT = 24 * MiB;
constexpr size_t WS_WREST = 52 * MiB;
constexpr size_t WS_WV = 56 * MiB;
constexpr size_t WS_WO = 57 * MiB;
constexpr size_t WS_WC = 59 * MiB;
constexpr size_t WS_WCO = 63 * MiB;
constexpr size_t WS_WGU = 65 * MiB;
constexpr size_t WS_WD = 193 * MiB;
constexpr size_t WS_H = 257 * MiB;
constexpr size_t WS_Z = 393 * MiB;
constexpr size_t WS_VT = 649 * MiB;
constexpr size_t WS_Y = 713 * MiB;
constexpr size_t WS_XB = 841 * MiB;
constexpr size_t WS_END = 969 * MiB;
constexpr int CW_TMO = 0;
constexpr int CW_ECNT = 8192;
constexpr int CW_PCNT = 12288;
constexpr int CW_BAR = 32768;
constexpr int LDS_BYTES = 147456;
constexpr int TAB_OFF = 131072;
constexpr int MISC_OFF = LDS_BYTES - 256;

__device__ __forceinline__ float bflo(unsigned w) { return __uint_as_float(w << 16); }
__device__ __forceinline__ float bfhi(unsigned w) { return __uint_as_float(w & 0xffff0000u); }
__device__ __forceinline__ float bf1(unsigned short b) { return __uint_as_float(((unsigned)b) << 16); }
__device__ __forceinline__ unsigned cvt_pk_bf16(float lo, float hi) { unsigned r; asm volatile("v_cvt_pk_bf16_f32 %0, %1, %2" : "=v"(r) : "v"(lo), "v"(hi)); return r; }
__device__ __forceinline__ float wave_sum(float v) {
#pragma unroll
    for (int o = 1; o < 64; o <<= 1) v += __shfl_xor(v, o);
    return v;
}
__device__ __forceinline__ float sigmoidf_(float x) { return __builtin_amdgcn_rcpf(1.0f + __builtin_amdgcn_exp2f(-1.44269504f * x)); }
typedef float f32x2_g __attribute__((ext_vector_type(2)));
__device__ __forceinline__ f32x2_g gelu_tanh2(f32x2_g x) {
    const f32x2_g one2 = (f32x2_g){1.0f, 1.0f}, c2 = (f32x2_g){0.044715f, 0.044715f}, k2 = (f32x2_g){-2.3022082f, -2.3022082f};
    const f32x2_g ea = (x * (one2 + c2 * (x * x))) * k2, d = (f32x2_g){__builtin_amdgcn_exp2f(ea.x), __builtin_amdgcn_exp2f(ea.y)} + one2;
    return x * (f32x2_g){__builtin_amdgcn_rcpf(d.x), __builtin_amdgcn_rcpf(d.y)}; }
__device__ __forceinline__ float gelu_tanh(float x) { const float z = x * (1.0f + 0.044715f * x * x); return x * __builtin_amdgcn_rcpf(1.0f + __builtin_amdgcn_exp2f(-2.3022082f * z)); }
__device__ __forceinline__ unsigned pk4_fp8(float a, float b, float c, float d) {
    a = __builtin_fminf(__builtin_fmaxf(a, -448.f), 448.f); b = __builtin_fminf(__builtin_fmaxf(b, -448.f), 448.f); c = __builtin_fminf(__builtin_fmaxf(c, -448.f), 448.f); d = __builtin_fminf(__builtin_fmaxf(d, -448.f), 448.f);
    unsigned r = 0; r = __builtin_amdgcn_cvt_pk_fp8_f32(a, b, r, false); r = __builtin_amdgcn_cvt_pk_fp8_f32(c, d, r, true); return r; }
constexpr float FP8_SW = 32.0f, FP8_SH = 16.0f, FP8_SY = 8.0f;
constexpr float I8_ASTEP = 8.0f / 127.0f;
__device__ __forceinline__ unsigned pk4_i8(float a, float b, float c, float d) {
    const int ia = (int)__builtin_rintf(__builtin_fminf(__builtin_fmaxf(a, -127.f), 127.f)), ib = (int)__builtin_rintf(__builtin_fminf(__builtin_fmaxf(b, -127.f), 127.f));
    const int ic = (int)__builtin_rintf(__builtin_fminf(__builtin_fmaxf(c, -127.f), 127.f)), id = (int)__builtin_rintf(__builtin_fminf(__builtin_fmaxf(d, -127.f), 127.f));
    return ((unsigned)ia & 0xffu) | (((unsigned)ib & 0xffu) << 8) | (((unsigned)ic & 0xffu) << 16) | ((unsigned)id << 24); }
typedef int v8i __attribute__((ext_vector_type(8)));
typedef int i32x4 __attribute__((ext_vector_type(4)));
__device__ __forceinline__ int lane_id_v() { int r; asm volatile("v_mbcnt_lo_u32_b32 %0, -1, 0\n\tv_mbcnt_hi_u32_b32 %0, -1, %0" : "=v"(r)); return r; }
#define LDS_WAIT() asm volatile("s_waitcnt lgkmcnt(0)" ::: "memory")
#define VM_WAIT() asm volatile("s_waitcnt vmcnt(0)" ::: "memory")

namespace pg8 {
constexpr int BM = 256, BK = 64, HALF = 128, HTB = HALF * BK * 2, STAGE_BYTES = 8 * HTB, NXCD = 8, WGM = 8;
__host__ __device__ __forceinline__ int lds_byte(int r, int c) { const int st = (r >> 4) * 2 + (c >> 5), rr = r & 15, cc = c & 31, ob = rr * 64 + cc * 2; return st * 1024 + (ob ^ (((ob >> 9) & 1) << 5)); }
__host__ __device__ __forceinline__ void stage_rc(int b, int& R, int& C) { const int st = b / 1024, sb = b % 1024, swz = sb ^ (((sb >> 9) & 1) << 5); R = (st >> 1) * 16 + swz / 64; C = (st & 1) * 32 + (swz % 64) / 2; }
__host__ __device__ __forceinline__ int perm32(int rho) { const int n = rho >> 4, i = rho & 15; return 8 * (i >> 2) + 4 * n + (i & 3); }

struct Unit { int pm, pn; const char* A; const char* B0; const char* B1; const unsigned* list; int nvalid; };

template <class Epi, class Sched, bool GATHER, int PREC = 0>
__device__ __forceinline__ void gemm_phase(LAS unsigned char* lds, const int lda, const int ldb, const int K, const int nth, const Sched& S, const Epi& E, const unsigned stagger_ticks = 0u) {
    constexpr bool FP8 = PREC == 1, I8 = PREC == 2;
    const int tid = threadIdx.x, wid = __builtin_amdgcn_readfirstlane(tid >> 6), lane = tid & 63, wr = wid >> 2, wc = wid & 3, fr = lane & 15, fq = lane >> 4;
    const int nt = K / BK;
    int R0, C0; stage_rc(tid * 16, R0, C0);
    unsigned voffB[2]; { const int Rb = Epi::PERM ? ((R0 & ~31) + perm32(R0 & 31)) : R0; voffB[0] = (unsigned)(Rb * ldb + C0) * 2u; voffB[1] = voffB[0] + (unsigned)(64 * ldb * 2); }
    const size_t kstep = (size_t)(BK * 2);
    const size_t hstepB = (size_t)HALF * ldb * 2;
    const unsigned ldsw = (unsigned)wid * 1024u;
    const int aoff = FP8 ? lds_byte(wr * 64 + fr, 16 * fq) : lds_byte(wr * 64 + fr, fq * 8), boff = FP8 ? lds_byte(wc * 32 + fr, 16 * fq) : lds_byte(wc * 32 + fr, fq * 8);
    constexpr int P1OFF = FP8 ? 16 : 1024;
#define PG8_SA(b, h) (((b) * 2 + (h)) * HTB)
#define PG8_SB(b, h) ((4 + (b) * 2 + (h)) * HTB)
#define PG8_STAGE(bufoff, gbase, voff) do { _Pragma("unroll") for (int _i = 0; _i < 2; ++_i) \
        __builtin_amdgcn_global_load_lds((const unsigned*)((const char*)(gbase) + (voff)[_i]), (LAS unsigned*)(lds + (bufoff) + ldsw + _i * 8192), 16, 0, 0); } while (0)
#define PG8_LDA(dst, dst8, b, h) do { if constexpr (FP8) { _Pragma("unroll") for (int m = 0; m < 4; ++m) { const i32x4 lo_ = *(const LAS i32x4*)(lds + PG8_SA(b, h) + aoff + m * 2048), hi_ = *(const LAS i32x4*)(lds + PG8_SA(b, h) + aoff + P1OFF + m * 2048); dst8[m] = __builtin_shufflevector(lo_, hi_, 0, 1, 2, 3, 4, 5, 6, 7); } } \
        else { _Pragma("unroll") for (int m = 0; m < 4; ++m) _Pragma("unroll") for (int k = 0; k < 2; ++k) dst[m][k] = *(const LAS bf16x8*)(lds + PG8_SA(b, h) + aoff + m * 2048 + k * P1OFF); } } while (0)
#define PG8_LDB(dst, dst8, b, h) do { if constexpr (FP8) { _Pragma("unroll") for (int n = 0; n < 2; ++n) { const i32x4 lo_ = *(const LAS i32x4*)(lds + PG8_SB(b, h) + boff + n * 2048), hi_ = *(const LAS i32x4*)(lds + PG8_SB(b, h) + boff + P1OFF + n * 2048); dst8[n] = __builtin_shufflevector(lo_, hi_, 0, 1, 2, 3, 4, 5, 6, 7); } } \
        else { _Pragma("unroll") for (int n = 0; n < 2; ++n) _Pragma("unroll") for (int k = 0; k < 2; ++k) dst[n][k] = *(const LAS bf16x8*)(lds + PG8_SB(b, h) + boff + n * 2048 + k * P1OFF); } } while (0)
#define PG8_MMA(ai, bj, At, Bt, At8, Bt8) do { __builtin_amdgcn_s_setprio(1); _Pragma("unroll") for (int m = 0; m < 4; ++m) _Pragma("unroll") for (int n = 0; n < 2; ++n) { \
        if constexpr (FP8) asm volatile("v_mfma_scale_f32_16x16x128_f8f6f4 %0, %1, %2, %0, %3, %3 op_sel_hi:[0,0,0]" : "+v"(acc[ai][bj][m][n]) : "v"(Bt8[n]), "v"(At8[m]), "v"(sc127)); \
        else if constexpr (I8) { _Pragma("unroll") for (int k = 0; k < 2; ++k) acc[ai][bj][m][n] = __builtin_bit_cast(f32x4, __builtin_amdgcn_mfma_i32_16x16x64_i8(__builtin_bit_cast(i32x4, Bt[n][k]), __builtin_bit_cast(i32x4, At[m][k]), __builtin_bit_cast(i32x4, acc[ai][bj][m][n]), 0, 0, 0)); } \
        else { _Pragma("unroll") for (int k = 0; k < 2; ++k) acc[ai][bj][m][n] = __builtin_amdgcn_mfma_f32_16x16x32_bf16(Bt[n][k], At[m][k], acc[ai][bj][m][n], 0, 0, 0); } } \
        __builtin_amdgcn_s_setprio(0); } while (0)
#define PG8_WAIT_V(n) asm volatile("s_waitcnt vmcnt(" #n ")" ::: "memory")
#define PG8_WAIT_L(n) asm volatile("s_waitcnt lgkmcnt(" #n ")" ::: "memory")
#define PG8_BAR __builtin_amdgcn_s_barrier()
#define PG8_SCHED __builtin_amdgcn_sched_barrier(0)
    Unit cur, nxt; int ui = 0;
    if (!S.next(0, cur)) return;
    if (stagger_ticks) { const unsigned long long t0 = wall_clock64(); while (wall_clock64() - t0 < (unsigned long long)stagger_ticks) __builtin_amdgcn_s_sleep(4); }
    unsigned offc[2][2], nid[2][2];
#pragma unroll
    for (int h = 0; h < 2; ++h)
#pragma unroll
        for (int i = 0; i < 2; ++i) {
            const int r = R0 + 64 * i + HALF * h;
            if constexpr (GATHER) { const unsigned ent = r < cur.nvalid ? cur.list[r] : 0u; offc[h][i] = (ent & 0x7fffffffu) * (unsigned)(lda * 2) + (unsigned)(C0 * 2); }
            else offc[h][i] = (unsigned)(r * lda + C0) * 2u;
            nid[h][i] = 0u;
        }
    f32x4 acc[2][2][4][2];
#pragma unroll
    for (int a = 0; a < 2; ++a)
#pragma unroll
        for (int b = 0; b < 2; ++b)
#pragma unroll
            for (int m = 0; m < 4; ++m)
#pragma unroll
                for (int n = 0; n < 2; ++n) acc[a][b][m][n] = (f32x4){0.f, 0.f, 0.f, 0.f};
    bf16x8 At[4][2], B0[2][2], B1[2][2]; v8i At8[4], B08[2], B18[2]; const int sc127 = 127;
    const char* cA = cur.A; const char* cB0 = cur.B0; const char* cB1 = cur.B1;
    E.prefetch(cur.pm, cur.pn, cur.list, cur.nvalid, lds, 0, wid, lane);
    PG8_STAGE(PG8_SB(0, 0), cB0, voffB); PG8_STAGE(PG8_SB(0, 1), cB0 + hstepB, voffB); PG8_STAGE(PG8_SA(0, 0), cA, offc[0]); PG8_STAGE(PG8_SA(0, 1), cA, offc[1]);
    if (wr == 1) PG8_BAR;
    PG8_WAIT_V(2); PG8_BAR;
    PG8_STAGE(PG8_SB(1, 0), cB0 + kstep, voffB); PG8_STAGE(PG8_SA(1, 0), cA + kstep, offc[0]); PG8_STAGE(PG8_SB(1, 1), cB0 + hstepB + kstep, voffB);
    PG8_WAIT_V(6); PG8_BAR;
    for (;;) {
        const bool has_next = S.next(ui + 1, nxt);
        if constexpr (GATHER) {
            if (has_next) {
#pragma unroll
                for (int h = 0; h < 2; ++h)
#pragma unroll
                    for (int i = 0; i < 2; ++i) { const int r = R0 + 64 * i + HALF * h; nid[h][i] = r < nxt.nvalid ? nxt.list[r] : 0u; }
            }
        }
        const char* nA = has_next ? nxt.A : cA; const char* nB0 = has_next ? nxt.B0 : cB0;
        for (int t = 0; t < nt; t += 2) {
            const bool last = (t == nt - 2);
            const char* a1 = cA + (size_t)(t + 1) * kstep;
            const char* a2 = last ? nA : cA + (size_t)(t + 2) * kstep;
            const char* b2 = last ? nB0 : ((t + 2 < nth) ? cB0 + (size_t)(t + 2) * kstep : cB1 + (size_t)(t + 2 - nth) * kstep);
            const char* a3 = a2 + kstep; const char* b3 = b2 + kstep;
            unsigned o2[2][2];
#pragma unroll
            for (int h = 0; h < 2; ++h)
#pragma unroll
                for (int i = 0; i < 2; ++i) {
                    if constexpr (GATHER) o2[h][i] = (last && has_next) ? (nid[h][i] & 0x7fffffffu) * (unsigned)(lda * 2) + (unsigned)(C0 * 2) : offc[h][i];
                    else o2[h][i] = offc[h][i]; }
            PG8_LDB(B0, B08, 0, 0); PG8_LDB(B1, B18, 0, 1); PG8_SCHED; PG8_LDA(At, At8, 0, 0); PG8_STAGE(PG8_SA(1, 1), a1, offc[1]);
            PG8_WAIT_V(8); PG8_WAIT_L(0); PG8_BAR; PG8_MMA(0, 0, At, B0, At8, B08); PG8_MMA(0, 1, At, B1, At8, B18); PG8_BAR; PG8_SCHED;
            PG8_LDA(At, At8, 0, 1); PG8_STAGE(PG8_SB(0, 0), b2, voffB); PG8_STAGE(PG8_SB(0, 1), b2 + hstepB, voffB); PG8_STAGE(PG8_SA(0, 0), a2, o2[0]);
            PG8_WAIT_V(8); PG8_WAIT_L(0); PG8_BAR; PG8_MMA(1, 0, At, B0, At8, B08); PG8_MMA(1, 1, At, B1, At8, B18); PG8_BAR; PG8_SCHED;
            PG8_LDB(B0, B08, 1, 0); PG8_LDB(B1, B18, 1, 1); PG8_SCHED; PG8_LDA(At, At8, 1, 0); PG8_STAGE(PG8_SA(0, 1), a2, o2[1]);
            PG8_WAIT_V(8); PG8_WAIT_L(0); PG8_BAR; PG8_MMA(0, 0, At, B0, At8, B08); PG8_MMA(0, 1, At, B1, At8, B18); PG8_BAR; PG8_SCHED;
            PG8_LDA(At, At8, 1, 1); PG8_STAGE(PG8_SB(1, 0), b3, voffB); PG8_STAGE(PG8_SB(1, 1), b3 + hstepB, voffB); PG8_STAGE(PG8_SA(1, 0), a3, o2[0]);
            PG8_WAIT_V(8); PG8_WAIT_L(0); PG8_BAR; PG8_MMA(1, 0, At, B0, At8, B08); PG8_MMA(1, 1, At, B1, At8, B18); PG8_BAR; PG8_SCHED;
        }
        if (wr == 0) PG8_BAR;
        if constexpr (FP8) asm volatile("s_nop 15\n\ts_nop 15" ::: "memory");
        E(acc, cur, wr, wc, fr, fq, lds, ui & 1);
        if (!has_next) break;
        E.prefetch(nxt.pm, nxt.pn, nxt.list, nxt.nvalid, lds, (ui + 1) & 1, wid, lane);
#pragma unroll
        for (int a = 0; a < 2; ++a)
#pragma unroll
            for (int b = 0; b < 2; ++b)
#pragma unroll
                for (int m = 0; m < 4; ++m)
#pragma unroll
                    for (int n = 0; n < 2; ++n) acc[a][b][m][n] = (f32x4){0.f, 0.f, 0.f, 0.f};
        cur = nxt; cA = nA; cB0 = nB0; cB1 = nxt.B1; ++ui;
        if constexpr (GATHER) {
#pragma unroll
            for (int h = 0; h < 2; ++h)
#pragma unroll
                for (int i = 0; i < 2; ++i) offc[h][i] = (nid[h][i] & 0x7fffffffu) * (unsigned)(lda * 2) + (unsigned)(C0 * 2);
        }
        if (wr == 1) PG8_BAR;
    }
    PG8_WAIT_V(0);
    PG8_BAR;
#undef PG8_SA
#undef PG8_SB
#undef PG8_STAGE
#undef PG8_LDA
#undef PG8_LDB
#undef PG8_MMA
#undef PG8_WAIT_V
#undef PG8_WAIT_L
#undef PG8_BAR
#undef PG8_SCHED
}

struct DenseOrder {
    int nM, nN, nwg, G, c, same_tile = 0; const char* A; const char* B; size_t tA, tB, b1off;
    __device__ __forceinline__ void init(int Mr, int N, int G_, int c_, const void* A_, int lda, const void* B_, int ldb, int nth) {
        nM = Mr / BM; nN = N / BM; nwg = nM * nN; G = G_; c = c_; A = (const char*)A_; B = (const char*)B_; tA = (size_t)BM * lda * 2; tB = (size_t)BM * ldb * 2; b1off = (size_t)nth * BK * 2; }
    __device__ __forceinline__ bool next(int i, Unit& u) const {
        const long L = (long)i * G + c; if (L >= nwg) return false;
        int wgid = (int)L; { const int q = nwg / NXCD, r = nwg % NXCD, xcd = wgid % NXCD, off = wgid / NXCD; wgid = (xcd < r ? xcd * (q + 1) : r * (q + 1) + (xcd - r) * q) + off; }
        const int nig = WGM * nN, gid = wgid / nig, fm = gid * WGM, gsz = (nM - fm) < WGM ? (nM - fm) : WGM;
        u.pm = fm + ((wgid % nig) % gsz); u.pn = (wgid % nig) / gsz;
        u.A = A + (same_tile ? 0 : (size_t)u.pm * tA); u.B0 = B + (same_tile ? 0 : (size_t)u.pn * tB); u.B1 = u.B0 + b1off; u.list = nullptr; u.nvalid = BM; return true;
    }
};
__device__ __forceinline__ int find_group(const LAS int* pref, int n, int rt, int lane) {
    const int j0 = lane, j1 = lane + 64;
    const bool f0 = j0 < n && pref[j0] <= rt && rt < pref[j0 + 1];
    const bool f1 = j1 < n && pref[j1] <= rt && rt < pref[j1 + 1];
    const unsigned long long m0 = __ballot(f0), m1 = __ballot(f1);
    return m0 ? (int)__builtin_ctzll(m0) : 64 + (int)__builtin_ctzll(m1 | (1ull << 63));
}
template <bool PAIR> struct GroupOrder {
    static constexpr size_t WSTRIDE = PAIR ? (size_t)1024 * 512 : (size_t)1024 * 1024, TB = PAIR ? (size_t)256 * 512 : (size_t)256 * 1024;
    const LAS int* pref; int ng, G, c, lane;
    const char* A; const char* W; const unsigned* lists;
    __device__ __forceinline__ bool next(int i, Unit& u) const {
        const LAS int* cnt = pref + 130;
        const long L = (long)i * G + c; const int total = __builtin_amdgcn_readfirstlane(pref[ng]);
        if (L >= 4L * total) return false;
        const int rt = (int)(L >> 2); u.pn = (int)(L & 3);
        const int g = __builtin_amdgcn_readfirstlane(find_group(pref, ng, rt, lane));
        const int tr = rt - __builtin_amdgcn_readfirstlane(pref[g]); const int cg = __builtin_amdgcn_readfirstlane(cnt[g]);
        u.pm = tr; u.nvalid = (cg - tr * BM) < BM ? (cg - tr * BM) : BM;
        u.list = lists + (size_t)g * 65536 + (size_t)tr * BM;
        u.A = A;
        if (PAIR) { const int grp = g / 28; int pi = g % 28, lo = 0; while (pi >= 7 - lo) { pi -= 7 - lo; ++lo; } const int hi = lo + 1 + pi;
            u.B0 = W + (size_t)(grp * 8 + lo) * WSTRIDE + (size_t)u.pn * TB; u.B1 = W + (size_t)(grp * 8 + hi) * WSTRIDE + (size_t)u.pn * TB; }
        else { u.B0 = W + (size_t)g * WSTRIDE + (size_t)u.pn * TB; u.B1 = u.B0; }
        return true;
    }
};

struct EpiZ {
    static constexpr bool PERM = true;
    bf16* O; int ldc; int gelu_lt; int st_on; int cx_from; int cx_col0; float scale; const float* sbase; int coff; int roff;
    static constexpr int SCL_OFF = 133120;
    __device__ __forceinline__ void prefetch(int pm, int pn, const unsigned*, int, LAS unsigned char* lds, int par, int wid, int lane) const {
        const int off = wid < 4 ? roff + pm * BM + 64 * wid : coff + pn * BM + 64 * (wid - 4); const float* src = sbase + off + lane;
        __builtin_amdgcn_global_load_lds((const unsigned*)src, (LAS unsigned*)(lds + SCL_OFF + par * 2048 + wid * 256), 4, 0, 0);
    }
    __device__ __forceinline__ f32x4 val(const f32x4& a) const { return __builtin_convertvector(__builtin_bit_cast(i32x4, a), f32x4); }
    __device__ __forceinline__ void operator()(const f32x4 (&acc)[2][2][4][2], const Unit& u, int wr, int wc, int fr, int fq, LAS unsigned char* lds, int par) const {
        if (!st_on) return;
        const int row0 = u.pm * BM + wr * 64 + fr, wcol0 = u.pn * BM + wc * 32 + 8 * fq;
        f32x4 cs[2][2]; float rs[2][4];
#pragma unroll
        for (int bj = 0; bj < 2; ++bj)
#pragma unroll
            for (int h = 0; h < 2; ++h) cs[bj][h] = *(const LAS f32x4*)(lds + SCL_OFF + par * 2048 + 1024 + (wc * 32 + 8 * fq + bj * HALF + 4 * h) * 4) * scale;
#pragma unroll
        for (int ai = 0; ai < 2; ++ai)
#pragma unroll
            for (int m = 0; m < 4; ++m) rs[ai][m] = *(const LAS float*)(lds + SCL_OFF + par * 2048 + (wr * 64 + fr + ai * HALF + m * 16) * 4);
        asm volatile("" ::: "memory");
        if (u.pn >= cx_from) { const int col0 = cx_col0 + (u.pn - cx_from) * HALF + wc * 32 + 8 * fq;
#pragma unroll
            for (int ai = 0; ai < 2; ++ai)
#pragma unroll
                for (int m = 0; m < 4; ++m) { const float r2 = rs[ai][m] * rs[ai][m];
                    const f32x4 v0 = val(acc[ai][0][m][0]) * val(acc[ai][1][m][0]) * (cs[0][0] * cs[1][0]) * r2, v1 = val(acc[ai][0][m][1]) * val(acc[ai][1][m][1]) * (cs[0][1] * cs[1][1]) * r2;
                    u32x4 w; w.x = cvt_pk_bf16(v0[0], v0[1]); w.y = cvt_pk_bf16(v0[2], v0[3]); w.z = cvt_pk_bf16(v1[0], v1[1]); w.w = cvt_pk_bf16(v1[2], v1[3]);
                    *(u32x4*)(O + (size_t)(row0 + ai * HALF + m * 16) * ldc + col0) = w; }
            return; }
        const bool act = u.pn < gelu_lt;
#pragma unroll
        for (int ai = 0; ai < 2; ++ai)
#pragma unroll
            for (int m = 0; m < 4; ++m) { bf16* rowp = O + (size_t)(row0 + ai * HALF + m * 16) * ldc + wcol0;
#pragma unroll
                for (int bj = 0; bj < 2; ++bj) { f32x4 v0 = val(acc[ai][bj][m][0]) * cs[bj][0] * rs[ai][m], v1 = val(acc[ai][bj][m][1]) * cs[bj][1] * rs[ai][m];
                    if (act) {
#pragma unroll
                        for (int jp = 0; jp < 2; ++jp) { const f32x2_g a = gelu_tanh2((f32x2_g){v0[2 * jp], v0[2 * jp + 1]}), b = gelu_tanh2((f32x2_g){v1[2 * jp], v1[2 * jp + 1]});
                            v0[2 * jp] = a.x; v0[2 * jp + 1] = a.y; v1[2 * jp] = b.x; v1[2 * jp + 1] = b.y; } }
                    u32x4 w; w.x = cvt_pk_bf16(v0[0], v0[1]); w.y = cvt_pk_bf16(v0[2], v0[3]); w.z = cvt_pk_bf16(v1[0], v1[1]); w.w = cvt_pk_bf16(v1[2], v1[3]);
                    *(u32x4*)(rowp + bj * HALF) = w; } }
    }
};
template <bool BASE_F32> struct EpiRes {
    static constexpr bool PERM = true;
    __device__ __forceinline__ void prefetch(int, int, const unsigned*, int, LAS unsigned char*, int, int, int) const {}
    const void* __restrict__ base; bf16* __restrict__ out; float scale; int probe = 0;
    __device__ __forceinline__ void operator()(f32x4 (&acc)[2][2][4][2], const Unit& u, int wr, int wc, int fr, int fq, LAS unsigned char* lds, int par) const {
        const int row0 = u.pm * BM + wr * 64 + fr, col0 = u.pn * BM + wc * 32 + 8 * fq;
        if (BASE_F32) {
#pragma unroll
            for (int ai = 0; ai < 2; ++ai) { f32x4 b[4][2][2];
#pragma unroll
                for (int m = 0; m < 4; ++m)
#pragma unroll
                    for (int bj = 0; bj < 2; ++bj) { const float* bp = (const float*)base + (size_t)(row0 + ai * HALF + m * 16) * 1024 + col0 + bj * HALF; b[m][bj][0] = *(const f32x4*)bp; b[m][bj][1] = *(const f32x4*)(bp + 4); }
                asm volatile("" ::: "memory");
#pragma unroll
                for (int m = 0; m < 4; ++m)
#pragma unroll
                    for (int bj = 0; bj < 2; ++bj) { acc[ai][bj][m][0] += b[m][bj][0]; acc[ai][bj][m][1] += b[m][bj][1]; } }
        } else {
            u32x4 b[2][4][2];
#pragma unroll
            for (int ai = 0; ai < 2; ++ai)
#pragma unroll
                for (int m = 0; m < 4; ++m)
#pragma unroll
                    for (int bj = 0; bj < 2; ++bj) { b[ai][m][bj] = (u32x4){0u, 0u, 0u, 0u}; if (!(probe & 1)) b[ai][m][bj] = *(const u32x4*)((const bf16*)base + (size_t)(row0 + ai * HALF + m * 16) * 1024 + col0 + bj * HALF); }
            asm volatile("" ::: "memory");
#pragma unroll
            for (int ai = 0; ai < 2; ++ai)
#pragma unroll
                for (int m = 0; m < 4; ++m)
#pragma unroll
                    for (int bj = 0; bj < 2; ++bj) { const u32x4 w = b[ai][m][bj];
                        acc[ai][bj][m][0] = acc[ai][bj][m][0] * scale + (f32x4){bflo(w.x), bfhi(w.x), bflo(w.y), bfhi(w.y)}; acc[ai][bj][m][1] = acc[ai][bj][m][1] * scale + (f32x4){bflo(w.z), bfhi(w.z), bflo(w.w), bfhi(w.w)}; }
        }
        asm volatile("" ::: "memory");
#pragma unroll
        for (int ai = 0; ai < 2; ++ai)
#pragma unroll
            for (int m = 0; m < 4; ++m) { const size_t off = (size_t)(row0 + ai * HALF + m * 16) * 1024 + col0;
#pragma unroll
                for (int bj = 0; bj < 2; ++bj) { const f32x4 v0 = acc[ai][bj][m][0], v1 = acc[ai][bj][m][1];
                    u32x4 w; w.x = cvt_pk_bf16(v0[0], v0[1]); w.y = cvt_pk_bf16(v0[2], v0[3]); w.z = cvt_pk_bf16(v1[0], v1[1]); w.w = cvt_pk_bf16(v1[2], v1[3]);
                    if (!(probe & 2)) *(u32x4*)(out + off + bj * HALF) = w; } }
    }
};
struct EpiG1 {
    static constexpr bool PERM = true;
    static constexpr int SCL_OFF = 133120;
    __device__ __forceinline__ void prefetch(int, int, const unsigned* list, int nvalid, LAS unsigned char* lds, int par, int wid, int lane) const {
        const int rl = 64 * (wid & 3) + lane, rc = rl < nvalid - 1 ? rl : nvalid - 1; const int off = wid < 4 ? 0 : (int)((WS_ELG - WS_ELT) / 4);
        __builtin_amdgcn_global_load_lds(list + off + rc, (LAS unsigned*)(lds + SCL_OFF + par * 2048 + wid * 256), 4, 0, 0);
    }
    unsigned char* HID;
    __device__ __forceinline__ void operator()(const f32x4 (&acc)[2][2][4][2], const Unit& u, int wr, int wc, int fr, int fq, LAS unsigned char* lds, int par) const {
        const int col0 = u.pn * HALF + wc * 32 + 8 * fq; const int nv1 = u.nvalid - 1;
        unsigned ent[2][4], gt[2][4];
#pragma unroll
        for (int ai = 0; ai < 2; ++ai)
#pragma unroll
            for (int m = 0; m < 4; ++m) { const int rl = ai * HALF + wr * 64 + m * 16 + fr; const LAS unsigned* sl = (const LAS unsigned*)(lds + SCL_OFF + par * 2048) + rl; ent[ai][m] = sl[0]; gt[ai][m] = sl[256]; }
        asm volatile("" ::: "memory");
#pragma unroll
        for (int ai = 0; ai < 2; ++ai)
#pragma unroll
            for (int m = 0; m < 4; ++m) { const int rl = ai * HALF + wr * 64 + m * 16 + fr; const unsigned tok = ent[ai][m] & 0x7fffffffu, half = ent[ai][m] >> 31; const float g_ = bflo(gt[ai][m]), rs_ = bfhi(gt[ai][m]) * (1.0f / FP8_SW);
                float o[8];
                const float ks_ = rs_ * -1.44269504f, us_ = rs_ * (g_ * FP8_SH); const f32x2 rs2 = (f32x2){rs_, rs_}, ks2 = (f32x2){ks_, ks_}, us2 = (f32x2){us_, us_}, one2 = (f32x2){1.0f, 1.0f};
#pragma unroll
                for (int n = 0; n < 2; ++n)
#pragma unroll
                    for (int jp = 0; jp < 2; ++jp) { const f32x2 ag = (f32x2){acc[ai][0][m][n][2 * jp], acc[ai][0][m][n][2 * jp + 1]}, au = (f32x2){acc[ai][1][m][n][2 * jp], acc[ai][1][m][n][2 * jp + 1]};
                        const f32x2 ea = ag * ks2, d = (f32x2){__builtin_amdgcn_exp2f(ea.x), __builtin_amdgcn_exp2f(ea.y)} + one2;
                        const f32x2 o2 = (ag * rs2) * (f32x2){__builtin_amdgcn_rcpf(d.x), __builtin_amdgcn_rcpf(d.y)} * (au * us2);
                        o[4 * n + 2 * jp] = o2.x; o[4 * n + 2 * jp + 1] = o2.y; }
                u32x2 w; w.x = pk4_fp8(o[0], o[1], o[2], o[3]); w.y = pk4_fp8(o[4], o[5], o[6], o[7]);
                if (rl <= nv1) *(u32x2*)(HID + (size_t)tok * 1024 + half * 512 + col0) = w; }
    }
};
struct EpiG2 {
    static constexpr bool PERM = true;
    static constexpr int SCL_OFF = 133120;
    __device__ __forceinline__ void prefetch(int, int, const unsigned* list, int nvalid, LAS unsigned char* lds, int par, int wid, int lane) const {
        if (wid < 4) { const int rl = 64 * wid + lane, rc = rl < nvalid - 1 ? rl : nvalid - 1;
            __builtin_amdgcn_global_load_lds(list + rc, (LAS unsigned*)(lds + SCL_OFF + par * 2048 + wid * 256), 4, 0, 0); }
    }
    bf16* __restrict__ out;
    __device__ __forceinline__ void operator()(f32x4 (&acc)[2][2][4][2], const Unit& u, int wr, int wc, int fr, int fq, LAS unsigned char* lds, int par) const {
        const int col0 = u.pn * BM + wc * 32 + 8 * fq; const int nv1 = u.nvalid - 1;
        unsigned tokv[2][4];
#pragma unroll
        for (int ai = 0; ai < 2; ++ai)
#pragma unroll
            for (int m = 0; m < 4; ++m) { const int rl = ai * HALF + wr * 64 + m * 16 + fr; tokv[ai][m] = (((const LAS unsigned*)(lds + SCL_OFF + par * 2048))[rl] & 0x7fffffffu) * 2048u + (unsigned)(col0 * 2); }
        asm volatile("" ::: "memory");
        u32x4 b[2][4][2];
#pragma unroll
        for (int ai = 0; ai < 2; ++ai)
#pragma unroll
            for (int m = 0; m < 4; ++m)
#pragma unroll
                for (int bj = 0; bj < 2; ++bj) b[ai][m][bj] = *(const u32x4*)((const char*)out + tokv[ai][m] + bj * (HALF * 2));
        asm volatile("" ::: "memory");
#pragma unroll
        for (int ai = 0; ai < 2; ++ai)
#pragma unroll
            for (int m = 0; m < 4; ++m) { const int rl = ai * HALF + wr * 64 + m * 16 + fr; bf16* p = (bf16*)((char*)out + tokv[ai][m]);
#pragma unroll
                for (int bj = 0; bj < 2; ++bj) { const u32x4 bw = b[ai][m][bj];
                    const float sc = 1.0f / (FP8_SW * FP8_SH);
                    const f32x4 v0 = acc[ai][bj][m][0] * sc + (f32x4){bflo(bw.x), bfhi(bw.x), bflo(bw.y), bfhi(bw.y)}, v1 = acc[ai][bj][m][1] * sc + (f32x4){bflo(bw.z), bfhi(bw.z), bflo(bw.w), bfhi(bw.w)};
                    u32x4 w; w.x = cvt_pk_bf16(v0[0], v0[1]); w.y = cvt_pk_bf16(v0[2], v0[3]); w.z = cvt_pk_bf16(v1[0], v1[1]); w.w = cvt_pk_bf16(v1[2], v1[3]);
                    if (rl <= nv1) *(u32x4*)(p + bj * HALF) = w; } }
    }
};
}

#define XB_TMO      128
#define XB_XCNT(j)  (256  + 64 * (j))
#define XB_XSUB(j)  (1280 + 64 * (j))
#define XB_XGEN(j)  (2304 + 64 * (j))
#define XB_TOP      3328
#define XB_TOPGEN   3392
#define XCD_BAR_WORDS 3456
#define XB_SPIN_CAP (1u << 18)
__device__ __forceinline__ unsigned xb_ld(unsigned* p)              { return __hip_atomic_load(p, __ATOMIC_RELAXED, __HIP_MEMORY_SCOPE_AGENT); }
__device__ __forceinline__ unsigned xb_add(unsigned* p, unsigned v) { return __hip_atomic_fetch_add(p, v, __ATOMIC_RELAXED, __HIP_MEMORY_SCOPE_AGENT); }
__device__ __forceinline__ unsigned xb_xcc_id() { return (unsigned)__builtin_amdgcn_s_getreg((3 << 11) | 20) & 0xFu; }
#define XB_SPIN(cond, bar) do { unsigned _sp = 0; while (cond) { __builtin_amdgcn_s_sleep(1); \
    if ((++_sp & 255u) == 0u) { if (xb_ld(&(bar)[XB_TMO])) break; if (_sp > XB_SPIN_CAP) { atomicAdd(&(bar)[XB_TMO], 1u); break; } } } } while (0)
struct XcdBarrier { unsigned* bar; unsigned x; volatile LAS unsigned* st; };
__device__ __forceinline__ XcdBarrier xcd_barrier_post(unsigned* bar, volatile LAS unsigned* st) {
    XcdBarrier b; b.bar = bar; b.x = xb_xcc_id(); b.st = st;
    if (threadIdx.x == 0) (void)xb_add(&bar[XB_XCNT(b.x)], 1u);
    return b;
}
__device__ __forceinline__ void xcd_barrier_complete(unsigned* bar, unsigned x, unsigned& nloc, unsigned& nx) {
    const unsigned G = gridDim.x * gridDim.y * gridDim.z;
    unsigned sum, cnt, mine, sp = 0u;
    for (;;) {
        sum = 0u; cnt = 0u; mine = 0u;
#pragma unroll
        for (unsigned j = 0; j < 16; ++j) { const unsigned c = xb_ld(&bar[XB_XCNT(j)]); sum += c; cnt += (c > 0u) ? 1u : 0u; mine = (j == x) ? c : mine; }
        if (sum == G) break;
        __builtin_amdgcn_s_sleep(1);
        if ((++sp & 255u) == 0u) { if (xb_ld(&bar[XB_TMO])) break; if (sp > XB_SPIN_CAP) { atomicAdd(&bar[XB_TMO], 1u); break; } }
    }
    nloc = mine > 0u ? mine : 1u; nx = cnt > 0u ? cnt : 1u;
}
__device__ __forceinline__ void xcd_barrier(const XcdBarrier& b) {
    asm volatile("s_waitcnt vmcnt(0)" ::: "memory");
    __syncthreads();
    if (threadIdx.x == 0) {
        unsigned* bar = b.bar;
        __builtin_amdgcn_s_waitcnt(0);
        unsigned nloc = b.st[0], nx = b.st[1];
        if (nloc == 0u) { xcd_barrier_complete(bar, b.x, nloc, nx); b.st[0] = nloc; b.st[1] = nx; }
        const unsigned old = xb_add(&bar[XB_XSUB(b.x)], 1u);
        const unsigned gen = old / nloc;
        if (old + 1u == (gen + 1u) * nloc) {
            __builtin_amdgcn_fence(__ATOMIC_RELEASE, "agent");
            asm volatile("s_waitcnt vmcnt(0)" ::: "memory");
            const unsigned og = xb_add(&bar[XB_TOP], 1u);
            const unsigned tg = og / nx;
            if (og + 1u == (tg + 1u) * nx) xb_add(&bar[XB_TOPGEN], 1u);
            else XB_SPIN(xb_ld(&bar[XB_TOPGEN]) == tg, bar);
            __builtin_amdgcn_fence(__ATOMIC_ACQUIRE, "agent");
            xb_add(&bar[XB_XGEN(b.x)], 1u);
            asm volatile("s_waitcnt vmcnt(0)" ::: "memory");
        } else {
            XB_SPIN(xb_ld(&bar[XB_XGEN(b.x)]) == gen, bar);
            __builtin_amdgcn_fence(__ATOMIC_ACQUIRE, "agent");
            asm volatile("s_waitcnt vmcnt(0)" ::: "memory");
        }
    }
    __syncthreads();
}

struct TrItem { const float* W; unsigned char* WT; int ldw, k0, n0, ldt, rd0, fp8; float scale; };
__device__ __forceinline__ void tr_load(const TrItem& t, f32x4 (&wv)[8], int lane) {
#pragma unroll
    for (int i = 0; i < 8; ++i) wv[i] = *(const f32x4*)(t.W + (size_t)(t.k0 + 8 * i + (lane >> 3)) * t.ldw + t.n0 + 4 * (lane & 7));
}
__device__ __forceinline__ void tr_store(const TrItem& t, const f32x4 (&wv)[8], LAS float* scr, int lane) {
#pragma unroll
    for (int i = 0; i < 8; ++i) { LAS float* p = scr + (8 * i + (lane >> 3)) * 33 + 4 * (lane & 7); const f32x4 v = wv[i] * t.scale; p[0] = v.x; p[1] = v.y; p[2] = v.z; p[3] = v.w; }
    LDS_WAIT(); asm volatile("" ::: "memory");
    const int c = lane & 7;
#pragma unroll
    for (int j = 0; j < 4; ++j) { const int n = (lane >> 3) + 8 * j; const LAS float* s = scr + (8 * c) * 33 + n;
        if (t.fp8) { u32x2 o; o.x = pk4_fp8(s[0 * 33], s[1 * 33], s[2 * 33], s[3 * 33]); o.y = pk4_fp8(s[4 * 33], s[5 * 33], s[6 * 33], s[7 * 33]);
            *(u32x2*)(t.WT + (size_t)(t.rd0 + n) * t.ldt + t.k0 + 8 * c) = o; }
        else { u32x4 o; o.x = cvt_pk_bf16(s[0 * 33], s[1 * 33]); o.y = cvt_pk_bf16(s[2 * 33], s[3 * 33]); o.z = cvt_pk_bf16(s[4 * 33], s[5 * 33]); o.w = cvt_pk_bf16(s[6 * 33], s[7 * 33]);
            *(u32x4*)((bf16*)t.WT + (size_t)(t.rd0 + n) * t.ldt + t.k0 + 8 * c) = o; } }
    LDS_WAIT(); asm volatile("" ::: "memory");
}
__device__ __forceinline__ void tr8_load(const TrItem& t, f32x4 (&wv)[16], int lane) {
#pragma unroll
    for (int i = 0; i < 16; ++i) wv[i] = *(const f32x4*)(t.W + (size_t)(t.k0 + 8 * i + (lane >> 3)) * t.ldw + t.n0 + 4 * (lane & 7));
}
__device__ __forceinline__ void tr8_store(const TrItem& t, const f32x4 (&wv)[16], LAS float* scr, int lane) {
#pragma unroll
    for (int i = 0; i < 16; ++i) { LAS float* p = scr + (8 * i + (lane >> 3)) * 33 + 4 * (lane & 7); const f32x4 v = wv[i] * t.scale; p[0] = v.x; p[1] = v.y; p[2] = v.z; p[3] = v.w; }
    LDS_WAIT(); asm volatile("" ::: "memory");
    const int n = lane >> 1, kh = lane & 1; const LAS float* s = scr + (64 * kh) * 33 + n;
    unsigned char* dst = t.WT + (size_t)(t.rd0 + n) * t.ldt + t.k0 + 64 * kh;
#pragma unroll
    for (int q = 0; q < 4; ++q) { u32x4 o;
#pragma unroll
        for (int w = 0; w < 4; ++w) { const int k = 16 * q + 4 * w; o[w] = pk4_fp8(s[k * 33], s[(k + 1) * 33], s[(k + 2) * 33], s[(k + 3) * 33]); }
        *(u32x4*)(dst + 16 * q) = o; }
    LDS_WAIT(); asm volatile("" ::: "memory");
}
struct Tr8Desc { const float* W; unsigned char* WT; int ldw, k0, n0, ldt, mode; };
__device__ __forceinline__ void tr8_wg_load(const Tr8Desc& d, f32x4 (&wv)[16]) {
    const int tid = threadIdx.x;
#pragma unroll
    for (int i = 0; i < 16; ++i) { const int idx = tid + 512 * i; wv[i] = *(const f32x4*)(d.W + (size_t)(d.k0 + (idx >> 6)) * d.ldw + d.n0 + 4 * (idx & 63)); }
    asm volatile("" ::: "memory");
}
__device__ __forceinline__ void tr8_wg_finish(const Tr8Desc& d, const f32x4 (&wv)[16], float scale, LAS float* scr) {
    const int tid = threadIdx.x;
    __syncthreads();
#pragma unroll
    for (int i = 0; i < 16; ++i) { const int idx = tid + 512 * i; *(LAS f32x4*)(scr + (idx >> 6) * 260 + 4 * (idx & 63)) = wv[i] * scale; }
    __syncthreads();
    const int n = tid >> 1, kh = tid & 1, c = d.n0 + n; const int row = d.mode == 0 ? c : (c >> 7) * 256 + (d.mode - 1) * 128 + (c & 127);
    const LAS float* sp = scr + (64 * kh) * 260 + n; unsigned char* dst = d.WT + (size_t)row * d.ldt + d.k0 + 64 * kh;
#pragma unroll
    for (int q = 0; q < 4; ++q) { u32x4 o;
#pragma unroll
        for (int w = 0; w < 4; ++w) { const int k = 16 * q + 4 * w; o[w] = pk4_fp8(sp[k * 260], sp[(k + 1) * 260], sp[(k + 2) * 260], sp[(k + 3) * 260]); }
        *(u32x4*)(dst + 16 * q) = o; }
}
__device__ __forceinline__ void tr_i8_cols_wg(const float* W, int ldw, int n0, unsigned char* WT  , float* steps  , LAS float* scr) {
    const int tid = threadIdx.x; LAS float* red = scr + 1024 * 33;
    __syncthreads();
#pragma unroll 1
    for (int h = 0; h < 2; ++h) { f32x4 wv[8];
#pragma unroll
        for (int i = 0; i < 8; ++i) { const int idx = tid + 512 * (8 * h + i); wv[i] = *(const f32x4*)(W + (size_t)(idx >> 3) * ldw + n0 + 4 * (idx & 7)); }
#pragma unroll
        for (int i = 0; i < 8; ++i) { const int idx = tid + 512 * (8 * h + i); LAS float* p = scr + (idx >> 3) * 33 + 4 * (idx & 7); p[0] = wv[i].x; p[1] = wv[i].y; p[2] = wv[i].z; p[3] = wv[i].w; } }
    __syncthreads();
    const int n = tid & 31, part = tid >> 5; float mx = 0.f;
#pragma unroll 8
    for (int k = 0; k < 64; ++k) mx = __builtin_fmaxf(mx, __builtin_fabsf(scr[(64 * part + k) * 33 + n]));
    red[part * 32 + n] = mx;
    __syncthreads();
    if (tid < 32) { float m2 = 1e-30f;
#pragma unroll
        for (int p = 0; p < 16; ++p) m2 = __builtin_fmaxf(m2, red[p * 32 + tid]);
        steps[tid] = m2 * (1.0f / 127.0f); red[512 + tid] = 127.0f / m2; }
    __syncthreads();
    const float inv = red[512 + n]; const LAS float* sp = scr + (64 * part) * 33 + n; unsigned char* dst = WT + (size_t)n * 1024 + 64 * part;
#pragma unroll
    for (int q = 0; q < 4; ++q) { u32x4 o;
#pragma unroll
        for (int w = 0; w < 4; ++w) { const int k = 16 * q + 4 * w; o[w] = pk4_i8(sp[k * 33] * inv, sp[(k + 1) * 33] * inv, sp[(k + 2) * 33] * inv, sp[(k + 3) * 33] * inv); }
        *(u32x4*)(dst + 16 * q) = o; }
    __syncthreads();
}
__device__ __forceinline__ void norm_rows4(const float* x0, const float* g, unsigned char* h0, float* steps, int lane) {
    f32x4 v[4][4]; float s[4], mx[4];
#pragma unroll
    for (int r = 0; r < 4; ++r)
#pragma unroll
        for (int j = 0; j < 4; ++j) v[r][j] = ((const f32x4*)(x0 + (size_t)r * D) + lane)[64 * j];
#pragma unroll
    for (int r = 0; r < 4; ++r) { s[r] = 0.f; mx[r] = 0.f;
#pragma unroll
        for (int j = 0; j < 4; ++j) { s[r] += (v[r][j].x * v[r][j].x + v[r][j].y * v[r][j].y) + (v[r][j].z * v[r][j].z + v[r][j].w * v[r][j].w);
            const f32x4 gv = ((const f32x4*)g + lane)[64 * j]; v[r][j] = v[r][j] * gv;
            mx[r] = __builtin_fmaxf(mx[r], __builtin_fmaxf(__builtin_fmaxf(__builtin_fabsf(v[r][j].x), __builtin_fabsf(v[r][j].y)), __builtin_fmaxf(__builtin_fabsf(v[r][j].z), __builtin_fabsf(v[r][j].w)))); } }
#pragma unroll
    for (int o = 1; o < 64; o <<= 1) {
#pragma unroll
        for (int r = 0; r < 4; ++r) { s[r] += __shfl_xor(s[r], o); mx[r] = __builtin_fmaxf(mx[r], __shfl_xor(mx[r], o)); } }
#pragma unroll
    for (int r = 0; r < 4; ++r) { const float rs = 1.0f / sqrtf(s[r] * (1.0f / D) + EPS); const float m = __builtin_fmaxf(mx[r], 1e-30f), inv = 127.0f / m;
        if (lane == 0) steps[r] = m * rs * (1.0f / 127.0f);
        unsigned* o4 = (unsigned*)(h0 + (size_t)r * 1024) + lane;
#pragma unroll
        for (int j = 0; j < 4; ++j) o4[64 * j] = pk4_i8(v[r][j].x * inv, v[r][j].y * inv, v[r][j].z * inv, v[r][j].w * inv); }
}

struct Args { const float* in[26]; float* out; unsigned char* ws; int ph_lo, ph_hi, li, pad; };

__device__ __forceinline__ TrItem p0_item(const Args& a, unsigned char* ws, int it) {
    constexpr int I_OUT = 16 * 32, I_AX = 8 * 2 * 8;
    TrItem t; t.fp8 = 0; t.scale = 1.0f; int r = it;
    if (r < I_OUT) { t.W = a.in[9]; t.ldw = 1024; t.k0 = 64 * (r / 32); t.n0 = 32 * (r % 32); t.WT = ws + WS_WO; t.ldt = 1024; t.rd0 = t.n0; return t; } r -= I_OUT;
    if (r < I_AX) { const int h = r / 16, gate = (r / 8) & 1, kb = (r / 4) & 1, nb = r & 3;
        t.W = (gate ? a.in[15] : a.in[13]) + (size_t)h * 16384; t.ldw = 128; t.k0 = 64 * kb; t.n0 = 32 * nb; t.WT = ws + WS_WAX + (size_t)h * 256 * 128 * 2; t.ldt = 128; t.rd0 = gate * 128 + 32 * nb; t.scale = -1.44269504f; return t; } r -= I_AX;
    { const int l = r / 16, kb = r % 16; t.W = a.in[21] + (size_t)l * 1024 * 32; t.ldw = 32; t.k0 = 64 * kb; t.n0 = 0; t.WT = ws + WS_WRT + (size_t)l * 48 * 1024 * 2; t.ldt = 1024; t.rd0 = 0; }
    return t;
}
__device__ __forceinline__ TrItem p0_item8(const Args& a, unsigned char* ws, int it) {
    constexpr int I_CO = 8 * 32;
    TrItem t; t.fp8 = 1; t.scale = FP8_SW; int r = it;
    if (r < I_CO) { t.W = a.in[18]; t.ldw = 1024; t.k0 = 128 * (r / 32); t.n0 = 32 * (r % 32); t.WT = ws + WS_WCO; t.ldt = 1024; t.rd0 = t.n0; return t; } r -= I_CO;
    const int le = r / 384, q = r % 384;
    if (q < 256) { const int up = q / 128, qq = q % 128, kb = qq / 16, nb = qq % 16, n0 = 32 * nb;
        t.W = (up ? a.in[24] : a.in[23]) + (size_t)le * 1024 * 512; t.ldw = 512; t.k0 = 128 * kb; t.n0 = n0; t.WT = ws + WS_WGU + (size_t)le * 1024 * 1024; t.ldt = 1024; t.rd0 = (n0 / 128) * 256 + up * 128 + (n0 % 128); }
    else { const int qq = q - 256, kb = qq / 32, nb = qq % 32;
        t.W = a.in[25] + (size_t)le * 512 * 1024; t.ldw = 1024; t.k0 = 128 * kb; t.n0 = 32 * nb; t.WT = ws + WS_WD + (size_t)le * 1024 * 512; t.ldt = 512; t.rd0 = 32 * nb; }
    return t;
}
__device__ __forceinline__ Tr8Desc p0_slab8(const Args& a, unsigned char* ws, int it) {
    Tr8Desc d;
    if (it < 32) { d.W = a.in[18]; d.ldw = 1024; d.k0 = 128 * (it >> 2); d.n0 = 256 * (it & 3); d.WT = ws + WS_WCO; d.ldt = 1024; d.mode = 0; return d; }
    const int r = it - 32, le = r / 48, q = r % 48;
    if (q < 32) { const int up = q >> 4, kb = (q & 15) >> 1, nh = q & 1;
        d.W = (up ? a.in[24] : a.in[23]) + (size_t)le * 1024 * 512; d.ldw = 512; d.k0 = 128 * kb; d.n0 = 256 * nh; d.WT = ws + WS_WGU + (size_t)le * 1024 * 1024; d.ldt = 1024; d.mode = 1 + up; }
    else { const int qq = q - 32, kb = qq >> 2, nq = qq & 3;
        d.W = a.in[25] + (size_t)le * 512 * 1024; d.ldw = 1024; d.k0 = 128 * kb; d.n0 = 256 * nq; d.WT = ws + WS_WD + (size_t)le * 1024 * 512; d.ldt = 512; d.mode = 0; }
    return d;
}
__device__ __forceinline__ void p0_prologue(const Args& a, LAS unsigned char* lds, int G, int wave, int lane, const int parts = 3) {
    unsigned char* ws = a.ws;
    LAS float* scr = (LAS float*)(lds + wave * 16896);
    const int gw = blockIdx.x * 8 + wave, NGW = G * 8;
    constexpr int NITEMS = 16 * 32 + 8 * 2 * 8 + 2 * 16, NITEMS8 = 8 * 32 + 64 * 384;
    if (parts & 1) {
        for (int tl = blockIdx.x; tl < 64 + 80; tl += G) {
            if (tl < 64) { tr_i8_cols_wg(a.in[10], 2048, 32 * tl, ws + WS_WC + (size_t)(32 * tl) * 1024, (float*)(ws + WS_SWC) + 32 * tl, (LAS float*)lds); continue; }
            const int n0 = 32 * (tl - 64); int drow; unsigned char* WT; float* st;
            if (n0 < 512) { drow = n0; WT = ws + WS_WREST; st = (float*)(ws + WS_SWR); }
            else if (n0 < 1024) { drow = n0 - 512; WT = ws + WS_WV; st = (float*)(ws + WS_SWV); }
            else if (n0 < 1536) { drow = n0 - 512; WT = ws + WS_WREST; st = (float*)(ws + WS_SWR); }
            else { const int xb = n0 >= 2048, c = n0 - (xb ? 2048 : 1536); drow = 1024 + (c / 128) * 256 + xb * 128 + (c % 128); WT = ws + WS_WREST; st = (float*)(ws + WS_SWR); }
            tr_i8_cols_wg(a.in[4], 2560, n0, WT + (size_t)drow * 1024, st + drow, (LAS float*)lds);
        }
        {
            constexpr int NSLAB = 32 + 64 * 48;
            int it = blockIdx.x; Tr8Desc da, db; f32x4 wa[16], wb[16];
            bool ha = it < NSLAB; if (ha) { da = p0_slab8(a, ws, it); tr8_wg_load(da, wa); }
            while (ha) {
                const int itb = it + G; const bool hb = itb < NSLAB; if (hb) { db = p0_slab8(a, ws, itb); tr8_wg_load(db, wb); }
                tr8_wg_finish(da, wa, FP8_SW, (LAS float*)lds);
                if (!hb) break;
                it = itb + G; ha = it < NSLAB; if (ha) { da = p0_slab8(a, ws, it); tr8_wg_load(da, wa); }
                tr8_wg_finish(db, wb, FP8_SW, (LAS float*)lds);
            }
        }
        __syncthreads();
        for (int it = gw; it < NITEMS; it += NGW) { const TrItem t = p0_item(a, ws, it); f32x4 w0[8]; tr_load(t, w0, lane); tr_store(t, w0, scr, lane); }
    }
    const int gt = blockIdx.x * 512 + threadIdx.x, NGT = G * 512;
    for (int i = gt; i < 2 * 16 * 1024; i += NGT) {
        const int l = i / 16384, n = (i / 1024) & 15, k = i & 1023;
        const float v = n < 4 ? a.in[19][(size_t)l * 4096 + k * 4 + n] : 0.f;
        ((bf16*)(ws + WS_WRT))[(size_t)l * 48 * 1024 + (size_t)(32 + n) * 1024 + k] = (bf16)(cvt_pk_bf16(v, 0.f) & 0xffffu); }
    for (int i = gt; i < 4 * 128 * 128; i += NGT) {
        const int t = (i >> 7) & 127, s = i & 127; const float v = s <= t ? a.in[6][i] : 0.f;
        ((bf16*)(ws + WS_WSB))[i] = (bf16)(cvt_pk_bf16(v, 0.f) & 0xffffu); }
    if (parts & 2)
    for (int m = 4 * gw; m < M; m += 4 * NGW) norm_rows4(a.in[0] + (size_t)m * D, a.in[1], ws + WS_H + (size_t)m * 1024, (float*)(ws + WS_SH) + m, lane);
}
__device__ __forceinline__ void norm_phase(const bf16* xb, const float* g, unsigned char* H8i, float* steps, int G, int wave, int lane) {
    const int gw = blockIdx.x * 8 + wave, NGW = G * 8;
    constexpr int NR = 8;
    for (int m = NR * gw; m < M; m += NR * NGW) {
        u32x4 v[NR][2]; float s[NR], mx[NR];
#pragma unroll
        for (int r = 0; r < NR; ++r)
#pragma unroll
            for (int j = 0; j < 2; ++j) v[r][j] = ((const u32x4*)(xb + (size_t)(m + r) * D) + lane)[64 * j];
        f32x4 gg[2][2];
#pragma unroll
        for (int j = 0; j < 2; ++j) { gg[j][0] = *(const f32x4*)(g + 8 * lane + 512 * j); gg[j][1] = *(const f32x4*)(g + 8 * lane + 512 * j + 4); }
#pragma unroll
        for (int r = 0; r < NR; ++r) { s[r] = 0.f; mx[r] = 0.f;
#pragma unroll
            for (int j = 0; j < 2; ++j)
#pragma unroll
                for (int k = 0; k < 4; ++k) { const float lo = bflo(v[r][j][k]), hi = bfhi(v[r][j][k]); s[r] += lo * lo + hi * hi;
                    mx[r] = __builtin_fmaxf(mx[r], __builtin_fmaxf(__builtin_fabsf(lo * gg[j][k >> 1][2 * (k & 1)]), __builtin_fabsf(hi * gg[j][k >> 1][2 * (k & 1) + 1]))); } }
#pragma unroll
        for (int o = 1; o < 64; o <<= 1) {
#pragma unroll
            for (int r = 0; r < NR; ++r) { s[r] += __shfl_xor(s[r], o); mx[r] = __builtin_fmaxf(mx[r], __shfl_xor(mx[r], o)); } }
#pragma unroll
        for (int r = 0; r < NR; ++r) { const float rs = 1.0f / sqrtf(s[r] * (1.0f / D) + EPS); const float mm = __builtin_fmaxf(mx[r], 1e-30f), inv = 127.0f / mm;
            if (lane == 0) steps[m + r] = mm * rs * (1.0f / 127.0f);
            u32x2* hr = (u32x2*)(H8i + (size_t)(m + r) * 1024) + lane;
#pragma unroll
            for (int j = 0; j < 2; ++j) { const f32x4 g0 = gg[j][0] * inv, g1 = gg[j][1] * inv; u32x2 o;
                o.x = pk4_i8(bflo(v[r][j].x) * g0.x, bfhi(v[r][j].x) * g0.y, bflo(v[r][j].y) * g0.z, bfhi(v[r][j].y) * g0.w);
                o.y = pk4_i8(bflo(v[r][j].z) * g1.x, bfhi(v[r][j].z) * g1.y, bflo(v[r][j].w) * g1.z, bfhi(v[r][j].w) * g1.w); hr[64 * j] = o; } }
    }
}
__device__ __forceinline__ void final_norm_phase(const bf16* xb, float* out, const float* g, int G, int wave, int lane) {
    const int gw = blockIdx.x * 8 + wave, NGW = G * 8;
    constexpr int NR = 8;
    for (int m = NR * gw; m < M; m += NR * NGW) {
        u32x4 v[NR][2]; float s[NR];
#pragma unroll
        for (int r = 0; r < NR; ++r)
#pragma unroll
            for (int j = 0; j < 2; ++j) v[r][j] = ((const u32x4*)(xb + (size_t)(m + r) * D) + lane)[64 * j];
#pragma unroll
        for (int r = 0; r < NR; ++r) { s[r] = 0.f;
#pragma unroll
            for (int j = 0; j < 2; ++j)
#pragma unroll
                for (int k = 0; k < 4; ++k) { const float lo = bflo(v[r][j][k]), hi = bfhi(v[r][j][k]); s[r] += lo * lo + hi * hi; } }
#pragma unroll
        for (int o = 1; o < 64; o <<= 1) {
#pragma unroll
            for (int r = 0; r < NR; ++r) s[r] += __shfl_xor(s[r], o); }
#pragma unroll
        for (int r = 0; r < NR; ++r) { const float rs = 1.0f / sqrtf(s[r] * (1.0f / D) + EPS); float* orow = out + (size_t)(m + r) * D;
#pragma unroll
            for (int j = 0; j < 2; ++j) { const f32x4 g0 = *(const f32x4*)(g + 8 * lane + 512 * j) * rs, g1 = *(const f32x4*)(g + 8 * lane + 512 * j + 4) * rs;
                *(f32x4*)(orow + 8 * lane + 512 * j) = (f32x4){bflo(v[r][j].x) * g0.x, bfhi(v[r][j].x) * g0.y, bflo(v[r][j].y) * g0.z, bfhi(v[r][j].y) * g0.w};
                *(f32x4*)(orow + 8 * lane + 512 * j + 4) = (f32x4){bflo(v[r][j].z) * g1.x, bfhi(v[r][j].z) * g1.y, bflo(v[r][j].w) * g1.z, bfhi(v[r][j].w) * g1.w}; } }
    }
}

__device__ __forceinline__ void p2_spatial(const Args& a, LAS unsigned char* lds, int G, int wave, int lane) {
    const bf16* ZR = (const bf16*)(a.ws + WS_Z); const bf16* VT = (const bf16*)(a.ws + WS_VT); bf16* Y = (bf16*)(a.ws + WS_Y); const bf16* WSB = (const bf16*)(a.ws + WS_WSB);
    LAS unsigned char* T = lds;
    LAS float* MU = (LAS float*)(lds + 131072); LAS float* RS = MU + 128; LAS float* PART = (LAS float*)(lds + 131072 + 1024);
    const int tid = threadIdx.x, fr = lane & 15, fq = lane >> 4;
    bf16x8 Af[4][4];
    { const int hh = wave >> 1, rh = wave & 1;
#pragma unroll
        for (int ks = 0; ks < 4; ++ks)
#pragma unroll
            for (int m = 0; m < 4; ++m) Af[ks][m] = *(const bf16x8*)(WSB + (size_t)((hh * 128 + 64 * rh + 16 * m + fr) * 128 + 32 * ks + 8 * fq)); }
    for (int unit_ = blockIdx.x; unit_ < M / 128; unit_ += G) { const int unit = M / 128 - 1 - unit_;
        const size_t row0 = (size_t)unit * 128;
        u32x4 vt0[8];
#pragma unroll
        for (int p = 0; p < 8; ++p) vt0[p] = *(const u32x4*)(VT + (size_t)(p * 32 + (tid >> 4)) * M + row0 + (tid & 15) * 8);
        asm volatile("" ::: "memory");
        {
            const int cg = tid & 63, rg = tid >> 6, c0 = 8 * cg; const size_t R = row0 + 16 * rg;
            float w0[8], w1[8], w2[8], p2v[8], p1v[8];
#pragma unroll
            for (int j = 0; j < 8; ++j) { w0[j] = a.in[8][c0 + j]; w1[j] = a.in[8][512 + c0 + j]; w2[j] = a.in[8][1024 + c0 + j]; p2v[j] = 0.f; p1v[j] = 0.f; }
            if ((R & (SEQ - 1)) != 0) {
                const u32x4 c2 = *(const u32x4*)(ZR + (R - 2) * 2048 + 1024 + c0), c1 = *(const u32x4*)(ZR + (R - 1) * 2048 + 1024 + c0);
#pragma unroll
                for (int j = 0; j < 4; ++j) { p2v[2 * j] = bflo(c2[j]); p2v[2 * j + 1] = bfhi(c2[j]); p1v[2 * j] = bflo(c1[j]); p1v[2 * j + 1] = bfhi(c1[j]); }
            }
#pragma unroll 8
            for (int r = 0; r < 16; ++r) { const bf16* zr = ZR + (R + r) * 2048 + c0;
                const u32x4 gb = *(const u32x4*)(zr + 512), cxw = *(const u32x4*)(zr + 1024);
                float cx[8], y[8];
#pragma unroll
                for (int j = 0; j < 4; ++j) { cx[2 * j] = bflo(cxw[j]); cx[2 * j + 1] = bfhi(cxw[j]); }
#pragma unroll
                for (int j = 0; j < 8; ++j) { const float gbj = (j & 1) ? bfhi(gb[j >> 1]) : bflo(gb[j >> 1]); y[j] = gbj * (w0[j] * p2v[j] + w1[j] * p1v[j] + w2[j] * cx[j]); p2v[j] = p1v[j]; p1v[j] = cx[j]; }
                u32x4 o; o.x = cvt_pk_bf16(y[0], y[1]); o.y = cvt_pk_bf16(y[2], y[3]); o.z = cvt_pk_bf16(y[4], y[5]); o.w = cvt_pk_bf16(y[6], y[7]);
                *(u32x4*)(Y + (R + r) * 1024 + 512 + c0) = o; }
        }
        {   u32x4 vt[8];
#pragma unroll
            for (int p = 0; p < 8; ++p) vt[p] = *(const u32x4*)(VT + (size_t)((8 + p) * 32 + (tid >> 4)) * M + row0 + (tid & 15) * 8);
#pragma unroll
            for (int p = 0; p < 8; ++p) { const int row = p * 32 + (tid >> 4), ch = tid & 15; *(LAS u32x4*)(T + row * 256 + ((ch ^ (row & 15)) << 4)) = vt0[p]; }
#pragma unroll
            for (int p = 0; p < 8; ++p) { const int row = (8 + p) * 32 + (tid >> 4), ch = tid & 15; *(LAS u32x4*)(T + row * 256 + ((ch ^ (row & 15)) << 4)) = vt[p]; } }
        __syncthreads();
        const int sg = tid & 15, dg = tid >> 4;
        {   float s[8], q[8];
#pragma unroll
            for (int j = 0; j < 8; ++j) { s[j] = 0.f; q[j] = 0.f; }
#pragma unroll 4
            for (int rr = 0; rr < 16; ++rr) { const u32x4 v = *(const LAS u32x4*)(T + (16 * dg + rr) * 256 + ((sg ^ rr) << 4));
#pragma unroll
                for (int j = 0; j < 4; ++j) { const float lo = bflo(v[j]), hi = bfhi(v[j]); s[2 * j] += lo; q[2 * j] += lo * lo; s[2 * j + 1] += hi; q[2 * j + 1] += hi * hi; } }
#pragma unroll
            for (int j = 0; j < 8; ++j) { s[j] += __shfl_xor(s[j], 16); s[j] += __shfl_xor(s[j], 32); q[j] += __shfl_xor(q[j], 16); q[j] += __shfl_xor(q[j], 32); }
            if (lane < 16) {
#pragma unroll
                for (int j = 0; j < 8; ++j) { PART[(wave * 128 + 8 * sg + j) * 2] = s[j]; PART[(wave * 128 + 8 * sg + j) * 2 + 1] = q[j]; } }
        }
        __syncthreads();
        if (tid < 128) { float s = 0.f, q = 0.f;
#pragma unroll
            for (int w = 0; w < 8; ++w) { s += PART[(w * 128 + tid) * 2]; q += PART[(w * 128 + tid) * 2 + 1]; }
            const float mean = s * (1.0f / 512.0f); float var = q * (1.0f / 512.0f) - mean * mean; var = var > 0.f ? var : 0.f;
            MU[tid] = mean; RS[tid] = 1.0f / sqrtf(var + EPS); }
        __syncthreads();
        {   float mu8[8], rs8[8];
#pragma unroll
            for (int j = 0; j < 8; ++j) { mu8[j] = MU[8 * sg + j]; rs8[j] = RS[8 * sg + j]; }
#pragma unroll 4
            for (int rr = 0; rr < 16; ++rr) { const int row = 16 * dg + rr; const float gd = a.in[5][row]; LAS u32x4* pp = (LAS u32x4*)(T + row * 256 + ((sg ^ rr) << 4)); const u32x4 v = *pp; u32x4 o;
#pragma unroll
                for (int j = 0; j < 4; ++j) o[j] = cvt_pk_bf16((bflo(v[j]) - mu8[2 * j]) * rs8[2 * j] * gd, (bfhi(v[j]) - mu8[2 * j + 1]) * rs8[2 * j + 1] * gd);
                *pp = o; }
        }
        __syncthreads();
        {   const int hh = wave >> 1, rh = wave & 1;
#pragma unroll 1
            for (int nh = 0; nh < 2; ++nh) {
                f32x4 acc[4][4];
#pragma unroll
                for (int m = 0; m < 4; ++m)
#pragma unroll
                    for (int n = 0; n < 4; ++n) acc[m][n] = (f32x4){0.f, 0.f, 0.f, 0.f};
#pragma unroll
                for (int ks = 0; ks < 4; ++ks) {
#pragma unroll
                    for (int n = 0; n < 4; ++n) { const bf16x8 Bf = *(const LAS bf16x8*)(T + (hh * 128 + 64 * nh + 16 * n + fr) * 256 + (((4 * ks + fq) ^ fr) << 4));
#pragma unroll
                        for (int m = 0; m < 4; ++m) acc[m][n] = __builtin_amdgcn_mfma_f32_16x16x32_bf16(Bf, Af[ks][m], acc[m][n], 0, 0, 0); } }
#pragma unroll
                for (int m = 0; m < 4; ++m) { const int t = 64 * rh + 16 * m + fr; const size_t R = row0 + t; const float bias = a.in[7][hh * 128 + t];
#pragma unroll
                    for (int n = 0; n < 4; ++n) { const int d = hh * 128 + 64 * nh + 16 * n + 4 * fq; const u32x2 u4 = *(const u32x2*)(ZR + R * 2048 + d);
                        u32x2 o; o.x = cvt_pk_bf16(bflo(u4.x) * (acc[m][n][0] + bias), bfhi(u4.x) * (acc[m][n][1] + bias)); o.y = cvt_pk_bf16(bflo(u4.y) * (acc[m][n][2] + bias), bfhi(u4.y) * (acc[m][n][3] + bias));
                        *(u32x2*)(Y + R * 1024 + d) = o; } }
            }
        }
        __syncthreads();
    }
}

__device__ __forceinline__ void route_phase(const Args& a, int l, LAS unsigned char* lds, int G, int wave, int lane) {
    const bf16* X = (const bf16*)(a.ws + WS_XB); unsigned char* H8 = a.ws + WS_H;
    const bf16* WRT = (const bf16*)(a.ws + WS_WRT) + (size_t)l * 48 * 1024; const float* gvec = a.in[2] + l * 1024;
    const float* brg = a.in[20] + l * 4; const float* bre = a.in[22] + l * 32;
    unsigned* ECNT = (unsigned*)(a.ws + WS_CTL) + CW_ECNT + l * 2048; unsigned* PCNT = (unsigned*)(a.ws + WS_CTL) + CW_PCNT + l * 7168;
    unsigned* ELT = (unsigned*)(a.ws + WS_ELT); unsigned* ELG = (unsigned*)(a.ws + WS_ELG); unsigned* PLT = (unsigned*)(a.ws + WS_PLT);
    constexpr int WROW = 2064;
    LAS unsigned char* WL = lds; LAS float* GL = (LAS float*)(lds + 99072); LAS float* SCR = (LAS float*)(lds + 103168) + wave * 768;
    LAS int* TOK = (LAS int*)(lds + 127744);
    LAS int* HIST = (LAS int*)(lds + 135936);
    const int tid = threadIdx.x, fr = lane & 15, fq = lane >> 4;
    for (int tile = blockIdx.x; tile < M / 256; tile += G) {
        __syncthreads();
        for (int i = tid; i < 48 * 128; i += 512) { const int row = i >> 7, ch = i & 127; *(LAS u32x4*)(WL + row * WROW + ch * 16) = *(const u32x4*)(WRT + (size_t)row * 1024 + ch * 8); }
        if (tid < 256) *(LAS f32x4*)(GL + 4 * tid) = *(const f32x4*)(gvec + 4 * tid);
        if (tid < 288) HIST[tid] = 0;
        __syncthreads();
        for (int mt = 2 * wave; mt < 2 * wave + 2; ++mt) {
            const size_t row = (size_t)tile * 256 + 16 * mt + fr; const bf16* xr = X + row * D; unsigned char* hr = H8 + row * 1024;
            f32x4 acc[3]; acc[0] = acc[1] = acc[2] = (f32x4){0.f, 0.f, 0.f, 0.f}; float ss = 0.f;
#pragma unroll 1
            for (int kb = 0; kb < 4; ++kb) {
                u32x4 xv[8];
#pragma unroll
                for (int j = 0; j < 8; ++j) xv[j] = *(const u32x4*)(xr + 32 * (8 * kb + (j & ~1)) + 16 * fq + 8 * (j & 1));
#pragma unroll
                for (int pp = 0; pp < 4; ++pp) { u32x4 h16;
#pragma unroll
                    for (int jj = 0; jj < 2; ++jj) { const int j = 2 * pp + jj; const int k0 = 32 * (8 * kb + 2 * pp) + 16 * fq + 8 * jj; const u32x4 xw = xv[j];
                        const f32x4 x0 = (f32x4){bflo(xw.x), bfhi(xw.x), bflo(xw.y), bfhi(xw.y)}, x1 = (f32x4){bflo(xw.z), bfhi(xw.z), bflo(xw.w), bfhi(xw.w)};
                        const f32x4 g0 = *(const LAS f32x4*)(GL + k0), g1 = *(const LAS f32x4*)(GL + k0 + 4);
                        ss += (x0.x * x0.x + x0.y * x0.y) + (x0.z * x0.z + x0.w * x0.w) + (x1.x * x1.x + x1.y * x1.y) + (x1.z * x1.z + x1.w * x1.w);
                        const f32x4 y0 = x0 * g0, y1 = x1 * g1;
                        u32x4 hw; hw.x = cvt_pk_bf16(y0.x, y0.y); hw.y = cvt_pk_bf16(y0.z, y0.w); hw.z = cvt_pk_bf16(y1.x, y1.y); hw.w = cvt_pk_bf16(y1.z, y1.w);
                        const bf16x8 Af = __builtin_bit_cast(bf16x8, hw);
                        h16[2 * jj] = pk4_fp8(y0.x, y0.y, y0.z, y0.w); h16[2 * jj + 1] = pk4_fp8(y1.x, y1.y, y1.z, y1.w);
#pragma unroll
                        for (int n = 0; n < 3; ++n) { const bf16x8 Bf = *(const LAS bf16x8*)(WL + (16 * n + fr) * WROW + k0 * 2); acc[n] = __builtin_amdgcn_mfma_f32_16x16x32_bf16(Bf, Af, acc[n], 0, 0, 0); } }
                    *(u32x4*)(hr + 32 * (8 * kb + 2 * pp) + 16 * fq) = h16; } }
            ss += __shfl_xor(ss, 16); ss += __shfl_xor(ss, 32);
            const float rstd = 1.0f / sqrtf(ss * (1.0f / D) + EPS);
#pragma unroll
            for (int n = 0; n < 3; ++n)
#pragma unroll
                for (int j = 0; j < 4; ++j) SCR[fr * 48 + 16 * n + 4 * fq + j] = acc[n][j] * rstd;
            LDS_WAIT(); asm volatile("" ::: "memory");
            if (lane < 16) { const LAS float* lg = SCR + lane * 48;
                float gl[4]; int gi = 0; float gm;
#pragma unroll
                for (int j = 0; j < 4; ++j) gl[j] = lg[32 + j] + brg[j];
                gm = gl[0];
#pragma unroll
                for (int j = 1; j < 4; ++j) if (gl[j] > gm) { gm = gl[j]; gi = j; }
                float den = 0.f;
#pragma unroll
                for (int j = 0; j < 4; ++j) den += __expf(gl[j] - gm);
                const float gp = 1.0f / den;
                float el[8];
#pragma unroll
                for (int j = 0; j < 8; ++j) el[j] = lg[8 * gi + j] + bre[8 * gi + j];
                int i1 = 0; float v1 = el[0];
#pragma unroll
                for (int j = 1; j < 8; ++j) if (el[j] > v1) { v1 = el[j]; i1 = j; }
                int i2 = -1; float v2 = -3.0e38f;
#pragma unroll
                for (int j = 0; j < 8; ++j) if (j != i1 && el[j] > v2) { v2 = el[j]; i2 = j; }
                const float e21 = __expf(v2 - v1), p1 = 1.0f / (1.0f + e21), p2 = e21 * p1;
                const int e1 = 8 * gi + i1, e2 = 8 * gi + i2; const int lo = i1 < i2 ? i1 : i2, hi = i1 < i2 ? i2 : i1;
                const int p = gi * 28 + (lo * (15 - lo)) / 2 + (hi - lo - 1);
                LAS int* tk = TOK + (16 * mt + lane) * 8;
                tk[0] = e1; tk[1] = e2; tk[2] = (int)cvt_pk_bf16(gp * p1, rstd); tk[3] = (int)cvt_pk_bf16(gp * p2, rstd);
                tk[4] = __hip_atomic_fetch_add(HIST + e1, 1, __ATOMIC_RELAXED, __HIP_MEMORY_SCOPE_WORKGROUP); tk[5] = __hip_atomic_fetch_add(HIST + e2, 1, __ATOMIC_RELAXED, __HIP_MEMORY_SCOPE_WORKGROUP); tk[6] = __hip_atomic_fetch_add(HIST + 32 + p, 1, __ATOMIC_RELAXED, __HIP_MEMORY_SCOPE_WORKGROUP); tk[7] = p; }
            LDS_WAIT(); asm volatile("" ::: "memory");
        }
        __syncthreads();
        if (tid < 32) { const int c = HIST[tid]; HIST[144 + tid] = c ? (int)__hip_atomic_fetch_add(ECNT + 64 * tid, (unsigned)c, __ATOMIC_RELAXED, __HIP_MEMORY_SCOPE_AGENT) : 0; }
        else if (tid < 144) { const int j = tid - 32; const int c = HIST[32 + j]; HIST[176 + j] = c ? (int)__hip_atomic_fetch_add(PCNT + 64 * j, (unsigned)c, __ATOMIC_RELAXED, __HIP_MEMORY_SCOPE_AGENT) : 0; }
        __syncthreads();
        if (tid < 256) { const LAS int* tk = TOK + tid * 8; const unsigned tok = (unsigned)(tile * 256 + tid);
            const int e1 = tk[0], e2 = tk[1]; const unsigned h1 = e1 < e2 ? 0u : 1u;
            const size_t s1 = (size_t)e1 * 65536 + HIST[144 + e1] + tk[4], s2 = (size_t)e2 * 65536 + HIST[144 + e2] + tk[5];
            ELT[s1] = tok | (h1 << 31); ELG[s1] = (unsigned)tk[2]; ELT[s2] = tok | ((1u - h1) << 31); ELG[s2] = (unsigned)tk[3];
            PLT[(size_t)tk[7] * 65536 + HIST[176 + tk[7]] + tk[6]] = tok; }
    }
}
__device__ __forceinline__ void build_tables(LAS unsigned char* lds, unsigned* counters, int ng) {
    LAS int* pref = (LAS int*)(lds + TAB_OFF); LAS int* cnt = pref + 130;
    __syncthreads();
    if ((int)threadIdx.x < ng) cnt[threadIdx.x] = (int)__hip_atomic_load(counters + 64 * threadIdx.x, __ATOMIC_RELAXED, __HIP_MEMORY_SCOPE_AGENT);
    __syncthreads();
    if (threadIdx.x == 0) { int s = 0; for (int g = 0; g < ng; ++g) { pref[g] = s; s += (cnt[g] + 255) >> 8; } for (int g = ng; g < 130; ++g) pref[g] = s; }
    __syncthreads();
}

__device__ __forceinline__ void conv_phase(const Args& a, int G) {
    const bf16* ZC = (const bf16*)(a.ws + WS_Z); bf16* XRC = (bf16*)(a.ws + WS_H);
    const int tid = threadIdx.x, cc = tid & 127, rg = tid >> 7, c0 = 8 * cc;
    float cw[5][8];
#pragma unroll
    for (int j = 0; j < 8; ++j) { cw[4][j] = a.in[12][c0 + j];
#pragma unroll
        for (int k = 0; k < 4; ++k) cw[k][j] = a.in[11][k * 1024 + c0 + j]; }
    for (int tile_ = blockIdx.x; tile_ < M / 64; tile_ += G) { const int tile = M / 64 - 1 - tile_;
        const size_t R = (size_t)tile * 64 + 16 * rg; const int pos0 = (int)(R & (SEQ - 1));
        u32x4 v[19];
#pragma unroll
        for (int r = 0; r < 19; ++r) { v[r] = (u32x4){0u, 0u, 0u, 0u}; if (pos0 + r - 3 >= 0) v[r] = *(const u32x4*)(ZC + (R + r - 3) * 2048 + 1024 + c0); }
#pragma unroll
        for (int i = 0; i < 16; ++i) { float o[8];
#pragma unroll
            for (int j = 0; j < 8; ++j) o[j] = cw[4][j];
#pragma unroll
            for (int k = 0; k < 4; ++k) { const u32x4 x = v[i + k];
#pragma unroll
                for (int j = 0; j < 4; ++j) { o[2 * j] += cw[k][2 * j] * bflo(x[j]); o[2 * j + 1] += cw[k][2 * j + 1] * bfhi(x[j]); } }
            u32x4 w; w.x = cvt_pk_bf16(o[0], o[1]); w.y = cvt_pk_bf16(o[2], o[3]); w.z = cvt_pk_bf16(o[4], o[5]); w.w = cvt_pk_bf16(o[6], o[7]);
            *(u32x4*)(XRC + (R + i) * 1024 + c0) = w; }
    }
}
__device__ __forceinline__ void scan_chain_phase(const Args& a, LAS unsigned char* lds, int G, int vcu, int wave, int lane) {
    const bf16* ZC = (const bf16*)(a.ws + WS_Z); const bf16* XRC = (const bf16*)(a.ws + WS_H); unsigned char* Y8 = a.ws + WS_Y;
    const bf16* WAX = (const bf16*)(a.ws + WS_WAX);
    LAS unsigned char* AT = lds;
    LAS f32x2* AGG = (LAS f32x2*)(lds + 65536);
    LAS unsigned char* GT = lds + 86016;
    LAS unsigned char* WL = lds + 69632;
    const int tid = threadIdx.x, fr = lane & 15, fq = lane >> 4;
    const int cc = tid & 15, rq = tid >> 4;
    for (int chain = vcu; chain < 256; chain += G) {
        const int b = chain >> 5, hd = (chain >> 2) & 7, cg = chain & 3;
        const size_t Rbase = (size_t)b * SEQ;
        float ba[2], bx[2], kl[2]; int chj[2];
#pragma unroll
        for (int j = 0; j < 2; ++j) { chj[j] = 128 * hd + 32 * cg + 16 * j + fr; ba[j] = -1.44269504f * a.in[14][chj[j]]; bx[j] = -1.44269504f * a.in[16][chj[j]];
            kl[j] = -8.0f * 1.44269504f * log1pf(__expf(-a.in[17][chj[j]])); }
        __syncthreads();
        for (int i = tid; i < 64 * 16; i += 512) { const int row = i >> 4, ch16 = i & 15;
            *(LAS u32x4*)(WL + row * 256 + ((ch16 ^ (row & 15)) << 4)) = *(const u32x4*)(WAX + (size_t)((hd * 256 + (row >> 5) * 128 + 32 * cg + (row & 31)) * 128 + 8 * ch16)); }
        float Hc[2] = {0.f, 0.f};
        const int t0l = 32 * wave + 8 * fq;
        u32x4 pr[8], pq[2];
#define CH_LOAD(sbn) do { const size_t R0n = Rbase + 256 * (sbn); \
            _Pragma("unroll") for (int p = 0; p < 8; ++p) pr[p] = *(const u32x4*)(XRC + (R0n + p * 32 + rq) * 1024 + 128 * hd + 8 * cc); \
            _Pragma("unroll") for (int p = 0; p < 2; ++p) { const int i_ = tid + 512 * p; pq[p] = *(const u32x4*)(ZC + (R0n + (i_ >> 2)) * 2048 + 128 * hd + 32 * cg + 8 * (i_ & 3)); } } while (0)
        CH_LOAD(0);
#pragma unroll 1
        for (int sb = 0; sb < 32; ++sb) {
            const size_t R0 = Rbase + 256 * sb; const int par = sb & 1;
#pragma unroll
            for (int p = 0; p < 8; ++p) { const int t = p * 32 + rq; const int key = (((t >> 3) & 3) << 2) | (t & 3); *(LAS u32x4*)(AT + t * 256 + ((cc ^ key) << 4)) = pr[p]; }
#pragma unroll
            for (int p = 0; p < 2; ++p) { const int i_ = tid + 512 * p, t = i_ >> 2; *(LAS u32x4*)(GT + par * 16384 + t * 64 + (((i_ & 3) ^ ((t >> 3) & 3)) << 4)) = pq[p]; }
            __syncthreads();
            if (sb > 0) {
#pragma unroll
                for (int p = 0; p < 2; ++p) { const int i_ = tid + 512 * p, t = i_ >> 2;
                    const u32x4 yw = *(const LAS u32x4*)(GT + (par ^ 1) * 16384 + t * 64 + (((i_ & 3) ^ ((t >> 3) & 3)) << 4)); u32x2 y8;
                    y8.x = pk4_fp8(bflo(yw.x) * FP8_SY, bfhi(yw.x) * FP8_SY, bflo(yw.y) * FP8_SY, bfhi(yw.y) * FP8_SY); y8.y = pk4_fp8(bflo(yw.z) * FP8_SY, bfhi(yw.z) * FP8_SY, bflo(yw.w) * FP8_SY, bfhi(yw.w) * FP8_SY);
                    *(u32x2*)(Y8 + (R0 - 256 + t) * 1024 + 128 * hd + 32 * cg + 8 * (i_ & 3)) = y8; } }
            if (sb < 31) CH_LOAD(sb + 1);
            f32x4 ar[2][2], ai[2][2];
#pragma unroll
            for (int mm = 0; mm < 2; ++mm)
#pragma unroll
                for (int j = 0; j < 2; ++j) { ar[mm][j] = (f32x4){0.f, 0.f, 0.f, 0.f}; ai[mm][j] = (f32x4){0.f, 0.f, 0.f, 0.f}; }
            const int arow = 32 * wave + 8 * (fr >> 2) + (fr & 3);
#pragma unroll
            for (int ks = 0; ks < 4; ++ks) { bf16x8 Br_[2], Bi_[2];
#pragma unroll
                for (int j = 0; j < 2; ++j) { Br_[j] = *(const LAS bf16x8*)(WL + (16 * j + fr) * 256 + (((4 * ks + fq) ^ fr) << 4)); Bi_[j] = *(const LAS bf16x8*)(WL + (32 + 16 * j + fr) * 256 + (((4 * ks + fq) ^ fr) << 4)); }
#pragma unroll
                for (int mm = 0; mm < 2; ++mm) { const bf16x8 Af = *(const LAS bf16x8*)(AT + (arow + 4 * mm) * 256 + (((4 * ks + fq) ^ fr) << 4));
#pragma unroll
                    for (int j = 0; j < 2; ++j) { ar[mm][j] = __builtin_amdgcn_mfma_f32_16x16x32_bf16(Af, Br_[j], ar[mm][j], 0, 0, 0); ai[mm][j] = __builtin_amdgcn_mfma_f32_16x16x32_bf16(Af, Bi_[j], ai[mm][j], 0, 0, 0); } } }
            float av[2][8], bv[2][8], A2[2], B2[2], Ae[2], Be[2];
#pragma unroll
            for (int j = 0; j < 2; ++j) {
                const f32x2 ba2 = (f32x2){ba[j], ba[j]}, bx2 = (f32x2){bx[j], bx[j]}, kl2 = (f32x2){kl[j], kl[j]}, one2 = (f32x2){1.0f, 1.0f};
#pragma unroll
                for (int mm = 0; mm < 2; ++mm)
#pragma unroll
                    for (int ip = 0; ip < 2; ++ip) { const int i0 = 2 * ip, sidx = 4 * mm + i0, t = t0l + sidx;
                        f32x2 xr2;
                        xr2.x = bf1(*(const LAS unsigned short*)(AT + t * 256 + (((4 * cg + 2 * j + (fr >> 3)) ^ ((fq << 2) | i0)) << 4) + (fr & 7) * 2));
                        xr2.y = bf1(*(const LAS unsigned short*)(AT + (t + 1) * 256 + (((4 * cg + 2 * j + (fr >> 3)) ^ ((fq << 2) | (i0 + 1))) << 4) + (fr & 7) * 2));
                        const f32x2 zr = (f32x2){ar[mm][j][i0], ar[mm][j][i0 + 1]} + ba2, zi = (f32x2){ai[mm][j][i0], ai[mm][j][i0 + 1]} + bx2;
                        const f32x2 dr = (f32x2){__builtin_amdgcn_exp2f(zr.x), __builtin_amdgcn_exp2f(zr.y)} + one2, di = (f32x2){__builtin_amdgcn_exp2f(zi.x), __builtin_amdgcn_exp2f(zi.y)} + one2;
                        const f32x2 ka = (f32x2){__builtin_amdgcn_rcpf(dr.x), __builtin_amdgcn_rcpf(dr.y)} * kl2;
                        const f32x2 aa = (f32x2){__builtin_amdgcn_exp2f(ka.x), __builtin_amdgcn_exp2f(ka.y)};
                        f32x2 om = one2 - aa * aa; om.x = __builtin_fmaxf(om.x, 1e-30f); om.y = __builtin_fmaxf(om.y, 1e-30f);
                        const f32x2 q = om * di * di;
                        const f32x2 b2 = om * (f32x2){__builtin_amdgcn_rsqf(q.x), __builtin_amdgcn_rsqf(q.y)} * xr2;
                        av[j][sidx] = aa.x; av[j][sidx + 1] = aa.y; bv[j][sidx] = b2.x; bv[j][sidx + 1] = b2.y; }
                float As = 1.f, Bs = 0.f;
#pragma unroll
                for (int s2 = 0; s2 < 8; ++s2) { Bs = av[j][s2] * Bs + bv[j][s2]; As *= av[j][s2]; }
                float A1 = As, B1 = Bs;
                { const float Ap = __shfl_up(As, 16), Bp = __shfl_up(Bs, 16); if (fq >= 1) { A1 = Ap * As; B1 = As * Bp + Bs; } }
                A2[j] = A1; B2[j] = B1;
                { const float Ap = __shfl_up(A1, 32), Bp = __shfl_up(B1, 32); if (fq >= 2) { A2[j] = Ap * A1; B2[j] = A1 * Bp + B1; } }
                Ae[j] = __shfl_up(A2[j], 16); Be[j] = __shfl_up(B2[j], 16); if (fq == 0) { Ae[j] = 1.f; Be[j] = 0.f; }
                if (fq == 3) AGG[(par * 8 + wave) * 32 + 16 * j + fr] = (f32x2){A2[j], B2[j]};
            }
            __syncthreads();
#pragma unroll
            for (int j = 0; j < 2; ++j) {
                float hrun = Hc[j], hstart = Hc[j];
#pragma unroll
                for (int w2 = 0; w2 < 8; ++w2) { const f32x2 ab = AGG[(par * 8 + w2) * 32 + 16 * j + fr]; if (w2 == wave) hstart = hrun; hrun = ab.x * hrun + ab.y; }
                Hc[j] = hrun;
                float h = Ae[j] * hstart + Be[j];
                LAS unsigned short* gp = (LAS unsigned short*)(GT + par * 16384 + t0l * 64 + (((2 * j + (fr >> 3)) ^ fq) << 4) + (fr & 7) * 2);
#pragma unroll
                for (int s2 = 0; s2 < 8; ++s2) { h = av[j][s2] * h + bv[j][s2]; gp[s2 * 32] = (unsigned short)(cvt_pk_bf16(bf1(gp[s2 * 32]) * h, 0.f) & 0xffffu); }
            }
        }
        __syncthreads();
#pragma unroll
        for (int p = 0; p < 2; ++p) { const int i_ = tid + 512 * p, t = i_ >> 2;
            const u32x4 yw = *(const LAS u32x4*)(GT + 16384 + t * 64 + (((i_ & 3) ^ ((t >> 3) & 3)) << 4)); u32x2 y8;
            y8.x = pk4_fp8(bflo(yw.x) * FP8_SY, bfhi(yw.x) * FP8_SY, bflo(yw.y) * FP8_SY, bfhi(yw.y) * FP8_SY); y8.y = pk4_fp8(bflo(yw.z) * FP8_SY, bfhi(yw.z) * FP8_SY, bflo(yw.w) * FP8_SY, bfhi(yw.w) * FP8_SY);
            *(u32x2*)(Y8 + (Rbase + 31 * 256 + t) * 1024 + 128 * hd + 32 * cg + 8 * (i_ & 3)) = y8; }
#undef CH_LOAD
    }
}

__device__ __forceinline__ int fp8_layout_selftest(int lane) {
    const int r16 = lane & 15, g = lane >> 4; int found = 0;
#pragma unroll 1
    for (int hyp = 1; hyp <= 3; ++hyp) {
        v8i A, B;
#pragma unroll
        for (int r = 0; r < 8; ++r) { unsigned wa = 0, wb = 0; float fa[4], fb[4];
#pragma unroll
            for (int b = 0; b < 4; ++b) { int k;
                if (hyp == 1) k = 32 * g + 4 * r + b; else if (hyp == 2) k = 16 * g + 4 * (r & 3) + b + 64 * (r >> 2); else k = 8 * g + 4 * (r & 1) + b + 32 * (r >> 1);
                fa[b] = (float)(((k * 5 + r16 * 3) % 7) % 3);
                fb[b] = (float)((k * 3 + r16 * 7 + (k >> 4)) % 5); }
            wa = __builtin_amdgcn_cvt_pk_fp8_f32(fa[0], fa[1], wa, false); wa = __builtin_amdgcn_cvt_pk_fp8_f32(fa[2], fa[3], wa, true);
            wb = __builtin_amdgcn_cvt_pk_fp8_f32(fb[0], fb[1], wb, false); wb = __builtin_amdgcn_cvt_pk_fp8_f32(fb[2], fb[3], wb, true);
            A[r] = (int)wa; B[r] = (int)wb; }
        f32x4 acc = {0.f, 0.f, 0.f, 0.f};
        acc = __builtin_amdgcn_mfma_scale_f32_16x16x128_f8f6f4(A, B, acc, 0, 0, 0, 127, 0, 127);
        bool ok = true;
#pragma unroll 1
        for (int q = 0; q < 4; ++q) { const int i = 4 * g + q, j = r16; int ref = 0;
            for (int k = 0; k < 128; ++k) ref += (((k * 5 + i * 3) % 7) % 3) * ((k * 3 + j * 7 + (k >> 4)) % 5);
            ok = ok && (acc[q] == (float)ref); }
        if (__all(ok) && !found) found = hyp;
    }
    return found;
}

__global__ void __launch_bounds__(512, 2) fwd(Args args) {
    extern __shared__ __attribute__((aligned(16))) unsigned char lds_raw[];
    LAS unsigned char* lds = (LAS unsigned char*)lds_raw;
    volatile LAS unsigned* MISC = (volatile LAS unsigned*)(lds + MISC_OFF);
    const int tid = threadIdx.x, wave = __builtin_amdgcn_readfirstlane(tid >> 6), G = gridDim.x;
    const int vcu = (G % 8 == 0) ? (int)(blockIdx.x % 8) * (G / 8) + (int)(blockIdx.x / 8) : (int)blockIdx.x;
    unsigned char* ws = args.ws;
    if (tid < 64) MISC[tid] = 0u;
    __syncthreads();
    XcdBarrier bar = xcd_barrier_post((unsigned*)(ws + WS_CTL) + CW_BAR + args.li * XCD_BAR_WORDS, MISC + 8);
    const int lo = args.ph_lo, hi = args.ph_hi;
    int fp8_code = 0; if (PROBE_FP8 && blockIdx.x == 0 && wave == 0) fp8_code = fp8_layout_selftest(lane_id_v());
    if (PROBE_PHASE >= 0 && tid == 0) { const unsigned long long t_ = wall_clock64(); MISC[16] = (unsigned)t_; MISC[17] = (unsigned)(t_ >> 32); }
#define IN(k) (ph_on(k) && lo <= (k) && (k) < hi)
#ifndef PROBE_NOSTORE
#define PROBE_NOSTORE 0
#endif
#define RUN(k, ...) do { if (IN(k)) { const int ST_ON = 1; const bool rep_second_ = false; (void)rep_second_; __VA_ARGS__ } if (IN(k) && ((REP_MASK >> (k)) & 1)) { const int ST_ON = PROBE_NOSTORE ? args.pad : 1; const bool rep_second_ = true; (void)rep_second_; __VA_ARGS__ } } while (0)
#ifndef PROBE_P11DUP
#define PROBE_P11DUP 0
#endif
#ifndef PROBE_P11DUP_MODE
#define PROBE_P11DUP_MODE 0
#endif
#ifndef PROBE_BAR2
#define PROBE_BAR2 0
#endif
#define SEAM(k) do { if (IN(k) && hi > (k) + 1) { xcd_barrier(bar); if (PROBE_BAR2) xcd_barrier(bar); } if (PROBE_PHASE >= 0 && tid == 0) { const unsigned long long t_ = wall_clock64(); MISC[16 + 2 * ((k) + 1)] = (unsigned)t_; MISC[17 + 2 * ((k) + 1)] = (unsigned)(t_ >> 32); } } while (0)
#define H ((bf16*)(args.ws + WS_H))
#define Z ((bf16*)(args.ws + WS_Z))
#define Yb ((bf16*)(args.ws + WS_Y))
#define XB ((bf16*)(args.ws + WS_XB))

#ifndef PROBE_P0PARTS
#define PROBE_P0PARTS 3
#endif
    RUN(0, p0_prologue(args, lds, G, wave, lane_id_v(), ST_ON == 1 && !((REP_MASK & 1) && rep_second_) ? 3 : PROBE_P0PARTS););
    SEAM(0);
    unsigned long long pc0 = 0, pw0 = 0, pc1 = 0, pw1 = 0;
    if (PROBE_CLOCK) { pc0 = clock64(); pw0 = wall_clock64(); }
    RUN(1,
        { pg8::DenseOrder S; S.init(M, 2048, G, (int)blockIdx.x, H, 512, ws + WS_WREST, 512, 8);
          pg8::EpiZ E{Z, 2048, 2, ST_ON, 4, 1024, 1.0f, (const float*)(ws + WS_SH), (int)((WS_SWR - WS_SH) / 4), 0}; pg8::gemm_phase<pg8::EpiZ, pg8::DenseOrder, false, 2>(lds, 512, 512, 512, 8, S, E); }
        { pg8::DenseOrder S; S.init(512, M, G, (int)blockIdx.x, ws + WS_WV, 512, H, 512, 8);
          pg8::EpiZ E{(bf16*)(ws + WS_VT), M, 1 << 30, ST_ON, 1 << 30, 0, 1.0f, (const float*)(ws + WS_SH), 0, (int)((WS_SWV - WS_SH) / 4)}; pg8::gemm_phase<pg8::EpiZ, pg8::DenseOrder, false, 2>(lds, 512, 512, 512, 8, S, E); }
    );
    SEAM(1);
    RUN(2, p2_spatial(args, lds, G, wave, lane_id_v()););
    SEAM(2);
    RUN(3, pg8::DenseOrder S; S.init(M, 1024, G, (int)blockIdx.x, Yb, 1024, ws + WS_WO, 1024, 16);
        pg8::EpiRes<true> E{args.in[0], XB, 1.0f}; pg8::gemm_phase<pg8::EpiRes<true>, pg8::DenseOrder, false>(lds, 1024, 1024, 1024, 16, S, E););
    SEAM(3);
#define MOE_LAYER(l, pb) do { \
        if (IN(pb)) route_phase(args, l, lds, G, wave, lane_id_v()); \
        SEAM(pb); \
        RUN((pb) + 1, \
            build_tables(lds, (unsigned*)(ws + WS_CTL) + CW_ECNT + (l) * 2048, NE); \
            pg8::GroupOrder<false> S; S.pref = (const LAS int*)(lds + TAB_OFF); S.ng = NE; S.G = G; S.c = vcu; S.lane = lane_id_v(); \
            S.A = (const char*)H; S.W = (const char*)(ws + WS_WGU) + (size_t)(l) * 32 * 1024 * 1024; S.lists = (const unsigned*)(ws + WS_ELT); \
            pg8::EpiG1 E{(unsigned char*)Z}; pg8::gemm_phase<pg8::EpiG1, pg8::GroupOrder<false>, true, 1>(lds, 512, 512, 512, 8, S, E); \
        ); \
        SEAM((pb) + 1); \
        if (IN((pb) + 2)) { \
            build_tables(lds, (unsigned*)(ws + WS_CTL) + CW_PCNT + (l) * 7168, NPAIR); \
            pg8::GroupOrder<true> S; S.pref = (const LAS int*)(lds + TAB_OFF); S.ng = NPAIR; S.G = G; S.c = vcu; S.lane = lane_id_v(); \
            S.A = (const char*)Z; S.W = (const char*)(ws + WS_WD) + (size_t)(l) * 32 * 1024 * 512; S.lists = (const unsigned*)(ws + WS_PLT); \
            pg8::EpiG2 E{XB}; pg8::gemm_phase<pg8::EpiG2, pg8::GroupOrder<true>, true, 1>(lds, 512, 256, 512, 4, S, E); \
        } \
        SEAM((pb) + 2); } while (0)
    MOE_LAYER(0, 4);
    RUN(7, norm_phase(XB, args.in[1] + 1024, ws + WS_H, (float*)(ws + WS_SH), G, wave, lane_id_v()););
    SEAM(7);
    RUN(8, pg8::DenseOrder S; S.init(M, 2048, G, (int)blockIdx.x, H, 512, ws + WS_WC, 512, 8);
        pg8::EpiZ E{Z, 2048, 4, ST_ON, 1 << 30, 0, 1.0f, (const float*)(ws + WS_SH), (int)((WS_SWC - WS_SH) / 4), 0}; pg8::gemm_phase<pg8::EpiZ, pg8::DenseOrder, false, 2>(lds, 512, 512, 512, 8, S, E););
    SEAM(8);
    RUN(9, conv_phase(args, G););
    SEAM(9);
    RUN(10, scan_chain_phase(args, lds, G, vcu, wave, lane_id_v()););
    SEAM(10);
    if (IN(11)) { pg8::DenseOrder S; S.init(M, 1024, G, (int)blockIdx.x, Yb, 512, ws + WS_WCO, 512, 8);
        pg8::EpiRes<false> E{XB, XB, 1.0f / (FP8_SW * FP8_SY)}; pg8::gemm_phase<pg8::EpiRes<false>, pg8::DenseOrder, false, 1>(lds, 512, 512, 512, 8, S, E); }
#if PROBE_P11DUP
    if (IN(11)) { pg8::DenseOrder S; S.init(M, 1024, G, (int)blockIdx.x, Yb, 512, ws + WS_WCO, 512, 8);
        pg8::EpiRes<false> E{XB, (bf16*)(ws + WS_H), 1.0f / (FP8_SW * FP8_SY), PROBE_P11DUP_MODE + args.pad}; pg8::gemm_phase<pg8::EpiRes<false>, pg8::DenseOrder, false, 1>(lds, 512, 512, 512, 8, S, E); }
#endif
    SEAM(11);
    MOE_LAYER(1, 12);
#undef MOE_LAYER
    if (IN(15)) final_norm_phase(XB, args.out, args.in[3], G, wave, lane_id_v());
    if (PROBE_PHASE >= 0 && blockIdx.x == 0 && tid == 0) {
        const unsigned long long te = wall_clock64(); if (PROBE_PHASE == 15) { MISC[16 + 32] = (unsigned)te; MISC[17 + 32] = (unsigned)(te >> 32); }
        const unsigned long long ta = ((unsigned long long)MISC[17 + 2 * PROBE_PHASE] << 32) | MISC[16 + 2 * PROBE_PHASE], tb = ((unsigned long long)MISC[17 + 2 * (PROBE_PHASE + 1)] << 32) | MISC[16 + 2 * (PROBE_PHASE + 1)];
        const unsigned long long t0 = wall_clock64(), ticks = 4ull * (tb - ta);
        while (wall_clock64() - t0 < ticks) __builtin_amdgcn_s_sleep(8);
    }
    if (PROBE_FP8 && blockIdx.x == 0 && wave == 0) {
        const unsigned long long t0 = wall_clock64(), ticks = fp8_code ? 40000ull * fp8_code : 200000ull;
        while (wall_clock64() - t0 < ticks) __builtin_amdgcn_s_sleep(8);
    }
    if (PROBE_CLOCK && blockIdx.x == 0 && wave == 0) {
        const unsigned long long dw = pw1 - pw0, dc = pc1 - pc0;
        const unsigned long long fmhz = dw ? (dc * 100ull) / dw : 0ull;
        const unsigned long long t0 = wall_clock64(), ticks = fmhz * 100ull;
        while (wall_clock64() - t0 < ticks) __builtin_amdgcn_s_sleep(8);
    }
#undef IN
#undef SEAM
#undef H
#undef Z
#undef Yb
#undef XB
}

extern "C" void kernel_launch(void* const* d_in, const int* in_sizes, int n_in, void* d_out, int out_size, void* d_ws, size_t ws_size, hipStream_t stream) {
    static int grid = 0;
    if (grid == 0) {
        if (n_in != 26 || in_sizes[0] != M * D || out_size != M * D || ws_size < WS_END) { fprintf(stderr, "kernel_launch: unexpected shapes (n_in %d, in0 %d, out %d, ws %zu < %zu); nothing launched\n", n_in, n_in > 0 ? in_sizes[0] : -1, out_size, ws_size, (size_t)WS_END); grid = -1; return; }
        int dev = 0, cus = 0, per_cu = 0;
        if (hipGetDevice(&dev) != hipSuccess || hipDeviceGetAttribute(&cus, hipDeviceAttributeMultiprocessorCount, dev) != hipSuccess) { grid = -1; return; }
        if (hipFuncSetAttribute((const void*)fwd, hipFuncAttributeMaxDynamicSharedMemorySize, LDS_BYTES) != hipSuccess) { fprintf(stderr, "kernel_launch: hipFuncSetAttribute failed\n"); grid = -1; return; }
        if (hipOccupancyMaxActiveBlocksPerMultiprocessor(&per_cu, (const void*)fwd, 512, LDS_BYTES) != hipSuccess || per_cu < 1) fprintf(stderr, "kernel_launch: occupancy query reports %d workgroups per CU\n", per_cu);
        (void)hipGetLastError();
        grid = cus;
    }
    if (grid < 0) return;
    if (hipMemsetAsync((char*)d_ws + WS_CTL, 0, CTL_ZERO_BYTES, stream) != hipSuccess) return;
    Args a{};
    for (int i = 0; i < 26; ++i) a.in[i] = (const float*)d_in[i];
    a.out = (float*)d_out; a.ws = (unsigned char*)d_ws; a.pad = 0;
#if MK_CUTS
    int li = 0;
    for (int k = 0; k < NPH; ++k) { if (!ph_on(k)) continue;
        a.ph_lo = k; a.ph_hi = k + 1; a.li = li++; hipLaunchKernelGGL(fwd, dim3(grid), dim3(512), LDS_BYTES, stream, a); }
#else
    a.ph_lo = 0; a.ph_hi = NPH; a.li = 0;
    hipLaunchKernelGGL(fwd, dim3(grid), dim3(512), LDS_BYTES, stream, a);
#endif
    const hipError_t le = hipPeekAtLastError();
    if (le != hipSuccess) fprintf(stderr, "kernel_launch: launch failed: %s\n", hipGetErrorName(le));
}
```

```cpp
#include <hip/hip_runtime.h>
#include <cstdio>
#include <cstdint>

#ifndef DBG_STOP
#define DBG_STOP 4
#endif
#ifndef REP_MASK
#define REP_MASK 0
#endif
#ifndef PROBE_PHASE
#define PROBE_PHASE -1
#endif
#ifndef PROBE_FP8
#define PROBE_FP8 0
#endif
#ifndef PROBE_CLOCK
#define PROBE_CLOCK 0
#endif
#ifndef MK_CUTS
#define MK_CUTS 0
#endif

#define LAS __attribute__((address_space(3)))
#define GAS __attribute__((address_space(1)))
typedef unsigned short bf16;
typedef short bf16x8 __attribute__((ext_vector_type(8)));
typedef float f32x4 __attribute__((ext_vector_type(4)));
typedef float f32x2 __attribute__((ext_vector_type(2)));
typedef unsigned u32x4 __attribute__((ext_vector_type(4)));
typedef unsigned u32x2 __attribute__((ext_vector_type(2)));

constexpr int D = 1024, NBATCH = 8, SEQ = 8192, M = NBATCH * SEQ;
constexpr int NE = 32, DE = 512, NPAIR = 112;
constexpr float EPS = 1e-6f;
constexpr int NPH = 16;
constexpr int HP = 1088;
#ifdef ONLY_PH
__host__ __device__ constexpr bool ph_on(int k) { return ((ONLY_PH >> k) & 1) != 0; }
#else
__host__ __device__ constexpr bool ph_on(int k) { return (k <= 3) || (k >= 4 && k <= 6 && DBG_STOP >= 2) || (k >= 7 && k <= 11 && DBG_STOP >= 3) || (k >= 12 && k <= 14 && DBG_STOP >= 4) || k == 15; }
#endif

constexpr size_t MiB = 1u << 20;
constexpr size_t WS_CTL = 0, CTL_ZERO_BYTES = 192 * 1024;
constexpr size_t WS_WSB = 1 * MiB;
constexpr size_t WS_WAX = 1 * MiB + 256 * 1024;
constexpr size_t WS_WRT = 2 * MiB;
constexpr size_t WS_SH = 3 * MiB;
constexpr size_t WS_SWC = 4 * MiB;
constexpr size_t WS_SWR = 4 * MiB + 64 * 1024;
constexpr size_t WS_SWV = 4 * MiB + 128 * 1024;
constexpr size_t WS_ELT = 8 * MiB;
constexpr size_t WS_ELG = 16 * MiB;
constexpr size_t WS_PLT = 24 * MiB;
constexpr size_t WS_WREST = 52 * MiB;
constexpr size_t WS_WV = 56 * MiB;
constexpr size_t WS_WO = 57 * MiB;
constexpr size_t WS_WC = 59 * MiB;
constexpr size_t WS_WCO = 63 * MiB;
constexpr size_t WS_WGU = 65 * MiB;
constexpr size_t WS_WD = 193 * MiB;
constexpr size_t WS_H = 257 * MiB;
constexpr size_t WS_Z = 393 * MiB;
constexpr size_t WS_VT = 649 * MiB;
constexpr size_t WS_Y = 713 * MiB;
constexpr size_t WS_XB = 841 * MiB;
constexpr size_t WS_END = 969 * MiB;
constexpr int CW_TMO = 0;
constexpr int CW_ECNT = 8192;
constexpr int CW_PCNT = 12288;
constexpr int CW_BAR = 32768;
constexpr int LDS_BYTES = 147456;
constexpr int TAB_OFF = 131072;
constexpr int MISC_OFF = LDS_BYTES - 256;

__device__ __forceinline__ float bflo(unsigned w) { return __uint_as_float(w << 16); }
__device__ __forceinline__ float bfhi(unsigned w) { return __uint_as_float(w & 0xffff0000u); }
__device__ __forceinline__ float bf1(unsigned short b) { return __uint_as_float(((unsigned)b) << 16); }
__device__ __forceinline__ unsigned cvt_pk_bf16(float lo, float hi) { unsigned r; asm volatile("v_cvt_pk_bf16_f32 %0, %1, %2" : "=v"(r) : "v"(lo), "v"(hi)); return r; }
__device__ __forceinline__ float wave_sum(float v) {
#pragma unroll
    for (int o = 1; o < 64; o <<= 1) v += __shfl_xor(v, o);
    return v;
}
__device__ __forceinline__ float sigmoidf_(float x) { return __builtin_amdgcn_rcpf(1.0f + __builtin_amdgcn_exp2f(-1.44269504f * x)); }
typedef float f32x2_g __attribute__((ext_vector_type(2)));
__device__ __forceinline__ f32x2_g gelu_tanh2(f32x2_g x) {
    const f32x2_g one2 = (f32x2_g){1.0f, 1.0f}, c2 = (f32x2_g){0.044715f, 0.044715f}, k2 = (f32x2_g){-2.3022082f, -2.3022082f};
    const f32x2_g ea = (x * (one2 + c2 * (x * x))) * k2, d = (f32x2_g){__builtin_amdgcn_exp2f(ea.x), __builtin_amdgcn_exp2f(ea.y)} + one2;
    return x * (f32x2_g){__builtin_amdgcn_rcpf(d.x), __builtin_amdgcn_rcpf(d.y)}; }
__device__ __forceinline__ float gelu_tanh(float x) { const float z = x * (1.0f + 0.044715f * x * x); return x * __builtin_amdgcn_rcpf(1.0f + __builtin_amdgcn_exp2f(-2.3022082f * z)); }
__device__ __forceinline__ unsigned pk4_fp8(float a, float b, float c, float d) {
    a = __builtin_fminf(__builtin_fmaxf(a, -448.f), 448.f); b = __builtin_fminf(__builtin_fmaxf(b, -448.f), 448.f); c = __builtin_fminf(__builtin_fmaxf(c, -448.f), 448.f); d = __builtin_fminf(__builtin_fmaxf(d, -448.f), 448.f);
    unsigned r = 0; r = __builtin_amdgcn_cvt_pk_fp8_f32(a, b, r, false); r = __builtin_amdgcn_cvt_pk_fp8_f32(c, d, r, true); return r; }
constexpr float FP8_SW = 32.0f, FP8_SH = 16.0f, FP8_SY = 8.0f;
constexpr float I8_ASTEP = 8.0f / 127.0f;
__device__ __forceinline__ unsigned pk4_i8(float a, float b, float c, float d) {
    const int ia = (int)__builtin_rintf(__builtin_fminf(__builtin_fmaxf(a, -127.f), 127.f)), ib = (int)__builtin_rintf(__builtin_fminf(__builtin_fmaxf(b, -127.f), 127.f));
    const int ic = (int)__builtin_rintf(__builtin_fminf(__builtin_fmaxf(c, -127.f), 127.f)), id = (int)__builtin_rintf(__builtin_fminf(__builtin_fmaxf(d, -127.f), 127.f));
    return ((unsigned)ia & 0xffu) | (((unsigned)ib & 0xffu) << 8) | (((unsigned)ic & 0xffu) << 16) | ((unsigned)id << 24); }
typedef int v8i __attribute__((ext_vector_type(8)));
typedef int i32x4 __attribute__((ext_vector_type(4)));
__device__ __forceinline__ int lane_id_v() { int r; asm volatile("v_mbcnt_lo_u32_b32 %0, -1, 0\n\tv_mbcnt_hi_u32_b32 %0, -1, %0" : "=v"(r)); return r; }
#define LDS_WAIT() asm volatile("s_waitcnt lgkmcnt(0)" ::: "memory")
#define VM_WAIT() asm volatile("s_waitcnt vmcnt(0)" ::: "memory")

namespace pg8 {
constexpr int BM = 256, BK = 64, HALF = 128, HTB = HALF * BK * 2, STAGE_BYTES = 8 * HTB, NXCD = 8, WGM = 8;
__host__ __device__ __forceinline__ int lds_byte(int r, int c) { const int st = (r >> 4) * 2 + (c >> 5), rr = r & 15, cc = c & 31, ob = rr * 64 + cc * 2; return st * 1024 + (ob ^ (((ob >> 9) & 1) << 5)); }
__host__ __device__ __forceinline__ void stage_rc(int b, int& R, int& C) { const int st = b / 1024, sb = b % 1024, swz = sb ^ (((sb >> 9) & 1) << 5); R = (st >> 1) * 16 + swz / 64; C = (st & 1) * 32 + (swz % 64) / 2; }
__host__ __device__ __forceinline__ int perm32(int rho) { const int n = rho >> 4, i = rho & 15; return 8 * (i >> 2) + 4 * n + (i & 3); }

struct Unit { int pm, pn; const char* A; const char* B0; const char* B1; const unsigned* list; int nvalid; };

template <class Epi, class Sched, bool GATHER, int PREC = 0>
__device__ __forceinline__ void gemm_phase(LAS unsigned char* lds, const int lda, const int ldb, const int K, const int nth, const Sched& S, const Epi& E, const unsigned stagger_ticks = 0u) {
    constexpr bool FP8 = PREC == 1, I8 = PREC == 2;
    const int tid = threadIdx.x, wid = __builtin_amdgcn_readfirstlane(tid >> 6), lane = tid & 63, wr = wid >> 2, wc = wid & 3, fr = lane & 15, fq = lane >> 4;
    const int nt = K / BK;
    int R0, C0; stage_rc(tid * 16, R0, C0);
    unsigned voffB[2]; { const int Rb = Epi::PERM ? ((R0 & ~31) + perm32(R0 & 31)) : R0; voffB[0] = (unsigned)(Rb * ldb + C0) * 2u; voffB[1] = voffB[0] + (unsigned)(64 * ldb * 2); }
    const size_t kstep = (size_t)(BK * 2);
    const size_t hstepB = (size_t)HALF * ldb * 2;
    const unsigned ldsw = (unsigned)wid * 1024u;
    const int aoff = lds_byte(wr * 64 + fr, fq * 8), boff = lds_byte(wc * 32 + fr, fq * 8);
    constexpr int P1OFF = 1024;
#define PG8_SA(b, h) (((b) * 2 + (h)) * HTB)
#define PG8_SB(b, h) ((4 + (b) * 2 + (h)) * HTB)
#define PG8_STAGE(bufoff, gbase, voff) do { _Pragma("unroll") for (int _i = 0; _i < 2; ++_i) \
        __builtin_amdgcn_global_load_lds((const unsigned*)((const char*)(gbase) + (voff)[_i]), (LAS unsigned*)(lds + (bufoff) + ldsw + _i * 8192), 16, 0, 0); } while (0)
#define PG8_LDA(dst, dst8, b, h) do { if constexpr (FP8) { _Pragma("unroll") for (int m = 0; m < 4; ++m) { const i32x4 lo_ = *(const LAS i32x4*)(lds + PG8_SA(b, h) + aoff + m * 2048), hi_ = *(const LAS i32x4*)(lds + PG8_SA(b, h) + aoff + P1OFF + m * 2048); dst8[m] = __builtin_shufflevector(lo_, hi_, 0, 1, 2, 3, 4, 5, 6, 7); } } \
        else { _Pragma("unroll") for (int m = 0; m < 4; ++m) _Pragma("unroll") for (int k = 0; k < 2; ++k) dst[m][k] = *(const LAS bf16x8*)(lds + PG8_SA(b, h) + aoff + m * 2048 + k * P1OFF); } } while (0)
#define PG8_LDB(dst, dst8, b, h) do { if constexpr (FP8) { _Pragma("unroll") for (int n = 0; n < 2; ++n) { const i32x4 lo_ = *(const LAS i32x4*)(lds + PG8_SB(b, h) + boff + n * 2048), hi_ = *(const LAS i32x4*)(lds + PG8_SB(b, h) + boff + P1OFF + n * 2048); dst8[n] = __builtin_shufflevector(lo_, hi_, 0, 1, 2, 3, 4, 5, 6, 7); } } \
        else { _Pragma("unroll") for (int n = 0; n < 2; ++n) _Pragma("unroll") for (int k = 0; k < 2; ++k) dst[n][k] = *(const LAS bf16x8*)(lds + PG8_SB(b, h) + boff + n * 2048 + k * P1OFF); } } while (0)
#define PG8_MMA(ai, bj, At, Bt, At8, Bt8) do { __builtin_amdgcn_s_setprio(1); _Pragma("unroll") for (int m = 0; m < 4; ++m) _Pragma("unroll") for (int n = 0; n < 2; ++n) { \
        if constexpr (FP8) asm volatile("v_mfma_scale_f32_16x16x128_f8f6f4 %0, %1, %2, %0, %3, %3 op_sel_hi:[0,0,0]" : "+v"(acc[ai][bj][m][n]) : "v"(Bt8[n]), "v"(At8[m]), "v"(sc127)); \
        else if constexpr (I8) { _Pragma("unroll") for (int k = 0; k < 2; ++k) acc[ai][bj][m][n] = __builtin_bit_cast(f32x4, __builtin_amdgcn_mfma_i32_16x16x64_i8(__builtin_bit_cast(i32x4, Bt[n][k]), __builtin_bit_cast(i32x4, At[m][k]), __builtin_bit_cast(i32x4, acc[ai][bj][m][n]), 0, 0, 0)); } \
        else { _Pragma("unroll") for (int k = 0; k < 2; ++k) acc[ai][bj][m][n] = __builtin_amdgcn_mfma_f32_16x16x32_bf16(Bt[n][k], At[m][k], acc[ai][bj][m][n], 0, 0, 0); } } \
        __builtin_amdgcn_s_setprio(0); } while (0)
#define PG8_WAIT_V(n) asm volatile("s_waitcnt vmcnt(" #n ")" ::: "memory")
#define PG8_WAIT_L(n) asm volatile("s_waitcnt lgkmcnt(" #n ")" ::: "memory")
#define PG8_BAR __builtin_amdgcn_s_barrier()
#define PG8_SCHED __builtin_amdgcn_sched_barrier(0)
    Unit cur, nxt; int ui = 0;
    if (!S.next(0, cur)) return;
    if (stagger_ticks) { const unsigned long long t0 = wall_clock64(); while (wall_clock64() - t0 < (unsigned long long)stagger_ticks) __builtin_amdgcn_s_sleep(4); }
    unsigned offc[2][2], nid[2][2];
#pragma unroll
    for (int h = 0; h < 2; ++h)
#pragma unroll
        for (int i = 0; i < 2; ++i) {
            const int r = R0 + 64 * i + HALF * h;
            if constexpr (GATHER) { const unsigned ent = r < cur.nvalid ? cur.list[r] : 0u; offc[h][i] = (ent & 0x7fffffffu) * (unsigned)(lda * 2) + (unsigned)(C0 * 2); }
            else offc[h][i] = (unsigned)(r * lda + C0) * 2u;
            nid[h][i] = 0u;
        }
    f32x4 acc[2][2][4][2];
#pragma unroll
    for (int a = 0; a < 2; ++a)
#pragma unroll
        for (int b = 0; b < 2; ++b)
#pragma unroll
            for (int m = 0; m < 4; ++m)
#pragma unroll
                for (int n = 0; n < 2; ++n) acc[a][b][m][n] = (f32x4){0.f, 0.f, 0.f, 0.f};
    bf16x8 At[4][2], B0[2][2], B1[2][2]; v8i At8[4], B08[2], B18[2]; const int sc127 = 127;
    const char* cA = cur.A; const char* cB0 = cur.B0; const char* cB1 = cur.B1;
    E.prefetch(cur.pm, cur.pn, cur.list, cur.nvalid, lds, 0, wid, lane);
    PG8_STAGE(PG8_SB(0, 0), cB0, voffB); PG8_STAGE(PG8_SB(0, 1), cB0 + hstepB, voffB); PG8_STAGE(PG8_SA(0, 0), cA, offc[0]); PG8_STAGE(PG8_SA(0, 1), cA, offc[1]);
    if (wr == 1) PG8_BAR;
    PG8_WAIT_V(2); PG8_BAR;
    PG8_STAGE(PG8_SB(1, 0), cB0 + kstep, voffB); PG8_STAGE(PG8_SA(1, 0), cA + kstep, offc[0]); PG8_STAGE(PG8_SB(1, 1), cB0 + hstepB + kstep, voffB);
    PG8_WAIT_V(6); PG8_BAR;
    for (;;) {
        const bool has_next = S.next(ui + 1, nxt);
        if constexpr (GATHER) {
            if (has_next) {
#pragma unroll
                for (int h = 0; h < 2; ++h)
#pragma unroll
                    for (int i = 0; i < 2; ++i) { const int r = R0 + 64 * i + HALF * h; nid[h][i] = r < nxt.nvalid ? nxt.list[r] : 0u; }
            }
        }
        const char* nA = has_next ? nxt.A : cA; const char* nB0 = has_next ? nxt.B0 : cB0;
        for (int t = 0; t < nt; t += 2) {
            const bool last = (t == nt - 2);
            const char* a1 = cA + (size_t)(t + 1) * kstep;
            const char* a2 = last ? nA : cA + (size_t)(t + 2) * kstep;
            const char* b2 = last ? nB0 : ((t + 2 < nth) ? cB0 + (size_t)(t + 2) * kstep : cB1 + (size_t)(t + 2 - nth) * kstep);
            const char* a3 = a2 + kstep; const char* b3 = b2 + kstep;
            unsigned o2[2][2];
#pragma unroll
            for (int h = 0; h < 2; ++h)
#pragma unroll
                for (int i = 0; i < 2; ++i) {
                    if constexpr (GATHER) o2[h][i] = (last && has_next) ? (nid[h][i] & 0x7fffffffu) * (unsigned)(lda * 2) + (unsigned)(C0 * 2) : offc[h][i];
                    else o2[h][i] = offc[h][i]; }
            PG8_LDB(B0, B08, 0, 0); PG8_LDB(B1, B18, 0, 1); PG8_SCHED; PG8_LDA(At, At8, 0, 0); PG8_STAGE(PG8_SA(1, 1), a1, offc[1]);
            PG8_WAIT_V(8); PG8_WAIT_L(0); PG8_BAR; PG8_MMA(0, 0, At, B0, At8, B08); PG8_MMA(0, 1, At, B1, At8, B18); PG8_BAR; PG8_SCHED;
            PG8_LDA(At, At8, 0, 1); PG8_STAGE(PG8_SB(0, 0), b2, voffB); PG8_STAGE(PG8_SB(0, 1), b2 + hstepB, voffB); PG8_STAGE(PG8_SA(0, 0), a2, o2[0]);
            PG8_WAIT_V(8); PG8_WAIT_L(0); PG8_BAR; PG8_MMA(1, 0, At, B0, At8, B08); PG8_MMA(1, 1, At, B1, At8, B18); PG8_BAR; PG8_SCHED;
            PG8_LDB(B0, B08, 1, 0); PG8_LDB(B1, B18, 1, 1); PG8_SCHED; PG8_LDA(At, At8, 1, 0); PG8_STAGE(PG8_SA(0, 1), a2, o2[1]);
            PG8_WAIT_V(8); PG8_WAIT_L(0); PG8_BAR; PG8_MMA(0, 0, At, B0, At8, B08); PG8_MMA(0, 1, At, B1, At8, B18); PG8_BAR; PG8_SCHED;
            PG8_LDA(At, At8, 1, 1); PG8_STAGE(PG8_SB(1, 0), b3, voffB); PG8_STAGE(PG8_SB(1, 1), b3 + hstepB, voffB); PG8_STAGE(PG8_SA(1, 0), a3, o2[0]);
            PG8_WAIT_V(8); PG8_WAIT_L(0); PG8_BAR; PG8_MMA(1, 0, At, B0, At8, B08); PG8_MMA(1, 1, At, B1, At8, B18); PG8_BAR; PG8_SCHED;
        }
        if (wr == 0) PG8_BAR;
        if constexpr (FP8) asm volatile("s_nop 15\n\ts_nop 15" ::: "memory");
        E(acc, cur, wr, wc, fr, fq, lds, ui & 1);
        if (!has_next) break;
        E.prefetch(nxt.pm, nxt.pn, nxt.list, nxt.nvalid, lds, (ui + 1) & 1, wid, lane);
#pragma unroll
        for (int a = 0; a < 2; ++a)
#pragma unroll
            for (int b = 0; b < 2; ++b)
#pragma unroll
                for (int m = 0; m < 4; ++m)
#pragma unroll
                    for (int n = 0; n < 2; ++n) acc[a][b][m][n] = (f32x4){0.f, 0.f, 0.f, 0.f};
        cur = nxt; cA = nA; cB0 = nB0; cB1 = nxt.B1; ++ui;
        if constexpr (GATHER) {
#pragma unroll
            for (int h = 0; h < 2; ++h)
#pragma unroll
                for (int i = 0; i < 2; ++i) offc[h][i] = (nid[h][i] & 0x7fffffffu) * (unsigned)(lda * 2) + (unsigned)(C0 * 2);
        }
        if (wr == 1) PG8_BAR;
    }
    PG8_WAIT_V(0);
    PG8_BAR;
#undef PG8_SA
#undef PG8_SB
#undef PG8_STAGE
#undef PG8_LDA
#undef PG8_LDB
#undef PG8_MMA
#undef PG8_WAIT_V
#undef PG8_WAIT_L
#undef PG8_BAR
#undef PG8_SCHED
}

struct DenseOrder {
    int nM, nN, nwg, G, c, same_tile = 0; const char* A; const char* B; size_t tA, tB, b1off;
    __device__ __forceinline__ void init(int Mr, int N, int G_, int c_, const void* A_, int lda, const void* B_, int ldb, int nth) {
        nM = Mr / BM; nN = N / BM; nwg = nM * nN; G = G_; c = c_; A = (const char*)A_; B = (const char*)B_; tA = (size_t)BM * lda * 2; tB = (size_t)BM * ldb * 2; b1off = (size_t)nth * BK * 2; }
    __device__ __forceinline__ bool next(int i, Unit& u) const {
        const long L = (long)i * G + c; if (L >= nwg) return false;
        int wgid = (int)L; { const int q = nwg / NXCD, r = nwg % NXCD, xcd = wgid % NXCD, off = wgid / NXCD; wgid = (xcd < r ? xcd * (q + 1) : r * (q + 1) + (xcd - r) * q) + off; }
        const int nig = WGM * nN, gid = wgid / nig, fm = gid * WGM, gsz = (nM - fm) < WGM ? (nM - fm) : WGM;
        u.pm = fm + ((wgid % nig) % gsz); u.pn = (wgid % nig) / gsz;
        u.A = A + (same_tile ? 0 : (size_t)u.pm * tA); u.B0 = B + (same_tile ? 0 : (size_t)u.pn * tB); u.B1 = u.B0 + b1off; u.list = nullptr; u.nvalid = BM; return true;
    }
};
__device__ __forceinline__ int find_group(const LAS int* pref, int n, int rt, int lane) {
    const int j0 = lane, j1 = lane + 64;
    const bool f0 = j0 < n && pref[j0] <= rt && rt < pref[j0 + 1];
    const bool f1 = j1 < n && pref[j1] <= rt && rt < pref[j1 + 1];
    const unsigned long long m0 = __ballot(f0), m1 = __ballot(f1);
    return m0 ? (int)__builtin_ctzll(m0) : 64 + (int)__builtin_ctzll(m1 | (1ull << 63));
}
template <bool PAIR> struct GroupOrder {
    static constexpr size_t WSTRIDE = PAIR ? (size_t)1024 * 512 : (size_t)1024 * 1024, TB = PAIR ? (size_t)256 * 512 : (size_t)256 * 1024;
    const LAS int* pref; int ng, G, c, lane;
    const char* A; const char* W; const unsigned* lists;
    __device__ __forceinline__ bool next(int i, Unit& u) const {
        const LAS int* cnt = pref + 130;
        const long L = (long)i * G + c; const int total = __builtin_amdgcn_readfirstlane(pref[ng]);
        if (L >= 4L * total) return false;
        const int rt = (int)(L >> 2); u.pn = (int)(L & 3);
        const int g = __builtin_amdgcn_readfirstlane(find_group(pref, ng, rt, lane));
        const int tr = rt - __builtin_amdgcn_readfirstlane(pref[g]); const int cg = __builtin_amdgcn_readfirstlane(cnt[g]);
        u.pm = tr; u.nvalid = (cg - tr * BM) < BM ? (cg - tr * BM) : BM;
        u.list = lists + (size_t)g * 65536 + (size_t)tr * BM;
        u.A = A;
        if (PAIR) { const int grp = g / 28; int pi = g % 28, lo = 0; while (pi >= 7 - lo) { pi -= 7 - lo; ++lo; } const int hi = lo + 1 + pi;
            u.B0 = W + (size_t)(grp * 8 + lo) * WSTRIDE + (size_t)u.pn * TB; u.B1 = W + (size_t)(grp * 8 + hi) * WSTRIDE + (size_t)u.pn * TB; }
        else { u.B0 = W + (size_t)g * WSTRIDE + (size_t)u.pn * TB; u.B1 = u.B0; }
        return true;
    }
};

struct EpiZ {
    static constexpr bool PERM = true;
    bf16* O; int ldc; int gelu_lt; int st_on; int cx_from; int cx_col0; float scale; const float* sbase; int coff; int roff;
    static constexpr int SCL_OFF = 133120;
    __device__ __forceinline__ void prefetch(int pm, int pn, const unsigned*, int, LAS unsigned char* lds, int par, int wid, int lane) const {
        const int off = wid < 4 ? roff + pm * BM + 64 * wid : coff + pn * BM + 64 * (wid - 4); const float* src = sbase + off + lane;
        __builtin_amdgcn_global_load_lds((const unsigned*)src, (LAS unsigned*)(lds + SCL_OFF + par * 2048 + wid * 256), 4, 0, 0);
    }
    __device__ __forceinline__ f32x4 val(const f32x4& a) const { return __builtin_convertvector(__builtin_bit_cast(i32x4, a), f32x4); }
    __device__ __forceinline__ void operator()(const f32x4 (&acc)[2][2][4][2], const Unit& u, int wr, int wc, int fr, int fq, LAS unsigned char* lds, int par) const {
        if (!st_on) return;
        const int row0 = u.pm * BM + wr * 64 + fr, wcol0 = u.pn * BM + wc * 32 + 8 * fq;
        f32x4 cs[2][2]; float rs[2][4];
#pragma unroll
        for (int bj = 0; bj < 2; ++bj)
#pragma unroll
            for (int h = 0; h < 2; ++h) cs[bj][h] = *(const LAS f32x4*)(lds + SCL_OFF + par * 2048 + 1024 + (wc * 32 + 8 * fq + bj * HALF + 4 * h) * 4) * scale;
#pragma unroll
        for (int ai = 0; ai < 2; ++ai)
#pragma unroll
            for (int m = 0; m < 4; ++m) rs[ai][m] = *(const LAS float*)(lds + SCL_OFF + par * 2048 + (wr * 64 + fr + ai * HALF + m * 16) * 4);
        asm volatile("" ::: "memory");
        if (u.pn >= cx_from) { const int col0 = cx_col0 + (u.pn - cx_from) * HALF + wc * 32 + 8 * fq;
#pragma unroll
            for (int ai = 0; ai < 2; ++ai)
#pragma unroll
                for (int m = 0; m < 4; ++m) { const float r2 = rs[ai][m] * rs[ai][m];
                    const f32x4 v0 = val(acc[ai][0][m][0]) * val(acc[ai][1][m][0]) * (cs[0][0] * cs[1][0]) * r2, v1 = val(acc[ai][0][m][1]) * val(acc[ai][1][m][1]) * (cs[0][1] * cs[1][1]) * r2;
                    u32x4 w; w.x = cvt_pk_bf16(v0[0], v0[1]); w.y = cvt_pk_bf16(v0[2], v0[3]); w.z = cvt_pk_bf16(v1[0], v1[1]); w.w = cvt_pk_bf16(v1[2], v1[3]);
                    *(u32x4*)(O + (size_t)(row0 + ai * HALF + m * 16) * ldc + col0) = w; }
            return; }
        const bool act = u.pn < gelu_lt;
#pragma unroll
        for (int ai = 0; ai < 2; ++ai)
#pragma unroll
            for (int m = 0; m < 4; ++m) { bf16* rowp = O + (size_t)(row0 + ai * HALF + m * 16) * ldc + wcol0;
#pragma unroll
                for (int bj = 0; bj < 2; ++bj) { f32x4 v0 = val(acc[ai][bj][m][0]) * cs[bj][0] * rs[ai][m], v1 = val(acc[ai][bj][m][1]) * cs[bj][1] * rs[ai][m];
                    if (act) {
#pragma unroll
                        for (int jp = 0; jp < 2; ++jp) { const f32x2_g a = gelu_tanh2((f32x2_g){v0[2 * jp], v0[2 * jp + 1]}), b = gelu_tanh2((f32x2_g){v1[2 * jp], v1[2 * jp + 1]});
                            v0[2 * jp] = a.x; v0[2 * jp + 1] = a.y; v1[2 * jp] = b.x; v1[2 * jp + 1] = b.y; } }
                    u32x4 w; w.x = cvt_pk_bf16(v0[0], v0[1]); w.y = cvt_pk_bf16(v0[2], v0[3]); w.z = cvt_pk_bf16(v1[0], v1[1]); w.w = cvt_pk_bf16(v1[2], v1[3]);
                    *(u32x4*)(rowp + bj * HALF) = w; } }
    }
};
template <bool BASE_F32> struct EpiRes {
    static constexpr bool PERM = true;
    __device__ __forceinline__ void prefetch(int, int, const unsigned*, int, LAS unsigned char*, int, int, int) const {}
    const void* __restrict__ base; bf16* __restrict__ out; float scale; int probe = 0;
    __device__ __forceinline__ void operator()(f32x4 (&acc)[2][2][4][2], const Unit& u, int wr, int wc, int fr, int fq, LAS unsigned char* lds, int par) const {
        const int row0 = u.pm * BM + wr * 64 + fr, col0 = u.pn * BM + wc * 32 + 8 * fq;
        if (BASE_F32) {
#pragma unroll
            for (int ai = 0; ai < 2; ++ai) { f32x4 b[4][2][2];
#pragma unroll
                for (int m = 0; m < 4; ++m)
#pragma unroll
                    for (int bj = 0; bj < 2; ++bj) { const float* bp = (const float*)base + (size_t)(row0 + ai * HALF + m * 16) * 1024 + col0 + bj * HALF; b[m][bj][0] = *(const f32x4*)bp; b[m][bj][1] = *(const f32x4*)(bp + 4); }
                asm volatile("" ::: "memory");
#pragma unroll
                for (int m = 0; m < 4; ++m)
#pragma unroll
                    for (int bj = 0; bj < 2; ++bj) { acc[ai][bj][m][0] += b[m][bj][0]; acc[ai][bj][m][1] += b[m][bj][1]; } }
        } else {
            u32x4 b[2][4][2];
#pragma unroll
            for (int ai = 0; ai < 2; ++ai)
#pragma unroll
                for (int m = 0; m < 4; ++m)
#pragma unroll
                    for (int bj = 0; bj < 2; ++bj) { b[ai][m][bj] = (u32x4){0u, 0u, 0u, 0u}; if (!(probe & 1)) b[ai][m][bj] = *(const u32x4*)((const bf16*)base + (size_t)(row0 + ai * HALF + m * 16) * 1024 + col0 + bj * HALF); }
            asm volatile("" ::: "memory");
#pragma unroll
            for (int ai = 0; ai < 2; ++ai)
#pragma unroll
                for (int m = 0; m < 4; ++m)
#pragma unroll
                    for (int bj = 0; bj < 2; ++bj) { const u32x4 w = b[ai][m][bj];
                        acc[ai][bj][m][0] = acc[ai][bj][m][0] * scale + (f32x4){bflo(w.x), bfhi(w.x), bflo(w.y), bfhi(w.y)}; acc[ai][bj][m][1] = acc[ai][bj][m][1] * scale + (f32x4){bflo(w.z), bfhi(w.z), bflo(w.w), bfhi(w.w)}; }
        }
        asm volatile("" ::: "memory");
#pragma unroll
        for (int ai = 0; ai < 2; ++ai)
#pragma unroll
            for (int m = 0; m < 4; ++m) { const size_t off = (size_t)(row0 + ai * HALF + m * 16) * 1024 + col0;
#pragma unroll
                for (int bj = 0; bj < 2; ++bj) { const f32x4 v0 = acc[ai][bj][m][0], v1 = acc[ai][bj][m][1];
                    u32x4 w; w.x = cvt_pk_bf16(v0[0], v0[1]); w.y = cvt_pk_bf16(v0[2], v0[3]); w.z = cvt_pk_bf16(v1[0], v1[1]); w.w = cvt_pk_bf16(v1[2], v1[3]);
                    if (!(probe & 2)) *(u32x4*)(out + off + bj * HALF) = w; } }
    }
};
struct EpiG1 {
    static constexpr bool PERM = true;
    static constexpr int SCL_OFF = 133120;
    __device__ __forceinline__ void prefetch(int, int, const unsigned* list, int nvalid, LAS unsigned char* lds, int par, int wid, int lane) const {
        const int rl = 64 * (wid & 3) + lane_id_v(), rc = rl < nvalid - 1 ? rl : nvalid - 1; const int off = wid < 4 ? 0 : (int)((WS_ELG - WS_ELT) / 4);
        __builtin_amdgcn_global_load_lds(list + off + rc, (LAS unsigned*)(lds + SCL_OFF + par * 2048 + wid * 256), 4, 0, 0);
    }
    unsigned char* HID;
    __device__ __forceinline__ void operator()(const f32x4 (&acc)[2][2][4][2], const Unit& u, int wr, int wc, int fr, int fq, LAS unsigned char* lds, int par) const {
        const int col0 = u.pn * HALF + wc * 32 + 8 * fq; const int nv1 = u.nvalid - 1;
        unsigned ent[2][4], gt[2][4];
#pragma unroll
        for (int ai = 0; ai < 2; ++ai)
#pragma unroll
            for (int m = 0; m < 4; ++m) { const int rl = ai * HALF + wr * 64 + m * 16 + fr; const LAS unsigned* sl = (const LAS unsigned*)(lds + SCL_OFF + par * 2048) + rl; ent[ai][m] = sl[0]; gt[ai][m] = sl[256]; }
        asm volatile("" ::: "memory");
#pragma unroll
        for (int ai = 0; ai < 2; ++ai)
#pragma unroll
            for (int m = 0; m < 4; ++m) { const int rl = ai * HALF + wr * 64 + m * 16 + fr; const unsigned tok = ent[ai][m] & 0x7fffffffu, half = ent[ai][m] >> 31; const float g_ = bflo(gt[ai][m]), rs_ = bfhi(gt[ai][m]) * (1.0f / FP8_SW);
                float o[8];
                const float ks_ = rs_ * -1.44269504f, us_ = rs_ * (g_ * FP8_SH); const f32x2 rs2 = (f32x2){rs_, rs_}, ks2 = (f32x2){ks_, ks_}, us2 = (f32x2){us_, us_}, one2 = (f32x2){1.0f, 1.0f};
#pragma unroll
                for (int n = 0; n < 2; ++n)
#pragma unroll
                    for (int jp = 0; jp < 2; ++jp) { const f32x2 ag = (f32x2){acc[ai][0][m][n][2 * jp], acc[ai][0][m][n][2 * jp + 1]}, au = (f32x2){acc[ai][1][m][n][2 * jp], acc[ai][1][m][n][2 * jp + 1]};
                        const f32x2 ea = ag * ks2, d = (f32x2){__builtin_amdgcn_exp2f(ea.x), __builtin_amdgcn_exp2f(ea.y)} + one2;
                        const f32x2 o2 = (ag * rs2) * (f32x2){__builtin_amdgcn_rcpf(d.x), __builtin_amdgcn_rcpf(d.y)} * (au * us2);
                        o[4 * n + 2 * jp] = o2.x; o[4 * n + 2 * jp + 1] = o2.y; }
                u32x2 w; w.x = pk4_fp8(o[0], o[1], o[2], o[3]); w.y = pk4_fp8(o[4], o[5], o[6], o[7]);
                if (rl <= nv1) *(u32x2*)(HID + (size_t)tok * 1024 + half * 512 + col0) = w; }
    }
};
struct EpiG2 {
    static constexpr bool PERM = true;
    static constexpr int SCL_OFF = 133120;
    __device__ __forceinline__ void prefetch(int, int, const unsigned* list, int nvalid, LAS unsigned char* lds, int par, int wid, int lane) const {
        if (wid < 4) { const int rl = 64 * wid + lane_id_v(), rc = rl < nvalid - 1 ? rl : nvalid - 1;
            __builtin_amdgcn_global_load_lds(list + rc, (LAS unsigned*)(lds + SCL_OFF + par * 2048 + wid * 256), 4, 0, 0); }
    }
    bf16* __restrict__ out;
    __device__ __forceinline__ void operator()(f32x4 (&acc)[2][2][4][2], const Unit& u, int wr, int wc, int fr, int fq, LAS unsigned char* lds, int par) const {
        const int col0 = u.pn * BM + wc * 32 + 8 * fq; const int nv1 = u.nvalid - 1;
        unsigned tokv[2][4];
#pragma unroll
        for (int ai = 0; ai < 2; ++ai)
#pragma unroll
            for (int m = 0; m < 4; ++m) { const int rl = ai * HALF + wr * 64 + m * 16 + fr; tokv[ai][m] = (((const LAS unsigned*)(lds + SCL_OFF + par * 2048))[rl] & 0x7fffffffu) * 2048u + (unsigned)(col0 * 2); }
        asm volatile("" ::: "memory");
        u32x4 b[2][4][2];
#pragma unroll
        for (int ai = 0; ai < 2; ++ai)
#pragma unroll
            for (int m = 0; m < 4; ++m)
#pragma unroll
                for (int bj = 0; bj < 2; ++bj) b[ai][m][bj] = *(const u32x4*)((const char*)out + tokv[ai][m] + bj * (HALF * 2));
        asm volatile("" ::: "memory");
#pragma unroll
        for (int ai = 0; ai < 2; ++ai)
#pragma unroll
            for (int m = 0; m < 4; ++m) { const int rl = ai * HALF + wr * 64 + m * 16 + fr; bf16* p = (bf16*)((char*)out + tokv[ai][m]);
#pragma unroll
                for (int bj = 0; bj < 2; ++bj) { const u32x4 bw = b[ai][m][bj];
                    const float sc = 1.0f / (FP8_SW * FP8_SH);
                    const f32x4 v0 = acc[ai][bj][m][0] * sc + (f32x4){bflo(bw.x), bfhi(bw.x), bflo(bw.y), bfhi(bw.y)}, v1 = acc[ai][bj][m][1] * sc + (f32x4){bflo(bw.z), bfhi(bw.z), bflo(bw.w), bfhi(bw.w)};
                    u32x4 w; w.x = cvt_pk_bf16(v0[0], v0[1]); w.y = cvt_pk_bf16(v0[2], v0[3]); w.z = cvt_pk_bf16(v1[0], v1[1]); w.w = cvt_pk_bf16(v1[2], v1[3]);
                    if (rl <= nv1) *(u32x4*)(p + bj * HALF) = w; } }
    }
};
}

#define XB_TMO      128
#define XB_XCNT(j)  (256  + 64 * (j))
#define XB_XSUB(j)  (1280 + 64 * (j))
#define XB_XGEN(j)  (2304 + 64 * (j))
#define XB_TOP      3328
#define XB_TOPGEN   3392
#define XCD_BAR_WORDS 3456
#define XB_SPIN_CAP (1u << 18)
__device__ __forceinline__ unsigned xb_ld(unsigned* p)              { return __hip_atomic_load(p, __ATOMIC_RELAXED, __HIP_MEMORY_SCOPE_AGENT); }
__device__ __forceinline__ unsigned xb_add(unsigned* p, unsigned v) { return __hip_atomic_fetch_add(p, v, __ATOMIC_RELAXED, __HIP_MEMORY_SCOPE_AGENT); }
__device__ __forceinline__ unsigned xb_xcc_id() { return (unsigned)__builtin_amdgcn_s_getreg((3 << 11) | 20) & 0xFu; }
#define XB_SPIN(cond, bar) do { unsigned _sp = 0; while (cond) { __builtin_amdgcn_s_sleep(1); \
    if ((++_sp & 255u) == 0u) { if (xb_ld(&(bar)[XB_TMO])) break; if (_sp > XB_SPIN_CAP) { atomicAdd(&(bar)[XB_TMO], 1u); break; } } } } while (0)
struct XcdBarrier { unsigned* bar; unsigned x; volatile LAS unsigned* st; };
__device__ __forceinline__ XcdBarrier xcd_barrier_post(unsigned* bar, volatile LAS unsigned* st) {
    XcdBarrier b; b.bar = bar; b.x = xb_xcc_id(); b.st = st;
    if (threadIdx.x == 0) (void)xb_add(&bar[XB_XCNT(b.x)], 1u);
    return b;
}
__device__ __forceinline__ void xcd_barrier_complete(unsigned* bar, unsigned x, unsigned& nloc, unsigned& nx) {
    const unsigned G = gridDim.x * gridDim.y * gridDim.z;
    unsigned sum, cnt, mine, sp = 0u;
    for (;;) {
        sum = 0u; cnt = 0u; mine = 0u;
#pragma unroll
        for (unsigned j = 0; j < 16; ++j) { const unsigned c = xb_ld(&bar[XB_XCNT(j)]); sum += c; cnt += (c > 0u) ? 1u : 0u; mine = (j == x) ? c : mine; }
        if (sum == G) break;
        __builtin_amdgcn_s_sleep(1);
        if ((++sp & 255u) == 0u) { if (xb_ld(&bar[XB_TMO])) break; if (sp > XB_SPIN_CAP) { atomicAdd(&bar[XB_TMO], 1u); break; } }
    }
    nloc = mine > 0u ? mine : 1u; nx = cnt > 0u ? cnt : 1u;
}
__device__ __forceinline__ void xcd_barrier(const XcdBarrier& b) {
    asm volatile("s_waitcnt vmcnt(0)" ::: "memory");
    __syncthreads();
    if (threadIdx.x == 0) {
        unsigned* bar = b.bar;
        __builtin_amdgcn_s_waitcnt(0);
        unsigned nloc = b.st[0], nx = b.st[1];
        if (nloc == 0u) { xcd_barrier_complete(bar, b.x, nloc, nx); b.st[0] = nloc; b.st[1] = nx; }
        const unsigned old = xb_add(&bar[XB_XSUB(b.x)], 1u);
        const unsigned gen = old / nloc;
        if (old + 1u == (gen + 1u) * nloc) {
            __builtin_amdgcn_fence(__ATOMIC_RELEASE, "agent");
            asm volatile("s_waitcnt vmcnt(0)" ::: "memory");
            const unsigned og = xb_add(&bar[XB_TOP], 1u);
            const unsigned tg = og / nx;
            if (og + 1u == (tg + 1u) * nx) xb_add(&bar[XB_TOPGEN], 1u);
            else XB_SPIN(xb_ld(&bar[XB_TOPGEN]) == tg, bar);
            __builtin_amdgcn_fence(__ATOMIC_ACQUIRE, "agent");
            xb_add(&bar[XB_XGEN(b.x)], 1u);
            asm volatile("s_waitcnt vmcnt(0)" ::: "memory");
        } else {
            XB_SPIN(xb_ld(&bar[XB_XGEN(b.x)]) == gen, bar);
            __builtin_amdgcn_fence(__ATOMIC_ACQUIRE, "agent");
            asm volatile("s_waitcnt vmcnt(0)" ::: "memory");
        }
    }
    __syncthreads();
}

struct TrItem { const float* W; unsigned char* WT; int ldw, k0, n0, ldt, rd0, fp8; float scale; };
__device__ __forceinline__ void tr_load(const TrItem& t, f32x4 (&wv)[8], int lane) {
#pragma unroll
    for (int i = 0; i < 8; ++i) wv[i] = *(const f32x4*)(t.W + (size_t)(t.k0 + 8 * i + (lane >> 3)) * t.ldw + t.n0 + 4 * (lane & 7));
}
__device__ __forceinline__ void tr_store(const TrItem& t, const f32x4 (&wv)[8], LAS float* scr, int lane) {
#pragma unroll
    for (int i = 0; i < 8; ++i) { LAS float* p = scr + (8 * i + (lane >> 3)) * 33 + 4 * (lane & 7); const f32x4 v = wv[i] * t.scale; p[0] = v.x; p[1] = v.y; p[2] = v.z; p[3] = v.w; }
    LDS_WAIT(); asm volatile("" ::: "memory");
    const int c = lane & 7;
#pragma unroll
    for (int j = 0; j < 4; ++j) { const int n = (lane >> 3) + 8 * j; const LAS float* s = scr + (8 * c) * 33 + n;
        if (t.fp8) { u32x2 o; o.x = pk4_fp8(s[0 * 33], s[1 * 33], s[2 * 33], s[3 * 33]); o.y = pk4_fp8(s[4 * 33], s[5 * 33], s[6 * 33], s[7 * 33]);
            *(u32x2*)(t.WT + (size_t)(t.rd0 + n) * t.ldt + t.k0 + 8 * c) = o; }
        else { u32x4 o; o.x = cvt_pk_bf16(s[0 * 33], s[1 * 33]); o.y = cvt_pk_bf16(s[2 * 33], s[3 * 33]); o.z = cvt_pk_bf16(s[4 * 33], s[5 * 33]); o.w = cvt_pk_bf16(s[6 * 33], s[7 * 33]);
            *(u32x4*)((bf16*)t.WT + (size_t)(t.rd0 + n) * t.ldt + t.k0 + 8 * c) = o; } }
    LDS_WAIT(); asm volatile("" ::: "memory");
}
__device__ __forceinline__ void tr8_load(const TrItem& t, f32x4 (&wv)[16], int lane) {
#pragma unroll
    for (int i = 0; i < 16; ++i) wv[i] = *(const f32x4*)(t.W + (size_t)(t.k0 + 8 * i + (lane >> 3)) * t.ldw + t.n0 + 4 * (lane & 7));
}
__device__ __forceinline__ void tr8_store(const TrItem& t, const f32x4 (&wv)[16], LAS float* scr, int lane) {
#pragma unroll
    for (int i = 0; i < 16; ++i) { LAS float* p = scr + (8 * i + (lane >> 3)) * 33 + 4 * (lane & 7); const f32x4 v = wv[i] * t.scale; p[0] = v.x; p[1] = v.y; p[2] = v.z; p[3] = v.w; }
    LDS_WAIT(); asm volatile("" ::: "memory");
    const int n = lane >> 1, kh = lane & 1; const LAS float* s = scr + (64 * kh) * 33 + n;
    unsigned char* dst = t.WT + (size_t)(t.rd0 + n) * t.ldt + t.k0 + 64 * kh;
#pragma unroll
    for (int q = 0; q < 4; ++q) { u32x4 o;
#pragma unroll
        for (int w = 0; w < 4; ++w) { const int k = 16 * q + 4 * w; o[w] = pk4_fp8(s[k * 33], s[(k + 1) * 33], s[(k + 2) * 33], s[(k + 3) * 33]); }
        *(u32x4*)(dst + 16 * q) = o; }
    LDS_WAIT(); asm volatile("" ::: "memory");
}
struct Tr8Desc { const float* W; unsigned char* WT; int ldw, k0, n0, ldt, mode; };
__device__ __forceinline__ void tr8_wg_load(const Tr8Desc& d, f32x4 (&wv)[16]) {
    const int tid = threadIdx.x;
#pragma unroll
    for (int i = 0; i < 16; ++i) { const int idx = tid + 512 * i; wv[i] = *(const f32x4*)(d.W + (size_t)(d.k0 + (idx >> 6)) * d.ldw + d.n0 + 4 * (idx & 63)); }
    asm volatile("" ::: "memory");
}
__device__ __forceinline__ void tr8_wg_finish(const Tr8Desc& d, const f32x4 (&wv)[16], float scale, LAS float* scr) {
    const int tid = threadIdx.x;
    __syncthreads();
#pragma unroll
    for (int i = 0; i < 16; ++i) { const int idx = tid + 512 * i; *(LAS f32x4*)(scr + (idx >> 6) * 260 + 4 * (idx & 63)) = wv[i] * scale; }
    __syncthreads();
    const int n = tid >> 1, kh = tid & 1, c = d.n0 + n; const int row = d.mode == 0 ? c : (c >> 7) * 256 + (d.mode - 1) * 128 + (c & 127);
    const LAS float* sp = scr + (64 * kh) * 260 + n; unsigned char* dst = d.WT + (size_t)row * d.ldt + d.k0 + 64 * kh;
#pragma unroll
    for (int q = 0; q < 4; ++q) { u32x4 o;
#pragma unroll
        for (int w = 0; w < 4; ++w) { const int k = 16 * q + 4 * w; o[w] = pk4_fp8(sp[k * 260], sp[(k + 1) * 260], sp[(k + 2) * 260], sp[(k + 3) * 260]); }
        *(u32x4*)(dst + 16 * q) = o; }
}
__device__ __forceinline__ void tr_i8_cols_wg(const float* W, int ldw, int n0, unsigned char* WT  , float* steps  , LAS float* scr) {
    const int tid = threadIdx.x; LAS float* red = scr + 1024 * 33;
    __syncthreads();
#pragma unroll 1
    for (int h = 0; h < 2; ++h) { f32x4 wv[8];
#pragma unroll
        for (int i = 0; i < 8; ++i) { const int idx = tid + 512 * (8 * h + i); wv[i] = *(const f32x4*)(W + (size_t)(idx >> 3) * ldw + n0 + 4 * (idx & 7)); }
#pragma unroll
        for (int i = 0; i < 8; ++i) { const int idx = tid + 512 * (8 * h + i); LAS float* p = scr + (idx >> 3) * 33 + 4 * (idx & 7); p[0] = wv[i].x; p[1] = wv[i].y; p[2] = wv[i].z; p[3] = wv[i].w; } }
    __syncthreads();
    const int n = tid & 31, part = tid >> 5; float mx = 0.f;
#pragma unroll 8
    for (int k = 0; k < 64; ++k) mx = __builtin_fmaxf(mx, __builtin_fabsf(scr[(64 * part + k) * 33 + n]));
    red[part * 32 + n] = mx;
    __syncthreads();
    if (tid < 32) { float m2 = 1e-30f;
#pragma unroll
        for (int p = 0; p < 16; ++p) m2 = __builtin_fmaxf(m2, red[p * 32 + tid]);
        steps[tid] = m2 * (1.0f / 127.0f); red[512 + tid] = 127.0f / m2; }
    __syncthreads();
    const float inv = red[512 + n]; const LAS float* sp = scr + (64 * part) * 33 + n; unsigned char* dst = WT + (size_t)n * 1024 + 64 * part;
#pragma unroll
    for (int q = 0; q < 4; ++q) { u32x4 o;
#pragma unroll
        for (int w = 0; w < 4; ++w) { const int k = 16 * q + 4 * w; o[w] = pk4_i8(sp[k * 33] * inv, sp[(k + 1) * 33] * inv, sp[(k + 2) * 33] * inv, sp[(k + 3) * 33] * inv); }
        *(u32x4*)(dst + 16 * q) = o; }
    __syncthreads();
}
__device__ __forceinline__ void norm_rows4(const float* x0, const float* g, unsigned char* h0, float* steps, int lane) {
    f32x4 v[4][4]; float s[4], mx[4];
#pragma unroll
    for (int r = 0; r < 4; ++r)
#pragma unroll
        for (int j = 0; j < 4; ++j) v[r][j] = ((const f32x4*)(x0 + (size_t)r * D) + lane)[64 * j];
#pragma unroll
    for (int r = 0; r < 4; ++r) { s[r] = 0.f; mx[r] = 0.f;
#pragma unroll
        for (int j = 0; j < 4; ++j) { s[r] += (v[r][j].x * v[r][j].x + v[r][j].y * v[r][j].y) + (v[r][j].z * v[r][j].z + v[r][j].w * v[r][j].w);
            const f32x4 gv = ((const f32x4*)g + lane)[64 * j]; v[r][j] = v[r][j] * gv;
            mx[r] = __builtin_fmaxf(mx[r], __builtin_fmaxf(__builtin_fmaxf(__builtin_fabsf(v[r][j].x), __builtin_fabsf(v[r][j].y)), __builtin_fmaxf(__builtin_fabsf(v[r][j].z), __builtin_fabsf(v[r][j].w)))); } }
#pragma unroll
    for (int o = 1; o < 64; o <<= 1) {
#pragma unroll
        for (int r = 0; r < 4; ++r) { s[r] += __shfl_xor(s[r], o); mx[r] = __builtin_fmaxf(mx[r], __shfl_xor(mx[r], o)); } }
#pragma unroll
    for (int r = 0; r < 4; ++r) { const float rs = 1.0f / sqrtf(s[r] * (1.0f / D) + EPS); const float m = __builtin_fmaxf(mx[r], 1e-30f), inv = 127.0f / m;
        if (lane == 0) steps[r] = m * rs * (1.0f / 127.0f);
        unsigned* o4 = (unsigned*)(h0 + (size_t)r * 1024) + lane;
#pragma unroll
        for (int j = 0; j < 4; ++j) o4[64 * j] = pk4_i8(v[r][j].x * inv, v[r][j].y * inv, v[r][j].z * inv, v[r][j].w * inv); }
}

struct Args { const float* in[26]; float* out; unsigned char* ws; int ph_lo, ph_hi, li, pad; };

__device__ __forceinline__ TrItem p0_item(const Args& a, unsigned char* ws, int it) {
    constexpr int I_OUT = 16 * 32, I_AX = 8 * 2 * 8;
    TrItem t; t.fp8 = 0; t.scale = 1.0f; int r = it;
    if (r < I_OUT) { t.W = a.in[9]; t.ldw = 1024; t.k0 = 64 * (r / 32); t.n0 = 32 * (r % 32); t.WT = ws + WS_WO; t.ldt = 1024; t.rd0 = t.n0; return t; } r -= I_OUT;
    if (r < I_AX) { const int h = r / 16, gate = (r / 8) & 1, kb = (r / 4) & 1, nb = r & 3;
        t.W = (gate ? a.in[15] : a.in[13]) + (size_t)h * 16384; t.ldw = 128; t.k0 = 64 * kb; t.n0 = 32 * nb; t.WT = ws + WS_WAX + (size_t)h * 256 * 128 * 2; t.ldt = 128; t.rd0 = gate * 128 + 32 * nb; t.scale = -1.44269504f; return t; } r -= I_AX;
    { const int l = r / 16, kb = r % 16; t.W = a.in[21] + (size_t)l * 1024 * 32; t.ldw = 32; t.k0 = 64 * kb; t.n0 = 0; t.WT = ws + WS_WRT + (size_t)l * 48 * 1024 * 2; t.ldt = 1024; t.rd0 = 0; }
    return t;
}
__device__ __forceinline__ TrItem p0_item8(const Args& a, unsigned char* ws, int it) {
    constexpr int I_CO = 8 * 32;
    TrItem t; t.fp8 = 1; t.scale = FP8_SW; int r = it;
    if (r < I_CO) { t.W = a.in[18]; t.ldw = 1024; t.k0 = 128 * (r / 32); t.n0 = 32 * (r % 32); t.WT = ws + WS_WCO; t.ldt = 1024; t.rd0 = t.n0; return t; } r -= I_CO;
    const int le = r / 384, q = r % 384;
    if (q < 256) { const int up = q / 128, qq = q % 128, kb = qq / 16, nb = qq % 16, n0 = 32 * nb;
        t.W = (up ? a.in[24] : a.in[23]) + (size_t)le * 1024 * 512; t.ldw = 512; t.k0 = 128 * kb; t.n0 = n0; t.WT = ws + WS_WGU + (size_t)le * 1024 * 1024; t.ldt = 1024; t.rd0 = (n0 / 128) * 256 + up * 128 + (n0 % 128); }
    else { const int qq = q - 256, kb = qq / 32, nb = qq % 32;
        t.W = a.in[25] + (size_t)le * 512 * 1024; t.ldw = 1024; t.k0 = 128 * kb; t.n0 = 32 * nb; t.WT = ws + WS_WD + (size_t)le * 1024 * 512; t.ldt = 512; t.rd0 = 32 * nb; }
    return t;
}
__device__ __forceinline__ Tr8Desc p0_slab8(const Args& a, unsigned char* ws, int it) {
    Tr8Desc d;
    if (it < 32) { d.W = a.in[18]; d.ldw = 1024; d.k0 = 128 * (it >> 2); d.n0 = 256 * (it & 3); d.WT = ws + WS_WCO; d.ldt = 1024; d.mode = 0; return d; }
    const int r = it - 32, le = r / 48, q = r % 48;
    if (q < 32) { const int up = q >> 4, kb = (q & 15) >> 1, nh = q & 1;
        d.W = (up ? a.in[24] : a.in[23]) + (size_t)le * 1024 * 512; d.ldw = 512; d.k0 = 128 * kb; d.n0 = 256 * nh; d.WT = ws + WS_WGU + (size_t)le * 1024 * 1024; d.ldt = 1024; d.mode = 1 + up; }
    else { const int qq = q - 32, kb = qq >> 2, nq = qq & 3;
        d.W = a.in[25] + (size_t)le * 512 * 1024; d.ldw = 1024; d.k0 = 128 * kb; d.n0 = 256 * nq; d.WT = ws + WS_WD + (size_t)le * 1024 * 512; d.ldt = 512; d.mode = 0; }
    return d;
}
__device__ __forceinline__ void p0_prologue(const Args& a, LAS unsigned char* lds, int G, int wave, int lane, const int parts = 3) {
    unsigned char* ws = a.ws;
    LAS float* scr = (LAS float*)(lds + wave * 16896);
    const int gw = blockIdx.x * 8 + wave, NGW = G * 8;
    constexpr int NITEMS = 16 * 32 + 8 * 2 * 8 + 2 * 16, NITEMS8 = 8 * 32 + 64 * 384;
    if (parts & 1) {
        for (int tl = blockIdx.x; tl < 64 + 80; tl += G) {
            if (tl < 64) { tr_i8_cols_wg(a.in[10], 2048, 32 * tl, ws + WS_WC + (size_t)(32 * tl) * 1024, (float*)(ws + WS_SWC) + 32 * tl, (LAS float*)lds); continue; }
            const int n0 = 32 * (tl - 64); int drow; unsigned char* WT; float* st;
            if (n0 < 512) { drow = n0; WT = ws + WS_WREST; st = (float*)(ws + WS_SWR); }
            else if (n0 < 1024) { drow = n0 - 512; WT = ws + WS_WV; st = (float*)(ws + WS_SWV); }
            else if (n0 < 1536) { drow = n0 - 512; WT = ws + WS_WREST; st = (float*)(ws + WS_SWR); }
            else { const int xb = n0 >= 2048, c = n0 - (xb ? 2048 : 1536); drow = 1024 + (c / 128) * 256 + xb * 128 + (c % 128); WT = ws + WS_WREST; st = (float*)(ws + WS_SWR); }
            tr_i8_cols_wg(a.in[4], 2560, n0, WT + (size_t)drow * 1024, st + drow, (LAS float*)lds);
        }
        {
            constexpr int NSLAB = 32 + 64 * 48;
            int it = blockIdx.x; Tr8Desc da, db; f32x4 wa[16], wb[16];
            bool ha = it < NSLAB; if (ha) { da = p0_slab8(a, ws, it); tr8_wg_load(da, wa); }
            while (ha) {
                const int itb = it + G; const bool hb = itb < NSLAB; if (hb) { db = p0_slab8(a, ws, itb); tr8_wg_load(db, wb); }
                tr8_wg_finish(da, wa, FP8_SW, (LAS float*)lds);
                if (!hb) break;
                it = itb + G; ha = it < NSLAB; if (ha) { da = p0_slab8(a, ws, it); tr8_wg_load(da, wa); }
                tr8_wg_finish(db, wb, FP8_SW, (LAS float*)lds);
            }
        }
        __syncthreads();
        for (int it = gw; it < NITEMS; it += NGW) { const TrItem t = p0_item(a, ws, it); f32x4 w0[8]; tr_load(t, w0, lane); tr_store(t, w0, scr, lane); }
    }
    const int gt = blockIdx.x * 512 + threadIdx.x, NGT = G * 512;
    for (int i = gt; i < 2 * 16 * 1024; i += NGT) {
        const int l = i / 16384, n = (i / 1024) & 15, k = i & 1023;
        const float v = n < 4 ? a.in[19][(size_t)l * 4096 + k * 4 + n] : 0.f;
        ((bf16*)(ws + WS_WRT))[(size_t)l * 48 * 1024 + (size_t)(32 + n) * 1024 + k] = (bf16)(cvt_pk_bf16(v, 0.f) & 0xffffu); }
    for (int i = gt; i < 4 * 128 * 128; i += NGT) {
        const int t = (i >> 7) & 127, s = i & 127; const float v = s <= t ? a.in[6][i] : 0.f;
        ((bf16*)(ws + WS_WSB))[i] = (bf16)(cvt_pk_bf16(v, 0.f) & 0xffffu); }
    if (parts & 2)
    for (int m = 4 * gw; m < M; m += 4 * NGW) norm_rows4(a.in[0] + (size_t)m * D, a.in[1], ws + WS_H + (size_t)m * 1024, (float*)(ws + WS_SH) + m, lane);
}
__device__ __forceinline__ void norm_phase(const bf16* xb, const float* g, unsigned char* H8i, float* steps, int G, int wave, int lane) {
    const int gw = blockIdx.x * 8 + wave, NGW = G * 8;
    constexpr int NR = 8;
    for (int m = NR * gw; m < M; m += NR * NGW) {
        u32x4 v[NR][2]; float s[NR], mx[NR];
#pragma unroll
        for (int r = 0; r < NR; ++r)
#pragma unroll
            for (int j = 0; j < 2; ++j) v[r][j] = ((const u32x4*)(xb + (size_t)(m + r) * D) + lane)[64 * j];
        f32x4 gg[2][2];
#pragma unroll
        for (int j = 0; j < 2; ++j) { gg[j][0] = *(const f32x4*)(g + 8 * lane + 512 * j); gg[j][1] = *(const f32x4*)(g + 8 * lane + 512 * j + 4); }
#pragma unroll
        for (int r = 0; r < NR; ++r) { s[r] = 0.f; mx[r] = 0.f;
#pragma unroll
            for (int j = 0; j < 2; ++j)
#pragma unroll
                for (int k = 0; k < 4; ++k) { const float lo = bflo(v[r][j][k]), hi = bfhi(v[r][j][k]); s[r] += lo * lo + hi * hi;
                    mx[r] = __builtin_fmaxf(mx[r], __builtin_fmaxf(__builtin_fabsf(lo * gg[j][k >> 1][2 * (k & 1)]), __builtin_fabsf(hi * gg[j][k >> 1][2 * (k & 1) + 1]))); } }
#pragma unroll
        for (int o = 1; o < 64; o <<= 1) {
#pragma unroll
            for (int r = 0; r < NR; ++r) { s[r] += __shfl_xor(s[r], o); mx[r] = __builtin_fmaxf(mx[r], __shfl_xor(mx[r], o)); } }
#pragma unroll
        for (int r = 0; r < NR; ++r) { const float rs = 1.0f / sqrtf(s[r] * (1.0f / D) + EPS); const float mm = __builtin_fmaxf(mx[r], 1e-30f), inv = 127.0f / mm;
            if (lane == 0) steps[m + r] = mm * rs * (1.0f / 127.0f);
            u32x2* hr = (u32x2*)(H8i + (size_t)(m + r) * 1024) + lane;
#pragma unroll
            for (int j = 0; j < 2; ++j) { const f32x4 g0 = gg[j][0] * inv, g1 = gg[j][1] * inv; u32x2 o;
                o.x = pk4_i8(bflo(v[r][j].x) * g0.x, bfhi(v[r][j].x) * g0.y, bflo(v[r][j].y) * g0.z, bfhi(v[r][j].y) * g0.w);
                o.y = pk4_i8(bflo(v[r][j].z) * g1.x, bfhi(v[r][j].z) * g1.y, bflo(v[r][j].w) * g1.z, bfhi(v[r][j].w) * g1.w); hr[64 * j] = o; } }
    }
}
__device__ __forceinline__ void final_norm_phase(const bf16* xb, float* out, const float* g, int G, int wave, int lane) {
    const int gw = blockIdx.x * 8 + wave, NGW = G * 8;
    constexpr int NR = 8;
    for (int m = NR * gw; m < M; m += NR * NGW) {
        u32x4 v[NR][2]; float s[NR];
#pragma unroll
        for (int r = 0; r < NR; ++r)
#pragma unroll
            for (int j = 0; j < 2; ++j) v[r][j] = ((const u32x4*)(xb + (size_t)(m + r) * D) + lane)[64 * j];
#pragma unroll
        for (int r = 0; r < NR; ++r) { s[r] = 0.f;
#pragma unroll
            for (int j = 0; j < 2; ++j)
#pragma unroll
                for (int k = 0; k < 4; ++k) { const float lo = bflo(v[r][j][k]), hi = bfhi(v[r][j][k]); s[r] += lo * lo + hi * hi; } }
#pragma unroll
        for (int o = 1; o < 64; o <<= 1) {
#pragma unroll
            for (int r = 0; r < NR; ++r) s[r] += __shfl_xor(s[r], o); }
#pragma unroll
        for (int r = 0; r < NR; ++r) { const float rs = 1.0f / sqrtf(s[r] * (1.0f / D) + EPS); float* orow = out + (size_t)(m + r) * D;
#pragma unroll
            for (int j = 0; j < 2; ++j) { const f32x4 g0 = *(const f32x4*)(g + 8 * lane + 512 * j) * rs, g1 = *(const f32x4*)(g + 8 * lane + 512 * j + 4) * rs;
                *(f32x4*)(orow + 8 * lane + 512 * j) = (f32x4){bflo(v[r][j].x) * g0.x, bfhi(v[r][j].x) * g0.y, bflo(v[r][j].y) * g0.z, bfhi(v[r][j].y) * g0.w};
                *(f32x4*)(orow + 8 * lane + 512 * j + 4) = (f32x4){bflo(v[r][j].z) * g1.x, bfhi(v[r][j].z) * g1.y, bflo(v[r][j].w) * g1.z, bfhi(v[r][j].w) * g1.w}; } }
    }
}

__device__ __forceinline__ void p2_spatial(const Args& a, LAS unsigned char* lds, int G, int wave, int lane) {
    const bf16* ZR = (const bf16*)(a.ws + WS_Z); const bf16* VT = (const bf16*)(a.ws + WS_VT); bf16* Y = (bf16*)(a.ws + WS_Y); const bf16* WSB = (const bf16*)(a.ws + WS_WSB);
    LAS unsigned char* T = lds;
    LAS float* MU = (LAS float*)(lds + 131072); LAS float* RS = MU + 128; LAS float* PART = (LAS float*)(lds + 131072 + 1024);
    const int tid = threadIdx.x, fr = lane & 15, fq = lane >> 4;
    bf16x8 Af[4][4];
    { const int hh = wave >> 1, rh = wave & 1;
#pragma unroll
        for (int ks = 0; ks < 4; ++ks)
#pragma unroll
            for (int m = 0; m < 4; ++m) Af[ks][m] = *(const bf16x8*)(WSB + (size_t)((hh * 128 + 64 * rh + 16 * m + fr) * 128 + 32 * ks + 8 * fq)); }
    for (int unit_ = blockIdx.x; unit_ < M / 128; unit_ += G) { const int unit = M / 128 - 1 - unit_;
        const size_t row0 = (size_t)unit * 128;
        u32x4 vt0[8];
#pragma unroll
        for (int p = 0; p < 8; ++p) vt0[p] = *(const u32x4*)(VT + (size_t)(p * 32 + (tid >> 4)) * M + row0 + (tid & 15) * 8);
        asm volatile("" ::: "memory");
        {
            const int cg = tid & 63, rg = tid >> 6, c0 = 8 * cg; const size_t R = row0 + 16 * rg;
            float w0[8], w1[8], w2[8], p2v[8], p1v[8];
#pragma unroll
            for (int j = 0; j < 8; ++j) { w0[j] = a.in[8][c0 + j]; w1[j] = a.in[8][512 + c0 + j]; w2[j] = a.in[8][1024 + c0 + j]; p2v[j] = 0.f; p1v[j] = 0.f; }
            if ((R & (SEQ - 1)) != 0) {
                const u32x4 c2 = *(const u32x4*)(ZR + (R - 2) * 2048 + 1024 + c0), c1 = *(const u32x4*)(ZR + (R - 1) * 2048 + 1024 + c0);
#pragma unroll
                for (int j = 0; j < 4; ++j) { p2v[2 * j] = bflo(c2[j]); p2v[2 * j + 1] = bfhi(c2[j]); p1v[2 * j] = bflo(c1[j]); p1v[2 * j + 1] = bfhi(c1[j]); }
            }
#pragma unroll 8
            for (int r = 0; r < 16; ++r) { const bf16* zr = ZR + (R + r) * 2048 + c0;
                const u32x4 gb = *(const u32x4*)(zr + 512), cxw = *(const u32x4*)(zr + 1024);
                float cx[8], y[8];
#pragma unroll
                for (int j = 0; j < 4; ++j) { cx[2 * j] = bflo(cxw[j]); cx[2 * j + 1] = bfhi(cxw[j]); }
#pragma unroll
                for (int j = 0; j < 8; ++j) { const float gbj = (j & 1) ? bfhi(gb[j >> 1]) : bflo(gb[j >> 1]); y[j] = gbj * (w0[j] * p2v[j] + w1[j] * p1v[j] + w2[j] * cx[j]); p2v[j] = p1v[j]; p1v[j] = cx[j]; }
                u32x4 o; o.x = cvt_pk_bf16(y[0], y[1]); o.y = cvt_pk_bf16(y[2], y[3]); o.z = cvt_pk_bf16(y[4], y[5]); o.w = cvt_pk_bf16(y[6], y[7]);
                *(u32x4*)(Y + (R + r) * 1024 + 512 + c0) = o; }
        }
        {   u32x4 vt[8];
#pragma unroll
            for (int p = 0; p < 8; ++p) vt[p] = *(const u32x4*)(VT + (size_t)((8 + p) * 32 + (tid >> 4)) * M + row0 + (tid & 15) * 8);
#pragma unroll
            for (int p = 0; p < 8; ++p) { const int row = p * 32 + (tid >> 4), ch = tid & 15; *(LAS u32x4*)(T + row * 256 + ((ch ^ (row & 15)) << 4)) = vt0[p]; }
#pragma unroll
            for (int p = 0; p < 8; ++p) { const int row = (8 + p) * 32 + (tid >> 4), ch = tid & 15; *(LAS u32x4*)(T + row * 256 + ((ch ^ (row & 15)) << 4)) = vt[p]; } }
        __syncthreads();
        const int sg = tid & 15, dg = tid >> 4;
        {   float s[8], q[8];
#pragma unroll
            for (int j = 0; j < 8; ++j) { s[j] = 0.f; q[j] = 0.f; }
#pragma unroll 4
            for (int rr = 0; rr < 16; ++rr) { const u32x4 v = *(const LAS u32x4*)(T + (16 * dg + rr) * 256 + ((sg ^ rr) << 4));
#pragma unroll
                for (int j = 0; j < 4; ++j) { const float lo = bflo(v[j]), hi = bfhi(v[j]); s[2 * j] += lo; q[2 * j] += lo * lo; s[2 * j + 1] += hi; q[2 * j + 1] += hi * hi; } }
#pragma unroll
            for (int j = 0; j < 8; ++j) { s[j] += __shfl_xor(s[j], 16); s[j] += __shfl_xor(s[j], 32); q[j] += __shfl_xor(q[j], 16); q[j] += __shfl_xor(q[j], 32); }
            if (lane < 16) {
#pragma unroll
                for (int j = 0; j < 8; ++j) { PART[(wave * 128 + 8 * sg + j) * 2] = s[j]; PART[(wave * 128 + 8 * sg + j) * 2 + 1] = q[j]; } }
        }
        __syncthreads();
        if (tid < 128) { float s = 0.f, q = 0.f;
#pragma unroll
            for (int w = 0; w < 8; ++w) { s += PART[(w * 128 + tid) * 2]; q += PART[(w * 128 + tid) * 2 + 1]; }
            const float mean = s * (1.0f / 512.0f); float var = q * (1.0f / 512.0f) - mean * mean; var = var > 0.f ? var : 0.f;
            MU[tid] = mean; RS[tid] = 1.0f / sqrtf(var + EPS); }
        __syncthreads();
        {   float mu8[8], rs8[8];
#pragma unroll
            for (int j = 0; j < 8; ++j) { mu8[j] = MU[8 * sg + j]; rs8[j] = RS[8 * sg + j]; }
#pragma unroll 4
            for (int rr = 0; rr < 16; ++rr) { const int row = 16 * dg + rr; const float gd = a.in[5][row]; LAS u32x4* pp = (LAS u32x4*)(T + row * 256 + ((sg ^ rr) << 4)); const u32x4 v = *pp; u32x4 o;
#pragma unroll
                for (int j = 0; j < 4; ++j) o[j] = cvt_pk_bf16((bflo(v[j]) - mu8[2 * j]) * rs8[2 * j] * gd, (bfhi(v[j]) - mu8[2 * j + 1]) * rs8[2 * j + 1] * gd);
                *pp = o; }
        }
        __syncthreads();
        {   const int hh = wave >> 1, rh = wave & 1;
#pragma unroll 1
            for (int nh = 0; nh < 2; ++nh) {
                f32x4 acc[4][4];
#pragma unroll
                for (int m = 0; m < 4; ++m)
#pragma unroll
                    for (int n = 0; n < 4; ++n) acc[m][n] = (f32x4){0.f, 0.f, 0.f, 0.f};
#pragma unroll
                for (int ks = 0; ks < 4; ++ks) {
#pragma unroll
                    for (int n = 0; n < 4; ++n) { const bf16x8 Bf = *(const LAS bf16x8*)(T + (hh * 128 + 64 * nh + 16 * n + fr) * 256 + (((4 * ks + fq) ^ fr) << 4));
#pragma unroll
                        for (int m = 0; m < 4; ++m) acc[m][n] = __builtin_amdgcn_mfma_f32_16x16x32_bf16(Bf, Af[ks][m], acc[m][n], 0, 0, 0); } }
#pragma unroll
                for (int m = 0; m < 4; ++m) { const int t = 64 * rh + 16 * m + fr; const size_t R = row0 + t; const float bias = a.in[7][hh * 128 + t];
#pragma unroll
                    for (int n = 0; n < 4; ++n) { const int d = hh * 128 + 64 * nh + 16 * n + 4 * fq; const u32x2 u4 = *(const u32x2*)(ZR + R * 2048 + d);
                        u32x2 o; o.x = cvt_pk_bf16(bflo(u4.x) * (acc[m][n][0] + bias), bfhi(u4.x) * (acc[m][n][1] + bias)); o.y = cvt_pk_bf16(bflo(u4.y) * (acc[m][n][2] + bias), bfhi(u4.y) * (acc[m][n][3] + bias));
                        *(u32x2*)(Y + R * 1024 + d) = o; } }
            }
        }
        __syncthreads();
    }
}

__device__ __forceinline__ void route_phase(const Args& a, int l, LAS unsigned char* lds, int G, int wave, int lane) {
    const bf16* X = (const bf16*)(a.ws + WS_XB); unsigned char* H8 = a.ws + WS_H;
    const bf16* WRT = (const bf16*)(a.ws + WS_WRT) + (size_t)l * 48 * 1024; const float* gvec = a.in[2] + l * 1024;
    const float* brg = a.in[20] + l * 4; const float* bre = a.in[22] + l * 32;
    unsigned* ECNT = (unsigned*)(a.ws + WS_CTL) + CW_ECNT + l * 2048; unsigned* PCNT = (unsigned*)(a.ws + WS_CTL) + CW_PCNT + l * 7168;
    unsigned* ELT = (unsigned*)(a.ws + WS_ELT); unsigned* ELG = (unsigned*)(a.ws + WS_ELG); unsigned* PLT = (unsigned*)(a.ws + WS_PLT);
    constexpr int WROW = 2064;
    LAS unsigned char* WL = lds; LAS float* GL = (LAS float*)(lds + 99072); LAS float* SCR = (LAS float*)(lds + 103168) + wave * 768;
    LAS int* TOK = (LAS int*)(lds + 127744);
    LAS int* HIST = (LAS int*)(lds + 135936);
    const int tid = threadIdx.x, fr = lane & 15, fq = lane >> 4;
    for (int tile = blockIdx.x; tile < M / 256; tile += G) {
        __syncthreads();
        for (int i = tid; i < 48 * 128; i += 512) { const int row = i >> 7, ch = i & 127; *(LAS u32x4*)(WL + row * WROW + ch * 16) = *(const u32x4*)(WRT + (size_t)row * 1024 + ch * 8); }
        if (tid < 256) *(LAS f32x4*)(GL + 4 * tid) = *(const f32x4*)(gvec + 4 * tid);
        if (tid < 288) HIST[tid] = 0;
        __syncthreads();
        for (int mt = 2 * wave; mt < 2 * wave + 2; ++mt) {
            const size_t row = (size_t)tile * 256 + 16 * mt + fr; const bf16* xr = X + row * D; unsigned char* hr = H8 + row * 1024;
            f32x4 acc[3]; acc[0] = acc[1] = acc[2] = (f32x4){0.f, 0.f, 0.f, 0.f}; float ss = 0.f;
#pragma unroll 1
            for (int kb = 0; kb < 4; ++kb) {
                u32x4 xv[8];
#pragma unroll
                for (int j = 0; j < 8; ++j) xv[j] = *(const u32x4*)(xr + 32 * (8 * kb + (j & ~1)) + 16 * fq + 8 * (j & 1));
#pragma unroll
                for (int pp = 0; pp < 4; ++pp) { u32x4 h16;
#pragma unroll
                    for (int jj = 0; jj < 2; ++jj) { const int j = 2 * pp + jj; const int k0 = 32 * (8 * kb + 2 * pp) + 16 * fq + 8 * jj; const u32x4 xw = xv[j];
                        const f32x4 x0 = (f32x4){bflo(xw.x), bfhi(xw.x), bflo(xw.y), bfhi(xw.y)}, x1 = (f32x4){bflo(xw.z), bfhi(xw.z), bflo(xw.w), bfhi(xw.w)};
                        const f32x4 g0 = *(const LAS f32x4*)(GL + k0), g1 = *(const LAS f32x4*)(GL + k0 + 4);
                        ss += (x0.x * x0.x + x0.y * x0.y) + (x0.z * x0.z + x0.w * x0.w) + (x1.x * x1.x + x1.y * x1.y) + (x1.z * x1.z + x1.w * x1.w);
                        const f32x4 y0 = x0 * g0, y1 = x1 * g1;
                        u32x4 hw; hw.x = cvt_pk_bf16(y0.x, y0.y); hw.y = cvt_pk_bf16(y0.z, y0.w); hw.z = cvt_pk_bf16(y1.x, y1.y); hw.w = cvt_pk_bf16(y1.z, y1.w);
                        const bf16x8 Af = __builtin_bit_cast(bf16x8, hw);
                        h16[2 * jj] = pk4_fp8(y0.x, y0.y, y0.z, y0.w); h16[2 * jj + 1] = pk4_fp8(y1.x, y1.y, y1.z, y1.w);
#pragma unroll
                        for (int n = 0; n < 3; ++n) { const bf16x8 Bf = *(const LAS bf16x8*)(WL + (16 * n + fr) * WROW + k0 * 2); acc[n] = __builtin_amdgcn_mfma_f32_16x16x32_bf16(Bf, Af, acc[n], 0, 0, 0); } }
                    *(u32x4*)(hr + 32 * (8 * kb + 2 * pp) + 16 * fq) = h16; } }
            ss += __shfl_xor(ss, 16); ss += __shfl_xor(ss, 32);
            const float rstd = 1.0f / sqrtf(ss * (1.0f / D) + EPS);
#pragma unroll
            for (int n = 0; n < 3; ++n)
#pragma unroll
                for (int j = 0; j < 4; ++j) SCR[fr * 48 + 16 * n + 4 * fq + j] = acc[n][j] * rstd;
            LDS_WAIT(); asm volatile("" ::: "memory");
            if (lane < 16) { const LAS float* lg = SCR + lane * 48;
                float gl[4]; int gi = 0; float gm;
#pragma unroll
                for (int j = 0; j < 4; ++j) gl[j] = lg[32 + j] + brg[j];
                gm = gl[0];
#pragma unroll
                for (int j = 1; j < 4; ++j) if (gl[j] > gm) { gm = gl[j]; gi = j; }
                float den = 0.f;
#pragma unroll
                for (int j = 0; j < 4; ++j) den += __expf(gl[j] - gm);
                const float gp = 1.0f / den;
                float el[8];
#pragma unroll
                for (int j = 0; j < 8; ++j) el[j] = lg[8 * gi + j] + bre[8 * gi + j];
                int i1 = 0; float v1 = el[0];
#pragma unroll
                for (int j = 1; j < 8; ++j) if (el[j] > v1) { v1 = el[j]; i1 = j; }
                int i2 = -1; float v2 = -3.0e38f;
#pragma unroll
                for (int j = 0; j < 8; ++j) if (j != i1 && el[j] > v2) { v2 = el[j]; i2 = j; }
                const float e21 = __expf(v2 - v1), p1 = 1.0f / (1.0f + e21), p2 = e21 * p1;
                const int e1 = 8 * gi + i1, e2 = 8 * gi + i2; const int lo = i1 < i2 ? i1 : i2, hi = i1 < i2 ? i2 : i1;
                const int p = gi * 28 + (lo * (15 - lo)) / 2 + (hi - lo - 1);
                LAS int* tk = TOK + (16 * mt + lane) * 8;
                tk[0] = e1; tk[1] = e2; tk[2] = (int)cvt_pk_bf16(gp * p1, rstd); tk[3] = (int)cvt_pk_bf16(gp * p2, rstd);
                tk[4] = __hip_atomic_fetch_add(HIST + e1, 1, __ATOMIC_RELAXED, __HIP_MEMORY_SCOPE_WORKGROUP); tk[5] = __hip_atomic_fetch_add(HIST + e2, 1, __ATOMIC_RELAXED, __HIP_MEMORY_SCOPE_WORKGROUP); tk[6] = __hip_atomic_fetch_add(HIST + 32 + p, 1, __ATOMIC_RELAXED, __HIP_MEMORY_SCOPE_WORKGROUP); tk[7] = p; }
            LDS_WAIT(); asm volatile("" ::: "memory");
        }
        __syncthreads();
        if (tid < 32) { const int c = HIST[tid]; HIST[144 + tid] = c ? (int)__hip_atomic_fetch_add(ECNT + 64 * tid, (unsigned)c, __ATOMIC_RELAXED, __HIP_MEMORY_SCOPE_AGENT) : 0; }
        else if (tid < 144) { const int j = tid - 32; const int c = HIST[32 + j]; HIST[176 + j] = c ? (int)__hip_atomic_fetch_add(PCNT + 64 * j, (unsigned)c, __ATOMIC_RELAXED, __HIP_MEMORY_SCOPE_AGENT) : 0; }
        __syncthreads();
        if (tid < 256) { const LAS int* tk = TOK + tid * 8; const unsigned tok = (unsigned)(tile * 256 + tid);
            const int e1 = tk[0], e2 = tk[1]; const unsigned h1 = e1 < e2 ? 0u : 1u;
            const size_t s1 = (size_t)e1 * 65536 + HIST[144 + e1] + tk[4], s2 = (size_t)e2 * 65536 + HIST[144 + e2] + tk[5];
            ELT[s1] = tok | (h1 << 31); ELG[s1] = (unsigned)tk[2]; ELT[s2] = tok | ((1u - h1) << 31); ELG[s2] = (unsigned)tk[3];
            PLT[(size_t)tk[7] * 65536 + HIST[176 + tk[7]] + tk[6]] = tok; }
    }
}
__device__ __forceinline__ void build_tables(LAS unsigned char* lds, unsigned* counters, int ng) {
    LAS int* pref = (LAS int*)(lds + TAB_OFF); LAS int* cnt = pref + 130;
    __syncthreads();
    if ((int)threadIdx.x < ng) cnt[threadIdx.x] = (int)__hip_atomic_load(counters + 64 * threadIdx.x, __ATOMIC_RELAXED, __HIP_MEMORY_SCOPE_AGENT);
    __syncthreads();
    if (threadIdx.x == 0) { int s = 0; for (int g = 0; g < ng; ++g) { pref[g] = s; s += (cnt[g] + 255) >> 8; } for (int g = ng; g < 130; ++g) pref[g] = s; }
    __syncthreads();
}

__device__ __forceinline__ void conv_phase(const Args& a, int G) {
    const bf16* ZC = (const bf16*)(a.ws + WS_Z); bf16* XRC = (bf16*)(a.ws + WS_H);
    const int tid = threadIdx.x, cc = tid & 127, rg = tid >> 7, c0 = 8 * cc;
    float cw[5][8];
#pragma unroll
    for (int j = 0; j < 8; ++j) { cw[4][j] = a.in[12][c0 + j];
#pragma unroll
        for (int k = 0; k < 4; ++k) cw[k][j] = a.in[11][k * 1024 + c0 + j]; }
    for (int tile_ = blockIdx.x; tile_ < M / 64; tile_ += G) { const int tile = M / 64 - 1 - tile_;
        const size_t R = (size_t)tile * 64 + 16 * rg; const int pos0 = (int)(R & (SEQ - 1));
        u32x4 v[19];
#pragma unroll
        for (int r = 0; r < 19; ++r) { v[r] = (u32x4){0u, 0u, 0u, 0u}; if (pos0 + r - 3 >= 0) v[r] = *(const u32x4*)(ZC + (R + r - 3) * 2048 + 1024 + c0); }
#pragma unroll
        for (int i = 0; i < 16; ++i) { float o[8];
#pragma unroll
            for (int j = 0; j < 8; ++j) o[j] = cw[4][j];
#pragma unroll
            for (int k = 0; k < 4; ++k) { const u32x4 x = v[i + k];
#pragma unroll
                for (int j = 0; j < 4; ++j) { o[2 * j] += cw[k][2 * j] * bflo(x[j]); o[2 * j + 1] += cw[k][2 * j + 1] * bfhi(x[j]); } }
            u32x4 w; w.x = cvt_pk_bf16(o[0], o[1]); w.y = cvt_pk_bf16(o[2], o[3]); w.z = cvt_pk_bf16(o[4], o[5]); w.w = cvt_pk_bf16(o[6], o[7]);
            *(u32x4*)(XRC + (R + i) * 1024 + c0) = w; }
    }
}
__device__ __forceinline__ void scan_chain_phase(const Args& a, LAS unsigned char* lds, int G, int vcu, int wave, int lane) {
    const bf16* ZC = (const bf16*)(a.ws + WS_Z); const bf16* XRC = (const bf16*)(a.ws + WS_H); unsigned char* Y8 = a.ws + WS_Y;
    const bf16* WAX = (const bf16*)(a.ws + WS_WAX);
    LAS unsigned char* AT = lds;
    LAS f32x2* AGG = (LAS f32x2*)(lds + 65536);
    LAS unsigned char* GT = lds + 86016;
    LAS unsigned char* WL = lds + 69632;
    const int tid = threadIdx.x, fr = lane & 15, fq = lane >> 4;
    const int cc = tid & 15, rq = tid >> 4;
    for (int chain = vcu; chain < 256; chain += G) {
        const int b = chain >> 5, hd = (chain >> 2) & 7, cg = chain & 3;
        const size_t Rbase = (size_t)b * SEQ;
        float ba[2], bx[2], kl[2]; int chj[2];
#pragma unroll
        for (int j = 0; j < 2; ++j) { chj[j] = 128 * hd + 32 * cg + 16 * j + fr; ba[j] = -1.44269504f * a.in[14][chj[j]]; bx[j] = -1.44269504f * a.in[16][chj[j]];
            kl[j] = -8.0f * 1.44269504f * log1pf(__expf(-a.in[17][chj[j]])); }
        __syncthreads();
        for (int i = tid; i < 64 * 16; i += 512) { const int row = i >> 4, ch16 = i & 15;
            *(LAS u32x4*)(WL + row * 256 + ((ch16 ^ (row & 15)) << 4)) = *(const u32x4*)(WAX + (size_t)((hd * 256 + (row >> 5) * 128 + 32 * cg + (row & 31)) * 128 + 8 * ch16)); }
        float Hc[2] = {0.f, 0.f};
        const int t0l = 32 * wave + 8 * fq;
        u32x4 pr[8], pq[2];
#define CH_LOAD(sbn) do { const size_t R0n = Rbase + 256 * (sbn); \
            _Pragma("unroll") for (int p = 0; p < 8; ++p) pr[p] = *(const u32x4*)(XRC + (R0n + p * 32 + rq) * 1024 + 128 * hd + 8 * cc); \
            _Pragma("unroll") for (int p = 0; p < 2; ++p) { const int i_ = tid + 512 * p; pq[p] = *(const u32x4*)(ZC + (R0n + (i_ >> 2)) * 2048 + 128 * hd + 32 * cg + 8 * (i_ & 3)); } } while (0)
        CH_LOAD(0);
#pragma unroll 1
        for (int sb = 0; sb < 32; ++sb) {
            const size_t R0 = Rbase + 256 * sb; const int par = sb & 1;
#pragma unroll
            for (int p = 0; p < 8; ++p) { const int t = p * 32 + rq; const int key = (((t >> 3) & 3) << 2) | (t & 3); *(LAS u32x4*)(AT + t * 256 + ((cc ^ key) << 4)) = pr[p]; }
#pragma unroll
            for (int p = 0; p < 2; ++p) { const int i_ = tid + 512 * p, t = i_ >> 2; *(LAS u32x4*)(GT + par * 16384 + t * 64 + (((i_ & 3) ^ ((t >> 3) & 3)) << 4)) = pq[p]; }
            __syncthreads();
            if (sb > 0) {
#pragma unroll
                for (int p = 0; p < 2; ++p) { const int i_ = tid + 512 * p, t = i_ >> 2;
                    const u32x4 yw = *(const LAS u32x4*)(GT + (par ^ 1) * 16384 + t * 64 + (((i_ & 3) ^ ((t >> 3) & 3)) << 4)); u32x2 y8;
                    y8.x = pk4_fp8(bflo(yw.x) * FP8_SY, bfhi(yw.x) * FP8_SY, bflo(yw.y) * FP8_SY, bfhi(yw.y) * FP8_SY); y8.y = pk4_fp8(bflo(yw.z) * FP8_SY, bfhi(yw.z) * FP8_SY, bflo(yw.w) * FP8_SY, bfhi(yw.w) * FP8_SY);
                    *(u32x2*)(Y8 + (R0 - 256 + t) * 1024 + 128 * hd + 32 * cg + 8 * (i_ & 3)) = y8; } }
            if (sb < 31) CH_LOAD(sb + 1);
            f32x4 ar[2][2], ai[2][2];
#pragma unroll
            for (int mm = 0; mm < 2; ++mm)
#pragma unroll
                for (int j = 0; j < 2; ++j) { ar[mm][j] = (f32x4){0.f, 0.f, 0.f, 0.f}; ai[mm][j] = (f32x4){0.f, 0.f, 0.f, 0.f}; }
            const int arow = 32 * wave + 8 * (fr >> 2) + (fr & 3);
#pragma unroll
            for (int ks = 0; ks < 4; ++ks) { bf16x8 Br_[2], Bi_[2];
#pragma unroll
                for (int j = 0; j < 2; ++j) { Br_[j] = *(const LAS bf16x8*)(WL + (16 * j + fr) * 256 + (((4 * ks + fq) ^ fr) << 4)); Bi_[j] = *(const LAS bf16x8*)(WL + (32 + 16 * j + fr) * 256 + (((4 * ks + fq) ^ fr) << 4)); }
#pragma unroll
                for (int mm = 0; mm < 2; ++mm) { const bf16x8 Af = *(const LAS bf16x8*)(AT + (arow + 4 * mm) * 256 + (((4 * ks + fq) ^ fr) << 4));
#pragma unroll
                    for (int j = 0; j < 2; ++j) { ar[mm][j] = __builtin_amdgcn_mfma_f32_16x16x32_bf16(Af, Br_[j], ar[mm][j], 0, 0, 0); ai[mm][j] = __builtin_amdgcn_mfma_f32_16x16x32_bf16(Af, Bi_[j], ai[mm][j], 0, 0, 0); } } }
            float av[2][8], bv[2][8], A2[2], B2[2], Ae[2], Be[2];
#pragma unroll
            for (int j = 0; j < 2; ++j) {
                const f32x2 ba2 = (f32x2){ba[j], ba[j]}, bx2 = (f32x2){bx[j], bx[j]}, kl2 = (f32x2){kl[j], kl[j]}, one2 = (f32x2){1.0f, 1.0f};
#pragma unroll
                for (int mm = 0; mm < 2; ++mm)
#pragma unroll
                    for (int ip = 0; ip < 2; ++ip) { const int i0 = 2 * ip, sidx = 4 * mm + i0, t = t0l + sidx;
                        f32x2 xr2;
                        xr2.x = bf1(*(const LAS unsigned short*)(AT + t * 256 + (((4 * cg + 2 * j + (fr >> 3)) ^ ((fq << 2) | i0)) << 4) + (fr & 7) * 2));
                        xr2.y = bf1(*(const LAS unsigned short*)(AT + (t + 1) * 256 + (((4 * cg + 2 * j + (fr >> 3)) ^ ((fq << 2) | (i0 + 1))) << 4) + (fr & 7) * 2));
                        const f32x2 zr = (f32x2){ar[mm][j][i0], ar[mm][j][i0 + 1]} + ba2, zi = (f32x2){ai[mm][j][i0], ai[mm][j][i0 + 1]} + bx2;
                        const f32x2 dr = (f32x2){__builtin_amdgcn_exp2f(zr.x), __builtin_amdgcn_exp2f(zr.y)} + one2, di = (f32x2){__builtin_amdgcn_exp2f(zi.x), __builtin_amdgcn_exp2f(zi.y)} + one2;
                        const f32x2 ka = (f32x2){__builtin_amdgcn_rcpf(dr.x), __builtin_amdgcn_rcpf(dr.y)} * kl2;
                        const f32x2 aa = (f32x2){__builtin_amdgcn_exp2f(ka.x), __builtin_amdgcn_exp2f(ka.y)};
                        f32x2 om = one2 - aa * aa; om.x = __builtin_fmaxf(om.x, 1e-30f); om.y = __builtin_fmaxf(om.y, 1e-30f);
                        const f32x2 q = om * di * di;
                        const f32x2 b2 = om * (f32x2){__builtin_amdgcn_rsqf(q.x), __builtin_amdgcn_rsqf(q.y)} * xr2;
                        av[j][sidx] = aa.x; av[j][sidx + 1] = aa.y; bv[j][sidx] = b2.x; bv[j][sidx + 1] = b2.y; }
                float As = 1.f, Bs = 0.f;
#pragma unroll
                for (int s2 = 0; s2 < 8; ++s2) { Bs = av[j][s2] * Bs + bv[j][s2]; As *= av[j][s2]; }
                float A1 = As, B1 = Bs;
                { const float Ap = __shfl_up(As, 16), Bp = __shfl_up(Bs, 16); if (fq >= 1) { A1 = Ap * As; B1 = As * Bp + Bs; } }
                A2[j] = A1; B2[j] = B1;
                { const float Ap = __shfl_up(A1, 32), Bp = __shfl_up(B1, 32); if (fq >= 2) { A2[j] = Ap * A1; B2[j] = A1 * Bp + B1; } }
                Ae[j] = __shfl_up(A2[j], 16); Be[j] = __shfl_up(B2[j], 16); if (fq == 0) { Ae[j] = 1.f; Be[j] = 0.f; }
                if (fq == 3) AGG[(par * 8 + wave) * 32 + 16 * j + fr] = (f32x2){A2[j], B2[j]};
            }
            __syncthreads();
#pragma unroll
            for (int j = 0; j < 2; ++j) {
                float hrun = Hc[j], hstart = Hc[j];
#pragma unroll
                for (int w2 = 0; w2 < 8; ++w2) { const f32x2 ab = AGG[(par * 8 + w2) * 32 + 16 * j + fr]; if (w2 == wave) hstart = hrun; hrun = ab.x * hrun + ab.y; }
                Hc[j] = hrun;
                float h = Ae[j] * hstart + Be[j];
                LAS unsigned short* gp = (LAS unsigned short*)(GT + par * 16384 + t0l * 64 + (((2 * j + (fr >> 3)) ^ fq) << 4) + (fr & 7) * 2);
#pragma unroll
                for (int s2 = 0; s2 < 8; ++s2) { h = av[j][s2] * h + bv[j][s2]; gp[s2 * 32] = (unsigned short)(cvt_pk_bf16(bf1(gp[s2 * 32]) * h, 0.f) & 0xffffu); }
            }
        }
        __syncthreads();
#pragma unroll
        for (int p = 0; p < 2; ++p) { const int i_ = tid + 512 * p, t = i_ >> 2;
            const u32x4 yw = *(const LAS u32x4*)(GT + 16384 + t * 64 + (((i_ & 3) ^ ((t >> 3) & 3)) << 4)); u32x2 y8;
            y8.x = pk4_fp8(bflo(yw.x) * FP8_SY, bfhi(yw.x) * FP8_SY, bflo(yw.y) * FP8_SY, bfhi(yw.y) * FP8_SY); y8.y = pk4_fp8(bflo(yw.z) * FP8_SY, bfhi(yw.z) * FP8_SY, bflo(yw.w) * FP8_SY, bfhi(yw.w) * FP8_SY);
            *(u32x2*)(Y8 + (Rbase + 31 * 256 + t) * 1024 + 128 * hd + 32 * cg + 8 * (i_ & 3)) = y8; }
#undef CH_LOAD
    }
}

__device__ __forceinline__ int fp8_layout_selftest(int lane) {
    const int r16 = lane & 15, g = lane >> 4; int found = 0;
#pragma unroll 1
    for (int hyp = 1; hyp <= 3; ++hyp) {
        v8i A, B;
#pragma unroll
        for (int r = 0; r < 8; ++r) { unsigned wa = 0, wb = 0; float fa[4], fb[4];
#pragma unroll
            for (int b = 0; b < 4; ++b) { int k;
                if (hyp == 1) k = 32 * g + 4 * r + b; else if (hyp == 2) k = 16 * g + 4 * (r & 3) + b + 64 * (r >> 2); else k = 8 * g + 4 * (r & 1) + b + 32 * (r >> 1);
                fa[b] = (float)(((k * 5 + r16 * 3) % 7) % 3);
                fb[b] = (float)((k * 3 + r16 * 7 + (k >> 4)) % 5); }
            wa = __builtin_amdgcn_cvt_pk_fp8_f32(fa[0], fa[1], wa, false); wa = __builtin_amdgcn_cvt_pk_fp8_f32(fa[2], fa[3], wa, true);
            wb = __builtin_amdgcn_cvt_pk_fp8_f32(fb[0], fb[1], wb, false); wb = __builtin_amdgcn_cvt_pk_fp8_f32(fb[2], fb[3], wb, true);
            A[r] = (int)wa; B[r] = (int)wb; }
        f32x4 acc = {0.f, 0.f, 0.f, 0.f};
        acc = __builtin_amdgcn_mfma_scale_f32_16x16x128_f8f6f4(A, B, acc, 0, 0, 0, 127, 0, 127);
        bool ok = true;
#pragma unroll 1
        for (int q = 0; q < 4; ++q) { const int i = 4 * g + q, j = r16; int ref = 0;
            for (int k = 0; k < 128; ++k) ref += (((k * 5 + i * 3) % 7) % 3) * ((k * 3 + j * 7 + (k >> 4)) % 5);
            ok = ok && (acc[q] == (float)ref); }
        if (__all(ok) && !found) found = hyp;
    }
    return found;
}

__global__ void __launch_bounds__(512, 2) fwd(Args args) {
    extern __shared__ __attribute__((aligned(16))) unsigned char lds_raw[];
    LAS unsigned char* lds = (LAS unsigned char*)lds_raw;
    volatile LAS unsigned* MISC = (volatile LAS unsigned*)(lds + MISC_OFF);
    const int tid = threadIdx.x, wave = __builtin_amdgcn_readfirstlane(tid >> 6), G = gridDim.x;
    const int vcu = (G % 8 == 0) ? (int)(blockIdx.x % 8) * (G / 8) + (int)(blockIdx.x / 8) : (int)blockIdx.x;
    unsigned char* ws = args.ws;
    if (tid < 64) MISC[tid] = 0u;
    __syncthreads();
    XcdBarrier bar = xcd_barrier_post((unsigned*)(ws + WS_CTL) + CW_BAR + args.li * XCD_BAR_WORDS, MISC + 8);
    const int lo = args.ph_lo, hi = args.ph_hi;
    int fp8_code = 0; if (PROBE_FP8 && blockIdx.x == 0 && wave == 0) fp8_code = fp8_layout_selftest(lane_id_v());
    if (PROBE_PHASE >= 0 && tid == 0) { const unsigned long long t_ = wall_clock64(); MISC[16] = (unsigned)t_; MISC[17] = (unsigned)(t_ >> 32); }
#define IN(k) (ph_on(k) && lo <= (k) && (k) < hi)
#ifndef PROBE_NOSTORE
#define PROBE_NOSTORE 0
#endif
#define RUN(k, ...) do { if (IN(k)) { const int ST_ON = 1; const bool rep_second_ = false; (void)rep_second_; __VA_ARGS__ } if (IN(k) && ((REP_MASK >> (k)) & 1)) { const int ST_ON = PROBE_NOSTORE ? args.pad : 1; const bool rep_second_ = true; (void)rep_second_; __VA_ARGS__ } } while (0)
#ifndef PROBE_P11DUP
#define PROBE_P11DUP 0
#endif
#ifndef PROBE_P11DUP_MODE
#define PROBE_P11DUP_MODE 0
#endif
#ifndef PROBE_BAR2
#define PROBE_BAR2 0
#endif
#define SEAM(k) do { if (IN(k) && hi > (k) + 1) { xcd_barrier(bar); if (PROBE_BAR2) xcd_barrier(bar); } if (PROBE_PHASE >= 0 && tid == 0) { const unsigned long long t_ = wall_clock64(); MISC[16 + 2 * ((k) + 1)] = (unsigned)t_; MISC[17 + 2 * ((k) + 1)] = (unsigned)(t_ >> 32); } } while (0)
#define H ((bf16*)(args.ws + WS_H))
#define Z ((bf16*)(args.ws + WS_Z))
#define Yb ((bf16*)(args.ws + WS_Y))
#define XB ((bf16*)(args.ws + WS_XB))

#ifndef PROBE_P0PARTS
#define PROBE_P0PARTS 3
#endif
    RUN(0, p0_prologue(args, lds, G, wave, lane_id_v(), ST_ON == 1 && !((REP_MASK & 1) && rep_second_) ? 3 : PROBE_P0PARTS););
    SEAM(0);
    unsigned long long pc0 = 0, pw0 = 0, pc1 = 0, pw1 = 0;
    if (PROBE_CLOCK) { pc0 = clock64(); pw0 = wall_clock64(); }
    RUN(1,
        { pg8::DenseOrder S; S.init(M, 2048, G, (int)blockIdx.x, H, 512, ws + WS_WREST, 512, 8);
          pg8::EpiZ E{Z, 2048, 2, ST_ON, 4, 1024, 1.0f, (const float*)(ws + WS_SH), (int)((WS_SWR - WS_SH) / 4), 0}; pg8::gemm_phase<pg8::EpiZ, pg8::DenseOrder, false, 2>(lds, 512, 512, 512, 8, S, E); }
        { pg8::DenseOrder S; S.init(512, M, G, (int)blockIdx.x, ws + WS_WV, 512, H, 512, 8);
          pg8::EpiZ E{(bf16*)(ws + WS_VT), M, 1 << 30, ST_ON, 1 << 30, 0, 1.0f, (const float*)(ws + WS_SH), 0, (int)((WS_SWV - WS_SH) / 4)}; pg8::gemm_phase<pg8::EpiZ, pg8::DenseOrder, false, 2>(lds, 512, 512, 512, 8, S, E); }
    );
    SEAM(1);
    RUN(2, p2_spatial(args, lds, G, wave, lane_id_v()););
    SEAM(2);
    RUN(3, pg8::DenseOrder S; S.init(M, 1024, G, (int)blockIdx.x, Yb, 1024, ws + WS_WO, 1024, 16);
        pg8::EpiRes<true> E{args.in[0], XB, 1.0f}; pg8::gemm_phase<pg8::EpiRes<true>, pg8::DenseOrder, false>(lds, 1024, 1024, 1024, 16, S, E););
    SEAM(3);
#define MOE_LAYER(l, pb) do { \
        if (IN(pb)) route_phase(args, l, lds, G, wave, lane_id_v()); \
        SEAM(pb); \
        RUN((pb) + 1, \
            build_tables(lds, (unsigned*)(ws + WS_CTL) + CW_ECNT + (l) * 2048, NE); \
            pg8::GroupOrder<false> S; S.pref = (const LAS int*)(lds + TAB_OFF); S.ng = NE; S.G = G; S.c = vcu; S.lane = lane_id_v(); \
            S.A = (const char*)H; S.W = (const char*)(ws + WS_WGU) + (size_t)(l) * 32 * 1024 * 1024; S.lists = (const unsigned*)(ws + WS_ELT); \
            pg8::EpiG1 E{(unsigned char*)Z}; pg8::gemm_phase<pg8::EpiG1, pg8::GroupOrder<false>, true, 1>(lds, 512, 512, 512, 8, S, E); \
        ); \
        SEAM((pb) + 1); \
        if (IN((pb) + 2)) { \
            build_tables(lds, (unsigned*)(ws + WS_CTL) + CW_PCNT + (l) * 7168, NPAIR); \
            pg8::GroupOrder<true> S; S.pref = (const LAS int*)(lds + TAB_OFF); S.ng = NPAIR; S.G = G; S.c = vcu; S.lane = lane_id_v(); \
            S.A = (const char*)Z; S.W = (const char*)(ws + WS_WD) + (size_t)(l) * 32 * 1024 * 512; S.lists = (const unsigned*)(ws + WS_PLT); \
            pg8::EpiG2 E{XB}; pg8::gemm_phase<pg8::EpiG2, pg8::GroupOrder<true>, true, 1>(lds, 512, 256, 512, 4, S, E); \
        } \
        SEAM((pb) + 2); } while (0)
    MOE_LAYER(0, 4);
    RUN(7, norm_phase(XB, args.in[1] + 1024, ws + WS_H, (float*)(ws + WS_SH), G, wave, lane_id_v()););
    SEAM(7);
    RUN(8, pg8::DenseOrder S; S.init(M, 2048, G, (int)blockIdx.x, H, 512, ws + WS_WC, 512, 8);
        pg8::EpiZ E{Z, 2048, 4, ST_ON, 1 << 30, 0, 1.0f, (const float*)(ws + WS_SH), (int)((WS_SWC - WS_SH) / 4), 0}; pg8::gemm_phase<pg8::EpiZ, pg8::DenseOrder, false, 2>(lds, 512, 512, 512, 8, S, E););
    SEAM(8);
    RUN(9, conv_phase(args, G););
    SEAM(9);
    RUN(10, scan_chain_phase(args, lds, G, vcu, wave, lane_id_v()););
    SEAM(10);
    if (IN(11)) { pg8::DenseOrder S; S.init(M, 1024, G, (int)blockIdx.x, Yb, 512, ws + WS_WCO, 512, 8);
        pg8::EpiRes<false> E{XB, XB, 1.0f / (FP8_SW * FP8_SY)}; pg8::gemm_phase<pg8::EpiRes<false>, pg8::DenseOrder, false, 1>(lds, 512, 512, 512, 8, S, E); }
#if PROBE_P11DUP
    if (IN(11)) { pg8::DenseOrder S; S.init(M, 1024, G, (int)blockIdx.x, Yb, 512, ws + WS_WCO, 512, 8);
        pg8::EpiRes<false> E{XB, (bf16*)(ws + WS_H), 1.0f / (FP8_SW * FP8_SY), PROBE_P11DUP_MODE + args.pad}; pg8::gemm_phase<pg8::EpiRes<false>, pg8::DenseOrder, false, 1>(lds, 512, 512, 512, 8, S, E); }
#endif
    SEAM(11);
    MOE_LAYER(1, 12);
#undef MOE_LAYER
    if (IN(15)) final_norm_phase(XB, args.out, args.in[3], G, wave, lane_id_v());
    if (PROBE_PHASE >= 0 && blockIdx.x == 0 && tid == 0) {
        const unsigned long long te = wall_clock64(); if (PROBE_PHASE == 15) { MISC[16 + 32] = (unsigned)te; MISC[17 + 32] = (unsigned)(te >> 32); }
        const unsigned long long ta = ((unsigned long long)MISC[17 + 2 * PROBE_PHASE] << 32) | MISC[16 + 2 * PROBE_PHASE], tb = ((unsigned long long)MISC[17 + 2 * (PROBE_PHASE + 1)] << 32) | MISC[16 + 2 * (PROBE_PHASE + 1)];
        const unsigned long long t0 = wall_clock64(), ticks = 4ull * (tb - ta);
        while (wall_clock64() - t0 < ticks) __builtin_amdgcn_s_sleep(8);
    }
    if (PROBE_FP8 && blockIdx.x == 0 && wave == 0) {
        const unsigned long long t0 = wall_clock64(), ticks = fp8_code ? 40000ull * fp8_code : 200000ull;
        while (wall_clock64() - t0 < ticks) __builtin_amdgcn_s_sleep(8);
    }
    if (PROBE_CLOCK && blockIdx.x == 0 && wave == 0) {
        const unsigned long long dw = pw1 - pw0, dc = pc1 - pc0;
        const unsigned long long fmhz = dw ? (dc * 100ull) / dw : 0ull;
        const unsigned long long t0 = wall_clock64(), ticks = fmhz * 100ull;
        while (wall_clock64() - t0 < ticks) __builtin_amdgcn_s_sleep(8);
    }
#undef IN
#undef SEAM
#undef H
#undef Z
#undef Yb
#undef XB
}

extern "C" void kernel_launch(void* const* d_in, const int* in_sizes, int n_in, void* d_out, int out_size, void* d_ws, size_t ws_size, hipStream_t stream) {
    static int grid = 0;
    if (grid == 0) {
        if (n_in != 26 || in_sizes[0] != M * D || out_size != M * D || ws_size < WS_END) { fprintf(stderr, "kernel_launch: unexpected shapes (n_in %d, in0 %d, out %d, ws %zu < %zu); nothing launched\n", n_in, n_in > 0 ? in_sizes[0] : -1, out_size, ws_size, (size_t)WS_END); grid = -1; return; }
        int dev = 0, cus = 0, per_cu = 0;
        if (hipGetDevice(&dev) != hipSuccess || hipDeviceGetAttribute(&cus, hipDeviceAttributeMultiprocessorCount, dev) != hipSuccess) { grid = -1; return; }
        if (hipFuncSetAttribute((const void*)fwd, hipFuncAttributeMaxDynamicSharedMemorySize, LDS_BYTES) != hipSuccess) { fprintf(stderr, "kernel_launch: hipFuncSetAttribute failed\n"); grid = -1; return; }
        if (hipOccupancyMaxActiveBlocksPerMultiprocessor(&per_cu, (const void*)fwd, 512, LDS_BYTES) != hipSuccess || per_cu < 1) fprintf(stderr, "kernel_launch: occupancy query reports %d workgroups per CU\n", per_cu);
        (void)hipGetLastError();
        grid = cus;
    }
    if (grid < 0) return;
    if (hipMemsetAsync((char*)d_ws + WS_CTL, 0, CTL_ZERO_BYTES, stream) != hipSuccess) return;
    Args a{};
    for (int i = 0; i < 26; ++i) a.in[i] = (const float*)d_in[i];
    a.out = (float*)d_out; a.ws = (unsigned char*)d_ws; a.pad = 0;
#if MK_CUTS
    int li = 0;
    for (int k = 0; k < NPH; ++k) { if (!ph_on(k)) continue;
        a.ph_lo = k; a.ph_hi = k + 1; a.li = li++; hipLaunchKernelGGL(fwd, dim3(grid), dim3(512), LDS_BYTES, stream, a); }
#else
    a.ph_lo = 0; a.ph_hi = NPH; a.li = 0;
    hipLaunchKernelGGL(fwd, dim3(grid), dim3(512), LDS_BYTES, stream, a);
#endif
    const hipError_t le = hipPeekAtLastError();
    if (le != hipSuccess) fprintf(stderr, "kernel_launch: launch failed: %s\n", hipGetErrorName(le));
}
```

```cpp
#include <hip/hip_runtime.h>
#include <cstdio>
#include <cstdint>

#ifndef DBG_STOP
#define DBG_STOP 4
#endif
#ifndef REP_MASK
#define REP_MASK 0
#endif
#ifndef PROBE_PHASE
#define PROBE_PHASE -1
#endif
#ifndef PROBE_FP8
#define PROBE_FP8 0
#endif
#ifndef PROBE_CLOCK
#define PROBE_CLOCK 0
#endif
#ifndef MK_CUTS
#define MK_CUTS 0
#endif

#define LAS __attribute__((address_space(3)))
#define GAS __attribute__((address_space(1)))
typedef unsigned short bf16;
typedef short bf16x8 __attribute__((ext_vector_type(8)));
typedef float f32x4 __attribute__((ext_vector_type(4)));
typedef float f32x2 __attribute__((ext_vector_type(2)));
typedef unsigned u32x4 __attribute__((ext_vector_type(4)));
typedef unsigned u32x2 __attribute__((ext_vector_type(2)));

constexpr int D = 1024, NBATCH = 8, SEQ = 8192, M = NBATCH * SEQ;
constexpr int NE = 32, DE = 512, NPAIR = 112;
constexpr float EPS = 1e-6f;
constexpr int NPH = 16;
constexpr int HP = 1088;
#ifdef ONLY_PH
__host__ __device__ constexpr bool ph_on(int k) { return ((ONLY_PH >> k) & 1) != 0; }
#else
__host__ __device__ constexpr bool ph_on(int k) { return (k <= 3) || (k >= 4 && k <= 6 && DBG_STOP >= 2) || (k >= 7 && k <= 11 && DBG_STOP >= 3) || (k >= 12 && k <= 14 && DBG_STOP >= 4) || k == 15; }
#endif

constexpr size_t MiB = 1u << 20;
constexpr size_t WS_CTL = 0, CTL_ZERO_BYTES = 192 * 1024;
constexpr size_t WS_WSB = 1 * MiB;
constexpr size_t WS_WAX = 1 * MiB + 256 * 1024;
constexpr size_t WS_WRT = 2 * MiB;
constexpr size_t WS_SH = 3 * MiB;
constexpr size_t WS_SWC = 4 * MiB;
constexpr size_t WS_SWR = 4 * MiB + 64 * 1024;
constexpr size_t WS_SWV = 4 * MiB + 128 * 1024;
constexpr size_t WS_ELT = 8 * MiB;
constexpr size_t WS_ELG = 16 * MiB;
constexpr size_t WS_PLT = 24 * MiB;
constexpr size_t WS_WREST = 52 * MiB;
constexpr size_t WS_WV = 56 * MiB;
constexpr size_t WS_WO = 57 * MiB;
constexpr size_t WS_WC = 59 * MiB;
constexpr size_t WS_WCO = 63 * MiB;
constexpr size_t WS_WGU = 65 * MiB;
constexpr size_t WS_WD = 193 * MiB;
constexpr size_t WS_H = 257 * MiB;
constexpr size_t WS_Z = 393 * MiB;
constexpr size_t WS_VT = 649 * MiB;
constexpr size_t WS_Y = 713 * MiB;
constexpr size_t WS_XB = 841 * MiB;
constexpr size_t WS_END = 969 * MiB;
constexpr int CW_TMO = 0;
constexpr int CW_ECNT = 8192;
constexpr int CW_PCNT = 12288;
constexpr int CW_BAR = 32768;
constexpr int LDS_BYTES = 147456;
constexpr int TAB_OFF = 131072;
constexpr int MISC_OFF = LDS_BYTES - 256;

__device__ __forceinline__ float bflo(unsigned w) { return __uint_as_float(w << 16); }
__device__ __forceinline__ float bfhi(unsigned w) { return __uint_as_float(w & 0xffff0000u); }
__device__ __forceinline__ float bf1(unsigned short b) { return __uint_as_float(((unsigned)b) << 16); }
__device__ __forceinline__ unsigned cvt_pk_bf16(float lo, float hi) { unsigned r; asm volatile("v_cvt_pk_bf16_f32 %0, %1, %2" : "=v"(r) : "v"(lo), "v"(hi)); return r; }
__device__ __forceinline__ float wave_sum(float v) {
#pragma unroll
    for (int o = 1; o < 64; o <<= 1) v += __shfl_xor(v, o);
    return v;
}
__device__ __forceinline__ float sigmoidf_(float x) { return __builtin_amdgcn_rcpf(1.0f + __builtin_amdgcn_exp2f(-1.44269504f * x)); }
typedef float f32x2_g __attribute__((ext_vector_type(2)));
__device__ __forceinline__ f32x2_g gelu_tanh2(f32x2_g x) {
    const f32x2_g one2 = (f32x2_g){1.0f, 1.0f}, c2 = (f32x2_g){0.044715f, 0.044715f}, k2 = (f32x2_g){-2.3022082f, -2.3022082f};
    const f32x2_g ea = (x * (one2 + c2 * (x * x))) * k2, d = (f32x2_g){__builtin_amdgcn_exp2f(ea.x), __builtin_amdgcn_exp2f(ea.y)} + one2;
    return x * (f32x2_g){__builtin_amdgcn_rcpf(d.x), __builtin_amdgcn_rcpf(d.y)}; }
__device__ __forceinline__ float gelu_tanh(float x) { const float z = x * (1.0f + 0.044715f * x * x); return x * __builtin_amdgcn_rcpf(1.0f + __builtin_amdgcn_exp2f(-2.3022082f * z)); }
__device__ __forceinline__ unsigned pk4_fp8(float a, float b, float c, float d) {
    a = __builtin_fminf(__builtin_fmaxf(a, -448.f), 448.f); b = __builtin_fminf(__builtin_fmaxf(b, -448.f), 448.f); c = __builtin_fminf(__builtin_fmaxf(c, -448.f), 448.f); d = __builtin_fminf(__builtin_fmaxf(d, -448.f), 448.f);
    unsigned r = 0; r = __builtin_amdgcn_cvt_pk_fp8_f32(a, b, r, false); r = __builtin_amdgcn_cvt_pk_fp8_f32(c, d, r, true); return r; }
constexpr float FP8_SW = 32.0f, FP8_SH = 16.0f, FP8_SY = 8.0f;
constexpr float I8_ASTEP = 8.0f / 127.0f;
__device__ __forceinline__ unsigned pk4_i8(float a, float b, float c, float d) {
    const int ia = (int)__builtin_rintf(__builtin_fminf(__builtin_fmaxf(a, -127.f), 127.f)), ib = (int)__builtin_rintf(__builtin_fminf(__builtin_fmaxf(b, -127.f), 127.f));
    const int ic = (int)__builtin_rintf(__builtin_fminf(__builtin_fmaxf(c, -127.f), 127.f)), id = (int)__builtin_rintf(__builtin_fminf(__builtin_fmaxf(d, -127.f), 127.f));
    return ((unsigned)ia & 0xffu) | (((unsigned)ib & 0xffu) << 8) | (((unsigned)ic & 0xffu) << 16) | ((unsigned)id << 24); }
typedef int v8i __attribute__((ext_vector_type(8)));
typedef int i32x4 __attribute__((ext_vector_type(4)));
__device__ __forceinline__ int lane_id_v() { int r; asm volatile("v_mbcnt_lo_u32_b32 %0, -1, 0\n\tv_mbcnt_hi_u32_b32 %0, -1, %0" : "=v"(r)); return r; }
#define LDS_WAIT() asm volatile("s_waitcnt lgkmcnt(0)" ::: "memory")
#define VM_WAIT() asm volatile("s_waitcnt vmcnt(0)" ::: "memory")

namespace pg8 {
constexpr int BM = 256, BK = 64, HALF = 128, HTB = HALF * BK * 2, STAGE_BYTES = 8 * HTB, NXCD = 8, WGM = 8;
__host__ __device__ __forceinline__ int lds_byte(int r, int c) { const int st = (r >> 4) * 2 + (c >> 5), rr = r & 15, cc = c & 31, ob = rr * 64 + cc * 2; return st * 1024 + (ob ^ (((ob >> 9) & 1) << 5)); }
__host__ __device__ __forceinline__ void stage_rc(int b, int& R, int& C) { const int st = b / 1024, sb = b % 1024, swz = sb ^ (((sb >> 9) & 1) << 5); R = (st >> 1) * 16 + swz / 64; C = (st & 1) * 32 + (swz % 64) / 2; }
__host__ __device__ __forceinline__ int perm32(int rho) { const int n = rho >> 4, i = rho & 15; return 8 * (i >> 2) + 4 * n + (i & 3); }

struct Unit { int pm, pn; const char* A; const char* B0; const char* B1; const unsigned* list; int nvalid; };

template <class Epi, class Sched, bool GATHER, int PREC = 0>
__device__ __forceinline__ void gemm_phase(LAS unsigned char* lds, const int lda, const int ldb, const int K, const int nth, const Sched& S, const Epi& E, const unsigned stagger_ticks = 0u) {
    constexpr bool FP8 = PREC == 1, I8 = PREC == 2;
    const int tid = threadIdx.x, wid = __builtin_amdgcn_readfirstlane(tid >> 6), lane = tid & 63, wr = wid >> 2, wc = wid & 3, fr = lane & 15, fq = lane >> 4;
    const int nt = K / BK;
    int R0, C0; stage_rc(tid * 16, R0, C0);
    unsigned voffB[2]; { const int Rb = Epi::PERM ? ((R0 & ~31) + perm32(R0 & 31)) : R0; voffB[0] = (unsigned)(Rb * ldb + C0) * 2u; voffB[1] = voffB[0] + (unsigned)(64 * ldb * 2); }
    const size_t kstep = (size_t)(BK * 2);
    const size_t hstepB = (size_t)HALF * ldb * 2;
    const unsigned ldsw = (unsigned)wid * 1024u;
    const int aoff = lds_byte(wr * 64 + fr, fq * 8), boff = lds_byte(wc * 32 + fr, fq * 8);
    constexpr int P1OFF = 1024;
#define PG8_SA(b, h) (((b) * 2 + (h)) * HTB)
#define PG8_SB(b, h) ((4 + (b) * 2 + (h)) * HTB)
#define PG8_STAGE(bufoff, gbase, voff) do { _Pragma("unroll") for (int _i = 0; _i < 2; ++_i) \
        __builtin_amdgcn_global_load_lds((const unsigned*)((const char*)(gbase) + (voff)[_i]), (LAS unsigned*)(lds + (bufoff) + ldsw + _i * 8192), 16, 0, 0); } while (0)
#define PG8_LDA(dst, dst8, b, h) do { if constexpr (FP8) { _Pragma("unroll") for (int m = 0; m < 4; ++m) { const i32x4 lo_ = *(const LAS i32x4*)(lds + PG8_SA(b, h) + aoff + m * 2048), hi_ = *(const LAS i32x4*)(lds + PG8_SA(b, h) + aoff + P1OFF + m * 2048); dst8[m] = __builtin_shufflevector(lo_, hi_, 0, 1, 2, 3, 4, 5, 6, 7); } } \
        else { _Pragma("unroll") for (int m = 0; m < 4; ++m) _Pragma("unroll") for (int k = 0; k < 2; ++k) dst[m][k] = *(const LAS bf16x8*)(lds + PG8_SA(b, h) + aoff + m * 2048 + k * P1OFF); } } while (0)
#define PG8_LDB(dst, dst8, b, h) do { if constexpr (FP8) { _Pragma("unroll") for (int n = 0; n < 2; ++n) { const i32x4 lo_ = *(const LAS i32x4*)(lds + PG8_SB(b, h) + boff + n * 2048), hi_ = *(const LAS i32x4*)(lds + PG8_SB(b, h) + boff + P1OFF + n * 2048); dst8[n] = __builtin_shufflevector(lo_, hi_, 0, 1, 2, 3, 4, 5, 6, 7); } } \
        else { _Pragma("unroll") for (int n = 0; n < 2; ++n) _Pragma("unroll") for (int k = 0; k < 2; ++k) dst[n][k] = *(const LAS bf16x8*)(lds + PG8_SB(b, h) + boff + n * 2048 + k * P1OFF); } } while (0)
#define PG8_MMA(ai, bj, At, Bt, At8, Bt8) do { __builtin_amdgcn_s_setprio(1); _Pragma("unroll") for (int m = 0; m < 4; ++m) _Pragma("unroll") for (int n = 0; n < 2; ++n) { \
        if constexpr (FP8) asm volatile("v_mfma_scale_f32_16x16x128_f8f6f4 %0, %1, %2, %0, %3, %3 op_sel_hi:[0,0,0]" : "+v"(acc[ai][bj][m][n]) : "v"(Bt8[n]), "v"(At8[m]), "v"(sc127)); \
        else if constexpr (I8) { _Pragma("unroll") for (int k = 0; k < 2; ++k) acc[ai][bj][m][n] = __builtin_bit_cast(f32x4, __builtin_amdgcn_mfma_i32_16x16x64_i8(__builtin_bit_cast(i32x4, Bt[n][k]), __builtin_bit_cast(i32x4, At[m][k]), __builtin_bit_cast(i32x4, acc[ai][bj][m][n]), 0, 0, 0)); } \
        else { _Pragma("unroll") for (int k = 0; k < 2; ++k) acc[ai][bj][m][n] = __builtin_amdgcn_mfma_f32_16x16x32_bf16(Bt[n][k], At[m][k], acc[ai][bj][m][n], 0, 0, 0); } } \
        __builtin_amdgcn_s_setprio(0); } while (0)
#define PG8_WAIT_V(n) asm volatile("s_waitcnt vmcnt(" #n ")" ::: "memory")
#define PG8_WAIT_L(n) asm volatile("s_waitcnt lgkmcnt(" #n ")" ::: "memory")
#define PG8_BAR __builtin_amdgcn_s_barrier()
#define PG8_SCHED __builtin_amdgcn_sched_barrier(0)
    Unit cur, nxt; int ui = 0;
    if (!S.next(0, cur)) return;
    if (stagger_ticks) { const unsigned long long t0 = wall_clock64(); while (wall_clock64() - t0 < (unsigned long long)stagger_ticks) __builtin_amdgcn_s_sleep(4); }
    unsigned offc[2][2], nid[2][2];
#pragma unroll
    for (int h = 0; h < 2; ++h)
#pragma unroll
        for (int i = 0; i < 2; ++i) {
            const int r = R0 + 64 * i + HALF * h;
            if constexpr (GATHER) { const unsigned ent = r < cur.nvalid ? cur.list[r] : 0u; offc[h][i] = (ent & 0x7fffffffu) * (unsigned)(lda * 2) + (unsigned)(C0 * 2); }
            else offc[h][i] = (unsigned)(r * lda + C0) * 2u;
            nid[h][i] = 0u;
        }
    f32x4 acc[2][2][4][2];
#pragma unroll
    for (int a = 0; a < 2; ++a)
#pragma unroll
        for (int b = 0; b < 2; ++b)
#pragma unroll
            for (int m = 0; m < 4; ++m)
#pragma unroll
                for (int n = 0; n < 2; ++n) acc[a][b][m][n] = (f32x4){0.f, 0.f, 0.f, 0.f};
    bf16x8 At[4][2], B0[2][2], B1[2][2]; v8i At8[4], B08[2], B18[2]; const int sc127 = 127;
    const char* cA = cur.A; const char* cB0 = cur.B0; const char* cB1 = cur.B1;
    E.prefetch(cur.pm, cur.pn, cur.list, cur.nvalid, lds, 0, wid, lane);
    PG8_STAGE(PG8_SB(0, 0), cB0, voffB); PG8_STAGE(PG8_SB(0, 1), cB0 + hstepB, voffB); PG8_STAGE(PG8_SA(0, 0), cA, offc[0]); PG8_STAGE(PG8_SA(0, 1), cA, offc[1]);
    if (wr == 1) PG8_BAR;
    PG8_WAIT_V(2); PG8_BAR;
    PG8_STAGE(PG8_SB(1, 0), cB0 + kstep, voffB); PG8_STAGE(PG8_SA(1, 0), cA + kstep, offc[0]); PG8_STAGE(PG8_SB(1, 1), cB0 + hstepB + kstep, voffB);
    PG8_WAIT_V(6); PG8_BAR;
    for (;;) {
        const bool has_next = S.next(ui + 1, nxt);
        if constexpr (GATHER) {
            if (has_next) {
#pragma unroll
                for (int h = 0; h < 2; ++h)
#pragma unroll
                    for (int i = 0; i < 2; ++i) { const int r = R0 + 64 * i + HALF * h; nid[h][i] = r < nxt.nvalid ? nxt.list[r] : 0u; }
            }
        }
        const char* nA = has_next ? nxt.A : cA; const char* nB0 = has_next ? nxt.B0 : cB0;
        for (int t = 0; t < nt; t += 2) {
            const bool last = (t == nt - 2);
            const char* a1 = cA + (size_t)(t + 1) * kstep;
            const char* a2 = last ? nA : cA + (size_t)(t + 2) * kstep;
            const char* b2 = last ? nB0 : ((t + 2 < nth) ? cB0 + (size_t)(t + 2) * kstep : cB1 + (size_t)(t + 2 - nth) * kstep);
            const char* a3 = a2 + kstep; const char* b3 = b2 + kstep;
            unsigned o2[2][2];
#pragma unroll
            for (int h = 0; h < 2; ++h)
#pragma unroll
                for (int i = 0; i < 2; ++i) {
                    if constexpr (GATHER) o2[h][i] = (last && has_next) ? (nid[h][i] & 0x7fffffffu) * (unsigned)(lda * 2) + (unsigned)(C0 * 2) : offc[h][i];
                    else o2[h][i] = offc[h][i]; }
            PG8_LDB(B0, B08, 0, 0); PG8_LDB(B1, B18, 0, 1); PG8_SCHED; PG8_LDA(At, At8, 0, 0); PG8_STAGE(PG8_SA(1, 1), a1, offc[1]);
            PG8_WAIT_V(8); PG8_WAIT_L(0); PG8_BAR; PG8_MMA(0, 0, At, B0, At8, B08); PG8_MMA(0, 1, At, B1, At8, B18); PG8_BAR; PG8_SCHED;
            PG8_LDA(At, At8, 0, 1); PG8_STAGE(PG8_SB(0, 0), b2, voffB); PG8_STAGE(PG8_SB(0, 1), b2 + hstepB, voffB); PG8_STAGE(PG8_SA(0, 0), a2, o2[0]);
            PG8_WAIT_V(8); PG8_WAIT_L(0); PG8_BAR; PG8_MMA(1, 0, At, B0, At8, B08); PG8_MMA(1, 1, At, B1, At8, B18); PG8_BAR; PG8_SCHED;
            PG8_LDB(B0, B08, 1, 0); PG8_LDB(B1, B18, 1, 1); PG8_SCHED; PG8_LDA(At, At8, 1, 0); PG8_STAGE(PG8_SA(0, 1), a2, o2[1]);
            PG8_WAIT_V(8); PG8_WAIT_L(0); PG8_BAR; PG8_MMA(0, 0, At, B0, At8, B08); PG8_MMA(0, 1, At, B1, At8, B18); PG8_BAR; PG8_SCHED;
            PG8_LDA(At, At8, 1, 1); PG8_STAGE(PG8_SB(1, 0), b3, voffB); PG8_STAGE(PG8_SB(1, 1), b3 + hstepB, voffB); PG8_STAGE(PG8_SA(1, 0), a3, o2[0]);
            PG8_WAIT_V(8); PG8_WAIT_L(0); PG8_BAR; PG8_MMA(1, 0, At, B0, At8, B08); PG8_MMA(1, 1, At, B1, At8, B18); PG8_BAR; PG8_SCHED;
        }
        if (wr == 0) PG8_BAR;
        if constexpr (FP8) asm volatile("s_nop 15\n\ts_nop 15" ::: "memory");
        E(acc, cur, wr, wc, fr, fq, lds, ui & 1);
        if (!has_next) break;
        E.prefetch(nxt.pm, nxt.pn, nxt.list, nxt.nvalid, lds, (ui + 1) & 1, wid, lane);
#pragma unroll
        for (int a = 0; a < 2; ++a)
#pragma unroll
            for (int b = 0; b < 2; ++b)
#pragma unroll
                for (int m = 0; m < 4; ++m)
#pragma unroll
                    for (int n = 0; n < 2; ++n) acc[a][b][m][n] = (f32x4){0.f, 0.f, 0.f, 0.f};
        cur = nxt; cA = nA; cB0 = nB0; cB1 = nxt.B1; ++ui;
        if constexpr (GATHER) {
#pragma unroll
            for (int h = 0; h < 2; ++h)
#pragma unroll
                for (int i = 0; i < 2; ++i) offc[h][i] = (nid[h][i] & 0x7fffffffu) * (unsigned)(lda * 2) + (unsigned)(C0 * 2);
        }
        if (wr == 1) PG8_BAR;
    }
    PG8_WAIT_V(0);
    PG8_BAR;
#undef PG8_SA
#undef PG8_SB
#undef PG8_STAGE
#undef PG8_LDA
#undef PG8_LDB
#undef PG8_MMA
#undef PG8_WAIT_V
#undef PG8_WAIT_L
#undef PG8_BAR
#undef PG8_SCHED
}

struct DenseOrder {
    int nM, nN, nwg, G, c, same_tile = 0; const char* A; const char* B; size_t tA, tB, b1off;
    __device__ __forceinline__ void init(int Mr, int N, int G_, int c_, const void* A_, int lda, const void* B_, int ldb, int nth) {
        nM = Mr / BM; nN = N / BM; nwg = nM * nN; G = G_; c = c_; A = (const char*)A_; B = (const char*)B_; tA = (size_t)BM * lda * 2; tB = (size_t)BM * ldb * 2; b1off = (size_t)nth * BK * 2; }
    __device__ __forceinline__ bool next(int i, Unit& u) const {
        const long L = (long)i * G + c; if (L >= nwg) return false;
        int wgid = (int)L; { const int q = nwg / NXCD, r = nwg % NXCD, xcd = wgid % NXCD, off = wgid / NXCD; wgid = (xcd < r ? xcd * (q + 1) : r * (q + 1) + (xcd - r) * q) + off; }
        const int nig = WGM * nN, gid = wgid / nig, fm = gid * WGM, gsz = (nM - fm) < WGM ? (nM - fm) : WGM;
        u.pm = fm + ((wgid % nig) % gsz); u.pn = (wgid % nig) / gsz;
        u.A = A + (same_tile ? 0 : (size_t)u.pm * tA); u.B0 = B + (same_tile ? 0 : (size_t)u.pn * tB); u.B1 = u.B0 + b1off; u.list = nullptr; u.nvalid = BM; return true;
    }
};
__device__ __forceinline__ int find_group(const LAS int* pref, int n, int rt, int lane) {
    const int j0 = lane, j1 = lane + 64;
    const bool f0 = j0 < n && pref[j0] <= rt && rt < pref[j0 + 1];
    const bool f1 = j1 < n && pref[j1] <= rt && rt < pref[j1 + 1];
    const unsigned long long m0 = __ballot(f0), m1 = __ballot(f1);
    return m0 ? (int)__builtin_ctzll(m0) : 64 + (int)__builtin_ctzll(m1 | (1ull << 63));
}
template <bool PAIR> struct GroupOrder {
    static constexpr size_t WSTRIDE = PAIR ? (size_t)1024 * 512 : (size_t)1024 * 1024, TB = PAIR ? (size_t)256 * 512 : (size_t)256 * 1024;
    const LAS int* pref; int ng, G, c, lane;
    const char* A; const char* W; const unsigned* lists;
    __device__ __forceinline__ bool next(int i, Unit& u) const {
        const LAS int* cnt = pref + 130;
        const long L = (long)i * G + c; const int total = __builtin_amdgcn_readfirstlane(pref[ng]);
        if (L >= 4L * total) return false;
        const int rt = (int)(L >> 2); u.pn = (int)(L & 3);
        const int g = __builtin_amdgcn_readfirstlane(find_group(pref, ng, rt, lane));
        const int tr = rt - __builtin_amdgcn_readfirstlane(pref[g]); const int cg = __builtin_amdgcn_readfirstlane(cnt[g]);
        u.pm = tr; u.nvalid = (cg - tr * BM) < BM ? (cg - tr * BM) : BM;
        u.list = lists + (size_t)g * 65536 + (size_t)tr * BM;
        u.A = A;
        if (PAIR) { const int grp = g / 28; int pi = g % 28, lo = 0; while (pi >= 7 - lo) { pi -= 7 - lo; ++lo; } const int hi = lo + 1 + pi;
            u.B0 = W + (size_t)(grp * 8 + lo) * WSTRIDE + (size_t)u.pn * TB; u.B1 = W + (size_t)(grp * 8 + hi) * WSTRIDE + (size_t)u.pn * TB; }
        else { u.B0 = W + (size_t)g * WSTRIDE + (size_t)u.pn * TB; u.B1 = u.B0; }
        return true;
    }
};

struct EpiZ {
    static constexpr bool PERM = true;
    bf16* O; int ldc; int gelu_lt; int st_on; int cx_from; int cx_col0; float scale; const float* sbase; int coff; int roff;
    static constexpr int SCL_OFF = 133120;
    __device__ __forceinline__ void prefetch(int pm, int pn, const unsigned*, int, LAS unsigned char* lds, int par, int wid, int lane) const {
        const int off = wid < 4 ? roff + pm * BM + 64 * wid : coff + pn * BM + 64 * (wid - 4); const float* src = sbase + off + lane;
        __builtin_amdgcn_global_load_lds((const unsigned*)src, (LAS unsigned*)(lds + SCL_OFF + par * 2048 + wid * 256), 4, 0, 0);
    }
    __device__ __forceinline__ f32x4 val(const f32x4& a) const { return __builtin_convertvector(__builtin_bit_cast(i32x4, a), f32x4); }
    __device__ __forceinline__ void operator()(const f32x4 (&acc)[2][2][4][2], const Unit& u, int wr, int wc, int fr, int fq, LAS unsigned char* lds, int par) const {
        if (!st_on) return;
        const int row0 = u.pm * BM + wr * 64 + fr, wcol0 = u.pn * BM + wc * 32 + 8 * fq;
        f32x4 cs[2][2]; float rs[2][4];
#pragma unroll
        for (int bj = 0; bj < 2; ++bj)
#pragma unroll
            for (int h = 0; h < 2; ++h) cs[bj][h] = *(const LAS f32x4*)(lds + SCL_OFF + par * 2048 + 1024 + (wc * 32 + 8 * fq + bj * HALF + 4 * h) * 4) * scale;
#pragma unroll
        for (int ai = 0; ai < 2; ++ai)
#pragma unroll
            for (int m = 0; m < 4; ++m) rs[ai][m] = *(const LAS float*)(lds + SCL_OFF + par * 2048 + (wr * 64 + fr + ai * HALF + m * 16) * 4);
        asm volatile("" ::: "memory");
        if (u.pn >= cx_from) { const int col0 = cx_col0 + (u.pn - cx_from) * HALF + wc * 32 + 8 * fq;
#pragma unroll
            for (int ai = 0; ai < 2; ++ai)
#pragma unroll
                for (int m = 0; m < 4; ++m) { const float r2 = rs[ai][m] * rs[ai][m];
                    const f32x4 v0 = val(acc[ai][0][m][0]) * val(acc[ai][1][m][0]) * (cs[0][0] * cs[1][0]) * r2, v1 = val(acc[ai][0][m][1]) * val(acc[ai][1][m][1]) * (cs[0][1] * cs[1][1]) * r2;
                    u32x4 w; w.x = cvt_pk_bf16(v0[0], v0[1]); w.y = cvt_pk_bf16(v0[2], v0[3]); w.z = cvt_pk_bf16(v1[0], v1[1]); w.w = cvt_pk_bf16(v1[2], v1[3]);
                    *(u32x4*)(O + (size_t)(row0 + ai * HALF + m * 16) * ldc + col0) = w; }
            return; }
        const bool act = u.pn < gelu_lt;
#pragma unroll
        for (int ai = 0; ai < 2; ++ai)
#pragma unroll
            for (int m = 0; m < 4; ++m) { bf16* rowp = O + (size_t)(row0 + ai * HALF + m * 16) * ldc + wcol0;
#pragma unroll
                for (int bj = 0; bj < 2; ++bj) { f32x4 v0 = val(acc[ai][bj][m][0]) * cs[bj][0] * rs[ai][m], v1 = val(acc[ai][bj][m][1]) * cs[bj][1] * rs[ai][m];
                    if (act) {
#pragma unroll
                        for (int jp = 0; jp < 2; ++jp) { const f32x2_g a = gelu_tanh2((f32x2_g){v0[2 * jp], v0[2 * jp + 1]}), b = gelu_tanh2((f32x2_g){v1[2 * jp], v1[2 * jp + 1]});
                            v0[2 * jp] = a.x; v0[2 * jp + 1] = a.y; v1[2 * jp] = b.x; v1[2 * jp + 1] = b.y; } }
                    u32x4 w; w.x = cvt_pk_bf16(v0[0], v0[1]); w.y = cvt_pk_bf16(v0[2], v0[3]); w.z = cvt_pk_bf16(v1[0], v1[1]); w.w = cvt_pk_bf16(v1[2], v1[3]);
                    *(u32x4*)(rowp + bj * HALF) = w; } }
    }
};
template <bool BASE_F32> struct EpiRes {
    static constexpr bool PERM = true;
    __device__ __forceinline__ void prefetch(int, int, const unsigned*, int, LAS unsigned char*, int, int, int) const {}
    const void* __restrict__ base; bf16* __restrict__ out; float scale; int probe = 0;
    __device__ __forceinline__ void operator()(f32x4 (&acc)[2][2][4][2], const Unit& u, int wr, int wc, int fr, int fq, LAS unsigned char* lds, int par) const {
        const int row0 = u.pm * BM + wr * 64 + fr, col0 = u.pn * BM + wc * 32 + 8 * fq;
        if (BASE_F32) {
#pragma unroll
            for (int ai = 0; ai < 2; ++ai) { f32x4 b[4][2][2];
#pragma unroll
                for (int m = 0; m < 4; ++m)
#pragma unroll
                    for (int bj = 0; bj < 2; ++bj) { const float* bp = (const float*)base + (size_t)(row0 + ai * HALF + m * 16) * 1024 + col0 + bj * HALF; b[m][bj][0] = *(const f32x4*)bp; b[m][bj][1] = *(const f32x4*)(bp + 4); }
                asm volatile("" ::: "memory");
#pragma unroll
                for (int m = 0; m < 4; ++m)
#pragma unroll
                    for (int bj = 0; bj < 2; ++bj) { acc[ai][bj][m][0] += b[m][bj][0]; acc[ai][bj][m][1] += b[m][bj][1]; } }
        } else {
            u32x4 b[2][4][2];
#pragma unroll
            for (int ai = 0; ai < 2; ++ai)
#pragma unroll
                for (int m = 0; m < 4; ++m)
#pragma unroll
                    for (int bj = 0; bj < 2; ++bj) { b[ai][m][bj] = (u32x4){0u, 0u, 0u, 0u}; if (!(probe & 1)) b[ai][m][bj] = *(const u32x4*)((const bf16*)base + (size_t)(row0 + ai * HALF + m * 16) * 1024 + col0 + bj * HALF); }
            asm volatile("" ::: "memory");
#pragma unroll
            for (int ai = 0; ai < 2; ++ai)
#pragma unroll
                for (int m = 0; m < 4; ++m)
#pragma unroll
                    for (int bj = 0; bj < 2; ++bj) { const u32x4 w = b[ai][m][bj];
                        acc[ai][bj][m][0] = acc[ai][bj][m][0] * scale + (f32x4){bflo(w.x), bfhi(w.x), bflo(w.y), bfhi(w.y)}; acc[ai][bj][m][1] = acc[ai][bj][m][1] * scale + (f32x4){bflo(w.z), bfhi(w.z), bflo(w.w), bfhi(w.w)}; }
        }
        asm volatile("" ::: "memory");
#pragma unroll
        for (int ai = 0; ai < 2; ++ai)
#pragma unroll
            for (int m = 0; m < 4; ++m) { const size_t off = (size_t)(row0 + ai * HALF + m * 16) * 1024 + col0;
#pragma unroll
                for (int bj = 0; bj < 2; ++bj) { const f32x4 v0 = acc[ai][bj][m][0], v1 = acc[ai][bj][m][1];
                    u32x4 w; w.x = cvt_pk_bf16(v0[0], v0[1]); w.y = cvt_pk_bf16(v0[2], v0[3]); w.z = cvt_pk_bf16(v1[0], v1[1]); w.w = cvt_pk_bf16(v1[2], v1[3]);
                    if (!(probe & 2)) *(u32x4*)(out + off + bj * HALF) = w; } }
    }
};
struct EpiG1 {
    static constexpr bool PERM = true;
    static constexpr int SCL_OFF = 133120;
    __device__ __forceinline__ void prefetch(int, int, const unsigned* list, int nvalid, LAS unsigned char* lds, int par, int wid, int lane) const {
        const int rl = 64 * (wid & 3) + lane_id_v(), rc = rl < nvalid - 1 ? rl : nvalid - 1; const int off = wid < 4 ? 0 : (int)((WS_ELG - WS_ELT) / 4);
        __builtin_amdgcn_global_load_lds(list + off + rc, (LAS unsigned*)(lds + SCL_OFF + par * 2048 + wid * 256), 4, 0, 0);
    }
    unsigned char* HID;
    __device__ __forceinline__ void operator()(const f32x4 (&acc)[2][2][4][2], const Unit& u, int wr, int wc, int fr, int fq, LAS unsigned char* lds, int par) const {
        const int col0 = u.pn * HALF + wc * 32 + 8 * fq; const int nv1 = u.nvalid - 1;
        unsigned ent[2][4], gt[2][4];
#pragma unroll
        for (int ai = 0; ai < 2; ++ai)
#pragma unroll
            for (int m = 0; m < 4; ++m) { const int rl = ai * HALF + wr * 64 + m * 16 + fr; const LAS unsigned* sl = (const LAS unsigned*)(lds + SCL_OFF + par * 2048) + rl; ent[ai][m] = sl[0]; gt[ai][m] = sl[256]; }
        asm volatile("" ::: "memory");
#pragma unroll
        for (int ai = 0; ai < 2; ++ai)
#pragma unroll
            for (int m = 0; m < 4; ++m) { const int rl = ai * HALF + wr * 64 + m * 16 + fr; const unsigned tok = ent[ai][m] & 0x7fffffffu, half = ent[ai][m] >> 31; const float g_ = bflo(gt[ai][m]), rs_ = bfhi(gt[ai][m]) * (1.0f / FP8_SW);
                float o[8];
                const float ks_ = rs_ * -1.44269504f, us_ = rs_ * (g_ * FP8_SH); const f32x2 rs2 = (f32x2){rs_, rs_}, ks2 = (f32x2){ks_, ks_}, us2 = (f32x2){us_, us_}, one2 = (f32x2){1.0f, 1.0f};
#pragma unroll
                for (int n = 0; n < 2; ++n)
#pragma unroll
                    for (int jp = 0; jp < 2; ++jp) { const f32x2 ag = (f32x2){acc[ai][0][m][n][2 * jp], acc[ai][0][m][n][2 * jp + 1]}, au = (f32x2){acc[ai][1][m][n][2 * jp], acc[ai][1][m][n][2 * jp + 1]};
                        const f32x2 ea = ag * ks2, d = (f32x2){__builtin_amdgcn_exp2f(ea.x), __builtin_amdgcn_exp2f(ea.y)} + one2;
                        const f32x2 o2 = (ag * rs2) * (f32x2){__builtin_amdgcn_rcpf(d.x), __builtin_amdgcn_rcpf(d.y)} * (au * us2);
                        o[4 * n + 2 * jp] = o2.x; o[4 * n + 2 * jp + 1] = o2.y; }
                u32x2 w; w.x = pk4_fp8(o[0], o[1], o[2], o[3]); w.y = pk4_fp8(o[4], o[5], o[6], o[7]);
                if (rl <= nv1) *(u32x2*)(HID + (size_t)tok * 1024 + half * 512 + col0) = w; }
    }
};
struct EpiG2 {
    static constexpr bool PERM = true;
    static constexpr int SCL_OFF = 133120;
    __device__ __forceinline__ void prefetch(int, int, const unsigned* list, int nvalid, LAS unsigned char* lds, int par, int wid, int lane) const {
        if (wid < 4) { const int rl = 64 * wid + lane_id_v(), rc = rl < nvalid - 1 ? rl : nvalid - 1;
            __builtin_amdgcn_global_load_lds(list + rc, (LAS unsigned*)(lds + SCL_OFF + par * 2048 + wid * 256), 4, 0, 0); }
    }
    bf16* __restrict__ out;
    __device__ __forceinline__ void operator()(f32x4 (&acc)[2][2][4][2], const Unit& u, int wr, int wc, int fr, int fq, LAS unsigned char* lds, int par) const {
        const int col0 = u.pn * BM + wc * 32 + 8 * fq; const int nv1 = u.nvalid - 1;
        unsigned tokv[2][4];
#pragma unroll
        for (int ai = 0; ai < 2; ++ai)
#pragma unroll
            for (int m = 0; m < 4; ++m) { const int rl = ai * HALF + wr * 64 + m * 16 + fr; tokv[ai][m] = (((const LAS unsigned*)(lds + SCL_OFF + par * 2048))[rl] & 0x7fffffffu) * 2048u + (unsigned)(col0 * 2); }
        asm volatile("" ::: "memory");
        u32x4 b[2][4][2];
#pragma unroll
        for (int ai = 0; ai < 2; ++ai)
#pragma unroll
            for (int m = 0; m < 4; ++m)
#pragma unroll
                for (int bj = 0; bj < 2; ++bj) b[ai][m][bj] = *(const u32x4*)((const char*)out + tokv[ai][m] + bj * (HALF * 2));
        asm volatile("" ::: "memory");
#pragma unroll
        for (int ai = 0; ai < 2; ++ai)
#pragma unroll
            for (int m = 0; m < 4; ++m) { const int rl = ai * HALF + wr * 64 + m * 16 + fr; bf16* p = (bf16*)((char*)out + tokv[ai][m]);
#pragma unroll
                for (int bj = 0; bj < 2; ++bj) { const u32x4 bw = b[ai][m][bj];
                    const float sc = 1.0f / (FP8_SW * FP8_SH);
                    const f32x4 v0 = acc[ai][bj][m][0] * sc + (f32x4){bflo(bw.x), bfhi(bw.x), bflo(bw.y), bfhi(bw.y)}, v1 = acc[ai][bj][m][1] * sc + (f32x4){bflo(bw.z), bfhi(bw.z), bflo(bw.w), bfhi(bw.w)};
                    u32x4 w; w.x = cvt_pk_bf16(v0[0], v0[1]); w.y = cvt_pk_bf16(v0[2], v0[3]); w.z = cvt_pk_bf16(v1[0], v1[1]); w.w = cvt_pk_bf16(v1[2], v1[3]);
                    if (rl <= nv1) *(u32x4*)(p + bj * HALF) = w; } }
    }
};
}

#define XB_TMO      128
#define XB_XCNT(j)  (256  + 64 * (j))
#define XB_XSUB(j)  (1280 + 64 * (j))
#define XB_XGEN(j)  (2304 + 64 * (j))
#define XB_TOP      3328
#define XB_TOPGEN   3392
#define XCD_BAR_WORDS 3456
#define XB_SPIN_CAP (1u << 18)
__device__ __forceinline__ unsigned xb_ld(unsigned* p)              { return __hip_atomic_load(p, __ATOMIC_RELAXED, __HIP_MEMORY_SCOPE_AGENT); }
__device__ __forceinline__ unsigned xb_add(unsigned* p, unsigned v) { return __hip_atomic_fetch_add(p, v, __ATOMIC_RELAXED, __HIP_MEMORY_SCOPE_AGENT); }
__device__ __forceinline__ unsigned xb_xcc_id() { return (unsigned)__builtin_amdgcn_s_getreg((3 << 11) | 20) & 0xFu; }
#define XB_SPIN(cond, bar) do { unsigned _sp = 0; while (cond) { __builtin_amdgcn_s_sleep(1); \
    if ((++_sp & 255u) == 0u) { if (xb_ld(&(bar)[XB_TMO])) break; if (_sp > XB_SPIN_CAP) { atomicAdd(&(bar)[XB_TMO], 1u); break; } } } } while (0)
struct XcdBarrier { unsigned* bar; unsigned x; volatile LAS unsigned* st; };
__device__ __forceinline__ XcdBarrier xcd_barrier_post(unsigned* bar, volatile LAS unsigned* st) {
    XcdBarrier b; b.bar = bar; b.x = xb_xcc_id(); b.st = st;
    if (threadIdx.x == 0) (void)xb_add(&bar[XB_XCNT(b.x)], 1u);
    return b;
}
__device__ __forceinline__ void xcd_barrier_complete(unsigned* bar, unsigned x, unsigned& nloc, unsigned& nx) {
    const unsigned G = gridDim.x * gridDim.y * gridDim.z;
    unsigned sum, cnt, mine, sp = 0u;
    for (;;) {
        sum = 0u; cnt = 0u; mine = 0u;
#pragma unroll
        for (unsigned j = 0; j < 16; ++j) { const unsigned c = xb_ld(&bar[XB_XCNT(j)]); sum += c; cnt += (c > 0u) ? 1u : 0u; mine = (j == x) ? c : mine; }
        if (sum == G) break;
        __builtin_amdgcn_s_sleep(1);
        if ((++sp & 255u) == 0u) { if (xb_ld(&bar[XB_TMO])) break; if (sp > XB_SPIN_CAP) { atomicAdd(&bar[XB_TMO], 1u); break; } }
    }
    nloc = mine > 0u ? mine : 1u; nx = cnt > 0u ? cnt : 1u;
}
__device__ __forceinline__ void xcd_barrier(const XcdBarrier& b) {
    asm volatile("s_waitcnt vmcnt(0)" ::: "memory");
    __syncthreads();
    if (threadIdx.x == 0) {
        unsigned* bar = b.bar;
        __builtin_amdgcn_s_waitcnt(0);
        unsigned nloc = b.st[0], nx = b.st[1];
        if (nloc == 0u) { xcd_barrier_complete(bar, b.x, nloc, nx); b.st[0] = nloc; b.st[1] = nx; }
        const unsigned old = xb_add(&bar[XB_XSUB(b.x)], 1u);
        const unsigned gen = old / nloc;
        if (old + 1u == (gen + 1u) * nloc) {
            __builtin_amdgcn_fence(__ATOMIC_RELEASE, "agent");
            asm volatile("s_waitcnt vmcnt(0)" ::: "memory");
            const unsigned og = xb_add(&bar[XB_TOP], 1u);
            const unsigned tg = og / nx;
            if (og + 1u == (tg + 1u) * nx) xb_add(&bar[XB_TOPGEN], 1u);
            else XB_SPIN(xb_ld(&bar[XB_TOPGEN]) == tg, bar);
            __builtin_amdgcn_fence(__ATOMIC_ACQUIRE, "agent");
            xb_add(&bar[XB_XGEN(b.x)], 1u);
            asm volatile("s_waitcnt vmcnt(0)" ::: "memory");
        } else {
            XB_SPIN(xb_ld(&bar[XB_XGEN(b.x)]) == gen, bar);
            __builtin_amdgcn_fence(__ATOMIC_ACQUIRE, "agent");
            asm volatile("s_waitcnt vmcnt(0)" ::: "memory");
        }
    }
    __syncthreads();
}

struct TrItem { const float* W; unsigned char* WT; int ldw, k0, n0, ldt, rd0, fp8; float scale; };
__device__ __forceinline__ void tr_load(const TrItem& t, f32x4 (&wv)[8], int lane) {
#pragma unroll
    for (int i = 0; i < 8; ++i) wv[i] = *(const f32x4*)(t.W + (size_t)(t.k0 + 8 * i + (lane >> 3)) * t.ldw + t.n0 + 4 * (lane & 7));
}
__device__ __forceinline__ void tr_store(const TrItem& t, const f32x4 (&wv)[8], LAS float* scr, int lane) {
#pragma unroll
    for (int i = 0; i < 8; ++i) { LAS float* p = scr + (8 * i + (lane >> 3)) * 33 + 4 * (lane & 7); const f32x4 v = wv[i] * t.scale; p[0] = v.x; p[1] = v.y; p[2] = v.z; p[3] = v.w; }
    LDS_WAIT(); asm volatile("" ::: "memory");
    const int c = lane & 7;
#pragma unroll
    for (int j = 0; j < 4; ++j) { const int n = (lane >> 3) + 8 * j; const LAS float* s = scr + (8 * c) * 33 + n;
        if (t.fp8) { u32x2 o; o.x = pk4_fp8(s[0 * 33], s[1 * 33], s[2 * 33], s[3 * 33]); o.y = pk4_fp8(s[4 * 33], s[5 * 33], s[6 * 33], s[7 * 33]);
            *(u32x2*)(t.WT + (size_t)(t.rd0 + n) * t.ldt + t.k0 + 8 * c) = o; }
        else { u32x4 o; o.x = cvt_pk_bf16(s[0 * 33], s[1 * 33]); o.y = cvt_pk_bf16(s[2 * 33], s[3 * 33]); o.z = cvt_pk_bf16(s[4 * 33], s[5 * 33]); o.w = cvt_pk_bf16(s[6 * 33], s[7 * 33]);
            *(u32x4*)((bf16*)t.WT + (size_t)(t.rd0 + n) * t.ldt + t.k0 + 8 * c) = o; } }
    LDS_WAIT(); asm volatile("" ::: "memory");
}
__device__ __forceinline__ void tr8_load(const TrItem& t, f32x4 (&wv)[16], int lane) {
#pragma unroll
    for (int i = 0; i < 16; ++i) wv[i] = *(const f32x4*)(t.W + (size_t)(t.k0 + 8 * i + (lane >> 3)) * t.ldw + t.n0 + 4 * (lane & 7));
}
__device__ __forceinline__ void tr8_store(const TrItem& t, const f32x4 (&wv)[16], LAS float* scr, int lane) {
#pragma unroll
    for (int i = 0; i < 16; ++i) { LAS float* p = scr + (8 * i + (lane >> 3)) * 33 + 4 * (lane & 7); const f32x4 v = wv[i] * t.scale; p[0] = v.x; p[1] = v.y; p[2] = v.z; p[3] = v.w; }
    LDS_WAIT(); asm volatile("" ::: "memory");
    const int n = lane >> 1, kh = lane & 1; const LAS float* s = scr + (64 * kh) * 33 + n;
    unsigned char* dst = t.WT + (size_t)(t.rd0 + n) * t.ldt + t.k0 + 64 * kh;
#pragma unroll
    for (int q = 0; q < 4; ++q) { u32x4 o;
#pragma unroll
        for (int w = 0; w < 4; ++w) { const int k = 16 * q + 4 * w; o[w] = pk4_fp8(s[k * 33], s[(k + 1) * 33], s[(k + 2) * 33], s[(k + 3) * 33]); }
        *(u32x4*)(dst + 16 * q) = o; }
    LDS_WAIT(); asm volatile("" ::: "memory");
}
struct Tr8Desc { const float* W; unsigned char* WT; int ldw, k0, n0, ldt, mode; };
__device__ __forceinline__ void tr8_wg_load(const Tr8Desc& d, f32x4 (&wv)[16]) {
    const int tid = threadIdx.x;
#pragma unroll
    for (int i = 0; i < 16; ++i) { const int idx = tid + 512 * i; wv[i] = *(const f32x4*)(d.W + (size_t)(d.k0 + (idx >> 6)) * d.ldw + d.n0 + 4 * (idx & 63)); }
    asm volatile("" ::: "memory");
}
__device__ __forceinline__ void tr8_wg_finish(const Tr8Desc& d, const f32x4 (&wv)[16], float scale, LAS float* scr) {
    const int tid = threadIdx.x;
    __syncthreads();
#pragma unroll
    for (int i = 0; i < 16; ++i) { const int idx = tid + 512 * i, k = idx >> 6; *(LAS f32x4*)(scr + k * 260 + ((4 * (idx & 63) + 4 * (k >> 4)) & 255)) = wv[i] * scale; }
    __syncthreads();
    const int c = tid & 7;
#pragma unroll
    for (int i = 0; i < 4; ++i) { const int n = (tid >> 3) + 64 * i, col = d.n0 + n; const int row = d.mode == 0 ? col : (col >> 7) * 256 + (d.mode - 1) * 128 + (col & 127);
        const LAS float* sp = scr + (16 * c) * 260 + ((n + 4 * c) & 255); u32x4 o;
#pragma unroll
        for (int w = 0; w < 4; ++w) o[w] = pk4_fp8(sp[(4 * w) * 260], sp[(4 * w + 1) * 260], sp[(4 * w + 2) * 260], sp[(4 * w + 3) * 260]);
        *(u32x4*)(d.WT + (size_t)row * d.ldt + d.k0 + 16 * c) = o; }
}
__device__ __forceinline__ void tr_i8_cols_wg(const float* W, int ldw, int n0, unsigned char* WT  , float* steps  , LAS float* scr) {
    const int tid = threadIdx.x; LAS float* red = scr + 1024 * 33;
    __syncthreads();
#pragma unroll 1
    for (int h = 0; h < 2; ++h) { f32x4 wv[8];
#pragma unroll
        for (int i = 0; i < 8; ++i) { const int idx = tid + 512 * (8 * h + i); wv[i] = *(const f32x4*)(W + (size_t)(idx >> 3) * ldw + n0 + 4 * (idx & 7)); }
#pragma unroll
        for (int i = 0; i < 8; ++i) { const int idx = tid + 512 * (8 * h + i); LAS float* p = scr + (idx >> 3) * 33 + 4 * (idx & 7); p[0] = wv[i].x; p[1] = wv[i].y; p[2] = wv[i].z; p[3] = wv[i].w; } }
    __syncthreads();
    const int n = tid & 31, part = tid >> 5; float mx = 0.f;
#pragma unroll 8
    for (int k = 0; k < 64; ++k) mx = __builtin_fmaxf(mx, __builtin_fabsf(scr[(64 * part + k) * 33 + n]));
    red[part * 32 + n] = mx;
    __syncthreads();
    if (tid < 32) { float m2 = 1e-30f;
#pragma unroll
        for (int p = 0; p < 16; ++p) m2 = __builtin_fmaxf(m2, red[p * 32 + tid]);
        steps[tid] = m2 * (1.0f / 127.0f); red[512 + tid] = 127.0f / m2; }
    __syncthreads();
    const float inv = red[512 + n]; const LAS float* sp = scr + (64 * part) * 33 + n; unsigned char* dst = WT + (size_t)n * 1024 + 64 * part;
#pragma unroll
    for (int q = 0; q < 4; ++q) { u32x4 o;
#pragma unroll
        for (int w = 0; w < 4; ++w) { const int k = 16 * q + 4 * w; o[w] = pk4_i8(sp[k * 33] * inv, sp[(k + 1) * 33] * inv, sp[(k + 2) * 33] * inv, sp[(k + 3) * 33] * inv); }
        *(u32x4*)(dst + 16 * q) = o; }
    __syncthreads();
}
__device__ __forceinline__ void norm_rows4(const float* x0, const float* g, unsigned char* h0, float* steps, int lane) {
    f32x4 v[4][4]; float s[4], mx[4];
#pragma unroll
    for (int r = 0; r < 4; ++r)
#pragma unroll
        for (int j = 0; j < 4; ++j) v[r][j] = ((const f32x4*)(x0 + (size_t)r * D) + lane)[64 * j];
#pragma unroll
    for (int r = 0; r < 4; ++r) { s[r] = 0.f; mx[r] = 0.f;
#pragma unroll
        for (int j = 0; j < 4; ++j) { s[r] += (v[r][j].x * v[r][j].x + v[r][j].y * v[r][j].y) + (v[r][j].z * v[r][j].z + v[r][j].w * v[r][j].w);
            const f32x4 gv = ((const f32x4*)g + lane)[64 * j]; v[r][j] = v[r][j] * gv;
            mx[r] = __builtin_fmaxf(mx[r], __builtin_fmaxf(__builtin_fmaxf(__builtin_fabsf(v[r][j].x), __builtin_fabsf(v[r][j].y)), __builtin_fmaxf(__builtin_fabsf(v[r][j].z), __builtin_fabsf(v[r][j].w)))); } }
#pragma unroll
    for (int o = 1; o < 64; o <<= 1) {
#pragma unroll
        for (int r = 0; r < 4; ++r) { s[r] += __shfl_xor(s[r], o); mx[r] = __builtin_fmaxf(mx[r], __shfl_xor(mx[r], o)); } }
#pragma unroll
    for (int r = 0; r < 4; ++r) { const float rs = 1.0f / sqrtf(s[r] * (1.0f / D) + EPS); const float m = __builtin_fmaxf(mx[r], 1e-30f), inv = 127.0f / m;
        if (lane == 0) steps[r] = m * rs * (1.0f / 127.0f);
        unsigned* o4 = (unsigned*)(h0 + (size_t)r * 1024) + lane;
#pragma unroll
        for (int j = 0; j < 4; ++j) o4[64 * j] = pk4_i8(v[r][j].x * inv, v[r][j].y * inv, v[r][j].z * inv, v[r][j].w * inv); }
}

struct Args { const float* in[26]; float* out; unsigned char* ws; int ph_lo, ph_hi, li, pad; };

__device__ __forceinline__ TrItem p0_item(const Args& a, unsigned char* ws, int it) {
    constexpr int I_OUT = 16 * 32, I_AX = 8 * 2 * 8;
    TrItem t; t.fp8 = 0; t.scale = 1.0f; int r = it;
    if (r < I_OUT) { t.W = a.in[9]; t.ldw = 1024; t.k0 = 64 * (r / 32); t.n0 = 32 * (r % 32); t.WT = ws + WS_WO; t.ldt = 1024; t.rd0 = t.n0; return t; } r -= I_OUT;
    if (r < I_AX) { const int h = r / 16, gate = (r / 8) & 1, kb = (r / 4) & 1, nb = r & 3;
        t.W = (gate ? a.in[15] : a.in[13]) + (size_t)h * 16384; t.ldw = 128; t.k0 = 64 * kb; t.n0 = 32 * nb; t.WT = ws + WS_WAX + (size_t)h * 256 * 128 * 2; t.ldt = 128; t.rd0 = gate * 128 + 32 * nb; t.scale = -1.44269504f; return t; } r -= I_AX;
    { const int l = r / 16, kb = r % 16; t.W = a.in[21] + (size_t)l * 1024 * 32; t.ldw = 32; t.k0 = 64 * kb; t.n0 = 0; t.WT = ws + WS_WRT + (size_t)l * 48 * 1024 * 2; t.ldt = 1024; t.rd0 = 0; }
    return t;
}
__device__ __forceinline__ TrItem p0_item8(const Args& a, unsigned char* ws, int it) {
    constexpr int I_CO = 8 * 32;
    TrItem t; t.fp8 = 1; t.scale = FP8_SW; int r = it;
    if (r < I_CO) { t.W = a.in[18]; t.ldw = 1024; t.k0 = 128 * (r / 32); t.n0 = 32 * (r % 32); t.WT = ws + WS_WCO; t.ldt = 1024; t.rd0 = t.n0; return t; } r -= I_CO;
    const int le = r / 384, q = r % 384;
    if (q < 256) { const int up = q / 128, qq = q % 128, kb = qq / 16, nb = qq % 16, n0 = 32 * nb;
        t.W = (up ? a.in[24] : a.in[23]) + (size_t)le * 1024 * 512; t.ldw = 512; t.k0 = 128 * kb; t.n0 = n0; t.WT = ws + WS_WGU + (size_t)le * 1024 * 1024; t.ldt = 1024; t.rd0 = (n0 / 128) * 256 + up * 128 + (n0 % 128); }
    else { const int qq = q - 256, kb = qq / 32, nb = qq % 32;
        t.W = a.in[25] + (size_t)le * 512 * 1024; t.ldw = 1024; t.k0 = 128 * kb; t.n0 = 32 * nb; t.WT = ws + WS_WD + (size_t)le * 1024 * 512; t.ldt = 512; t.rd0 = 32 * nb; }
    return t;
}
__device__ __forceinline__ Tr8Desc p0_slab8(const Args& a, unsigned char* ws, int it) {
    Tr8Desc d;
    if (it < 32) { d.W = a.in[18]; d.ldw = 1024; d.k0 = 128 * (it >> 2); d.n0 = 256 * (it & 3); d.WT = ws + WS_WCO; d.ldt = 1024; d.mode = 0; return d; }
    const int r = it - 32, le = r / 48, q = r % 48;
    if (q < 32) { const int up = q >> 4, kb = (q & 15) >> 1, nh = q & 1;
        d.W = (up ? a.in[24] : a.in[23]) + (size_t)le * 1024 * 512; d.ldw = 512; d.k0 = 128 * kb; d.n0 = 256 * nh; d.WT = ws + WS_WGU + (size_t)le * 1024 * 1024; d.ldt = 1024; d.mode = 1 + up; }
    else { const int qq = q - 32, kb = qq >> 2, nq = qq & 3;
        d.W = a.in[25] + (size_t)le * 512 * 1024; d.ldw = 1024; d.k0 = 128 * kb; d.n0 = 256 * nq; d.WT = ws + WS_WD + (size_t)le * 1024 * 512; d.ldt = 512; d.mode = 0; }
    return d;
}
__device__ __forceinline__ void p0_prologue(const Args& a, LAS unsigned char* lds, int G, int wave, int lane, const int parts = 3) {
    unsigned char* ws = a.ws;
    LAS float* scr = (LAS float*)(lds + wave * 16896);
    const int gw = blockIdx.x * 8 + wave, NGW = G * 8;
    constexpr int NITEMS = 16 * 32 + 8 * 2 * 8 + 2 * 16, NITEMS8 = 8 * 32 + 64 * 384;
    if (parts & 1) {
        for (int tl = blockIdx.x; tl < 64 + 80; tl += G) {
            if (tl < 64) { tr_i8_cols_wg(a.in[10], 2048, 32 * tl, ws + WS_WC + (size_t)(32 * tl) * 1024, (float*)(ws + WS_SWC) + 32 * tl, (LAS float*)lds); continue; }
            const int n0 = 32 * (tl - 64); int drow; unsigned char* WT; float* st;
            if (n0 < 512) { drow = n0; WT = ws + WS_WREST; st = (float*)(ws + WS_SWR); }
            else if (n0 < 1024) { drow = n0 - 512; WT = ws + WS_WV; st = (float*)(ws + WS_SWV); }
            else if (n0 < 1536) { drow = n0 - 512; WT = ws + WS_WREST; st = (float*)(ws + WS_SWR); }
            else { const int xb = n0 >= 2048, c = n0 - (xb ? 2048 : 1536); drow = 1024 + (c / 128) * 256 + xb * 128 + (c % 128); WT = ws + WS_WREST; st = (float*)(ws + WS_SWR); }
            tr_i8_cols_wg(a.in[4], 2560, n0, WT + (size_t)drow * 1024, st + drow, (LAS float*)lds);
        }
        {
            constexpr int NSLAB = 32 + 64 * 48;
            int it = blockIdx.x; Tr8Desc da, db; f32x4 wa[16], wb[16];
            bool ha = it < NSLAB; if (ha) { da = p0_slab8(a, ws, it); tr8_wg_load(da, wa); }
            while (ha) {
                const int itb = it + G; const bool hb = itb < NSLAB; if (hb) { db = p0_slab8(a, ws, itb); tr8_wg_load(db, wb); }
                tr8_wg_finish(da, wa, FP8_SW, (LAS float*)lds);
                if (!hb) break;
                it = itb + G; ha = it < NSLAB; if (ha) { da = p0_slab8(a, ws, it); tr8_wg_load(da, wa); }
                tr8_wg_finish(db, wb, FP8_SW, (LAS float*)lds);
            }
        }
        __syncthreads();
        for (int it = gw; it < NITEMS; it += NGW) { const TrItem t = p0_item(a, ws, it); f32x4 w0[8]; tr_load(t, w0, lane); tr_store(t, w0, scr, lane); }
    }
    const int gt = blockIdx.x * 512 + threadIdx.x, NGT = G * 512;
    for (int i = gt; i < 2 * 16 * 1024; i += NGT) {
        const int l = i / 16384, n = (i / 1024) & 15, k = i & 1023;
        const float v = n < 4 ? a.in[19][(size_t)l * 4096 + k * 4 + n] : 0.f;
        ((bf16*)(ws + WS_WRT))[(size_t)l * 48 * 1024 + (size_t)(32 + n) * 1024 + k] = (bf16)(cvt_pk_bf16(v, 0.f) & 0xffffu); }
    for (int i = gt; i < 4 * 128 * 128; i += NGT) {
        const int t = (i >> 7) & 127, s = i & 127; const float v = s <= t ? a.in[6][i] : 0.f;
        ((bf16*)(ws + WS_WSB))[i] = (bf16)(cvt_pk_bf16(v, 0.f) & 0xffffu); }
    if (parts & 2)
    for (int m = 4 * gw; m < M; m += 4 * NGW) norm_rows4(a.in[0] + (size_t)m * D, a.in[1], ws + WS_H + (size_t)m * 1024, (float*)(ws + WS_SH) + m, lane);
}
__device__ __forceinline__ void norm_phase(const bf16* xb, const float* g, unsigned char* H8i, float* steps, int G, int wave, int lane) {
    const int gw = blockIdx.x * 8 + wave, NGW = G * 8;
    constexpr int NR = 8;
    for (int m = NR * gw; m < M; m += NR * NGW) {
        u32x4 v[NR][2]; float s[NR], mx[NR];
#pragma unroll
        for (int r = 0; r < NR; ++r)
#pragma unroll
            for (int j = 0; j < 2; ++j) v[r][j] = ((const u32x4*)(xb + (size_t)(m + r) * D) + lane)[64 * j];
        f32x4 gg[2][2];
#pragma unroll
        for (int j = 0; j < 2; ++j) { gg[j][0] = *(const f32x4*)(g + 8 * lane + 512 * j); gg[j][1] = *(const f32x4*)(g + 8 * lane + 512 * j + 4); }
#pragma unroll
        for (int r = 0; r < NR; ++r) { s[r] = 0.f; mx[r] = 0.f;
#pragma unroll
            for (int j = 0; j < 2; ++j)
#pragma unroll
                for (int k = 0; k < 4; ++k) { const float lo = bflo(v[r][j][k]), hi = bfhi(v[r][j][k]); s[r] += lo * lo + hi * hi;
                    mx[r] = __builtin_fmaxf(mx[r], __builtin_fmaxf(__builtin_fabsf(lo * gg[j][k >> 1][2 * (k & 1)]), __builtin_fabsf(hi * gg[j][k >> 1][2 * (k & 1) + 1]))); } }
#pragma unroll
        for (int o = 1; o < 64; o <<= 1) {
#pragma unroll
            for (int r = 0; r < NR; ++r) { s[r] += __shfl_xor(s[r], o); mx[r] = __builtin_fmaxf(mx[r], __shfl_xor(mx[r], o)); } }
#pragma unroll
        for (int r = 0; r < NR; ++r) { const float rs = 1.0f / sqrtf(s[r] * (1.0f / D) + EPS); const float mm = __builtin_fmaxf(mx[r], 1e-30f), inv = 127.0f / mm;
            if (lane == 0) steps[m + r] = mm * rs * (1.0f / 127.0f);
            u32x2* hr = (u32x2*)(H8i + (size_t)(m + r) * 1024) + lane;
#pragma unroll
            for (int j = 0; j < 2; ++j) { const f32x4 g0 = gg[j][0] * inv, g1 = gg[j][1] * inv; u32x2 o;
                o.x = pk4_i8(bflo(v[r][j].x) * g0.x, bfhi(v[r][j].x) * g0.y, bflo(v[r][j].y) * g0.z, bfhi(v[r][j].y) * g0.w);
                o.y = pk4_i8(bflo(v[r][j].z) * g1.x, bfhi(v[r][j].z) * g1.y, bflo(v[r][j].w) * g1.z, bfhi(v[r][j].w) * g1.w); hr[64 * j] = o; } }
    }
}
__device__ __forceinline__ void final_norm_phase(const bf16* xb, float* out, const float* g, int G, int wave, int lane) {
    const int gw = blockIdx.x * 8 + wave, NGW = G * 8;
    constexpr int NR = 8;
    for (int m = NR * gw; m < M; m += NR * NGW) {
        u32x4 v[NR][2]; float s[NR];
#pragma unroll
        for (int r = 0; r < NR; ++r)
#pragma unroll
            for (int j = 0; j < 2; ++j) v[r][j] = ((const u32x4*)(xb + (size_t)(m + r) * D) + lane)[64 * j];
#pragma unroll
        for (int r = 0; r < NR; ++r) { s[r] = 0.f;
#pragma unroll
            for (int j = 0; j < 2; ++j)
#pragma unroll
                for (int k = 0; k < 4; ++k) { const float lo = bflo(v[r][j][k]), hi = bfhi(v[r][j][k]); s[r] += lo * lo + hi * hi; } }
#pragma unroll
        for (int o = 1; o < 64; o <<= 1) {
#pragma unroll
            for (int r = 0; r < NR; ++r) s[r] += __shfl_xor(s[r], o); }
#pragma unroll
        for (int r = 0; r < NR; ++r) { const float rs = 1.0f / sqrtf(s[r] * (1.0f / D) + EPS); float* orow = out + (size_t)(m + r) * D;
#pragma unroll
            for (int j = 0; j < 2; ++j) { const f32x4 g0 = *(const f32x4*)(g + 8 * lane + 512 * j) * rs, g1 = *(const f32x4*)(g + 8 * lane + 512 * j + 4) * rs;
                *(f32x4*)(orow + 8 * lane + 512 * j) = (f32x4){bflo(v[r][j].x) * g0.x, bfhi(v[r][j].x) * g0.y, bflo(v[r][j].y) * g0.z, bfhi(v[r][j].y) * g0.w};
                *(f32x4*)(orow + 8 * lane + 512 * j + 4) = (f32x4){bflo(v[r][j].z) * g1.x, bfhi(v[r][j].z) * g1.y, bflo(v[r][j].w) * g1.z, bfhi(v[r][j].w) * g1.w}; } }
    }
}

__device__ __forceinline__ void p2_spatial(const Args& a, LAS unsigned char* lds, int G, int wave, int lane) {
    const bf16* ZR = (const bf16*)(a.ws + WS_Z); const bf16* VT = (const bf16*)(a.ws + WS_VT); bf16* Y = (bf16*)(a.ws + WS_Y); const bf16* WSB = (const bf16*)(a.ws + WS_WSB);
    LAS unsigned char* T = lds;
    LAS float* MU = (LAS float*)(lds + 131072); LAS float* RS = MU + 128; LAS float* PART = (LAS float*)(lds + 131072 + 1024);
    const int tid = threadIdx.x, fr = lane & 15, fq = lane >> 4;
    bf16x8 Af[4][4];
    { const int hh = wave >> 1, rh = wave & 1;
#pragma unroll
        for (int ks = 0; ks < 4; ++ks)
#pragma unroll
            for (int m = 0; m < 4; ++m) Af[ks][m] = *(const bf16x8*)(WSB + (size_t)((hh * 128 + 64 * rh + 16 * m + fr) * 128 + 32 * ks + 8 * fq)); }
    for (int unit_ = blockIdx.x; unit_ < M / 128; unit_ += G) { const int unit = M / 128 - 1 - unit_;
        const size_t row0 = (size_t)unit * 128;
        u32x4 vt0[8];
#pragma unroll
        for (int p = 0; p < 8; ++p) vt0[p] = *(const u32x4*)(VT + (size_t)(p * 32 + (tid >> 4)) * M + row0 + (tid & 15) * 8);
        asm volatile("" ::: "memory");
        {
            const int cg = tid & 63, rg = tid >> 6, c0 = 8 * cg; const size_t R = row0 + 16 * rg;
            float w0[8], w1[8], w2[8], p2v[8], p1v[8];
#pragma unroll
            for (int j = 0; j < 8; ++j) { w0[j] = a.in[8][c0 + j]; w1[j] = a.in[8][512 + c0 + j]; w2[j] = a.in[8][1024 + c0 + j]; p2v[j] = 0.f; p1v[j] = 0.f; }
            if ((R & (SEQ - 1)) != 0) {
                const u32x4 c2 = *(const u32x4*)(ZR + (R - 2) * 2048 + 1024 + c0), c1 = *(const u32x4*)(ZR + (R - 1) * 2048 + 1024 + c0);
#pragma unroll
                for (int j = 0; j < 4; ++j) { p2v[2 * j] = bflo(c2[j]); p2v[2 * j + 1] = bfhi(c2[j]); p1v[2 * j] = bflo(c1[j]); p1v[2 * j + 1] = bfhi(c1[j]); }
            }
#pragma unroll 8
            for (int r = 0; r < 16; ++r) { const bf16* zr = ZR + (R + r) * 2048 + c0;
                const u32x4 gb = *(const u32x4*)(zr + 512), cxw = *(const u32x4*)(zr + 1024);
                float cx[8], y[8];
#pragma unroll
                for (int j = 0; j < 4; ++j) { cx[2 * j] = bflo(cxw[j]); cx[2 * j + 1] = bfhi(cxw[j]); }
#pragma unroll
                for (int j = 0; j < 8; ++j) { const float gbj = (j & 1) ? bfhi(gb[j >> 1]) : bflo(gb[j >> 1]); y[j] = gbj * (w0[j] * p2v[j] + w1[j] * p1v[j] + w2[j] * cx[j]); p2v[j] = p1v[j]; p1v[j] = cx[j]; }
                u32x4 o; o.x = cvt_pk_bf16(y[0], y[1]); o.y = cvt_pk_bf16(y[2], y[3]); o.z = cvt_pk_bf16(y[4], y[5]); o.w = cvt_pk_bf16(y[6], y[7]);
                *(u32x4*)(Y + (R + r) * 1024 + 512 + c0) = o; }
        }
        {   u32x4 vt[8];
#pragma unroll
            for (int p = 0; p < 8; ++p) vt[p] = *(const u32x4*)(VT + (size_t)((8 + p) * 32 + (tid >> 4)) * M + row0 + (tid & 15) * 8);
#pragma unroll
            for (int p = 0; p < 8; ++p) { const int row = p * 32 + (tid >> 4), ch = tid & 15; *(LAS u32x4*)(T + row * 256 + ((ch ^ (row & 15)) << 4)) = vt0[p]; }
#pragma unroll
            for (int p = 0; p < 8; ++p) { const int row = (8 + p) * 32 + (tid >> 4), ch = tid & 15; *(LAS u32x4*)(T + row * 256 + ((ch ^ (row & 15)) << 4)) = vt[p]; } }
        __syncthreads();
        const int sg = tid & 15, dg = tid >> 4;
        {   float s[8], q[8];
#pragma unroll
            for (int j = 0; j < 8; ++j) { s[j] = 0.f; q[j] = 0.f; }
#pragma unroll 4
            for (int rr = 0; rr < 16; ++rr) { const u32x4 v = *(const LAS u32x4*)(T + (16 * dg + rr) * 256 + ((sg ^ rr) << 4));
#pragma unroll
                for (int j = 0; j < 4; ++j) { const float lo = bflo(v[j]), hi = bfhi(v[j]); s[2 * j] += lo; q[2 * j] += lo * lo; s[2 * j + 1] += hi; q[2 * j + 1] += hi * hi; } }
#pragma unroll
            for (int j = 0; j < 8; ++j) { s[j] += __shfl_xor(s[j], 16); s[j] += __shfl_xor(s[j], 32); q[j] += __shfl_xor(q[j], 16); q[j] += __shfl_xor(q[j], 32); }
            if (lane < 16) {
#pragma unroll
                for (int j = 0; j < 8; ++j) { PART[(wave * 128 + 8 * sg + j) * 2] = s[j]; PART[(wave * 128 + 8 * sg + j) * 2 + 1] = q[j]; } }
        }
        __syncthreads();
        if (tid < 128) { float s = 0.f, q = 0.f;
#pragma unroll
            for (int w = 0; w < 8; ++w) { s += PART[(w * 128 + tid) * 2]; q += PART[(w * 128 + tid) * 2 + 1]; }
            const float mean = s * (1.0f / 512.0f); float var = q * (1.0f / 512.0f) - mean * mean; var = var > 0.f ? var : 0.f;
            MU[tid] = mean; RS[tid] = 1.0f / sqrtf(var + EPS); }
        __syncthreads();
        {   float mu8[8], rs8[8];
#pragma unroll
            for (int j = 0; j < 8; ++j) { mu8[j] = MU[8 * sg + j]; rs8[j] = RS[8 * sg + j]; }
#pragma unroll 4
            for (int rr = 0; rr < 16; ++rr) { const int row = 16 * dg + rr; const float gd = a.in[5][row]; LAS u32x4* pp = (LAS u32x4*)(T + row * 256 + ((sg ^ rr) << 4)); const u32x4 v = *pp; u32x4 o;
#pragma unroll
                for (int j = 0; j < 4; ++j) o[j] = cvt_pk_bf16((bflo(v[j]) - mu8[2 * j]) * rs8[2 * j] * gd, (bfhi(v[j]) - mu8[2 * j + 1]) * rs8[2 * j + 1] * gd);
                *pp = o; }
        }
        __syncthreads();
        {   const int hh = wave >> 1, rh = wave & 1;
#pragma unroll 1
            for (int nh = 0; nh < 2; ++nh) {
                f32x4 acc[4][4];
#pragma unroll
                for (int m = 0; m < 4; ++m)
#pragma unroll
                    for (int n = 0; n < 4; ++n) acc[m][n] = (f32x4){0.f, 0.f, 0.f, 0.f};
#pragma unroll
                for (int ks = 0; ks < 4; ++ks) {
#pragma unroll
                    for (int n = 0; n < 4; ++n) { const bf16x8 Bf = *(const LAS bf16x8*)(T + (hh * 128 + 64 * nh + 16 * n + fr) * 256 + (((4 * ks + fq) ^ fr) << 4));
#pragma unroll
                        for (int m = 0; m < 4; ++m) acc[m][n] = __builtin_amdgcn_mfma_f32_16x16x32_bf16(Bf, Af[ks][m], acc[m][n], 0, 0, 0); } }
#pragma unroll
                for (int m = 0; m < 4; ++m) { const int t = 64 * rh + 16 * m + fr; const size_t R = row0 + t; const float bias = a.in[7][hh * 128 + t];
#pragma unroll
                    for (int n = 0; n < 4; ++n) { const int d = hh * 128 + 64 * nh + 16 * n + 4 * fq; const u32x2 u4 = *(const u32x2*)(ZR + R * 2048 + d);
                        u32x2 o; o.x = cvt_pk_bf16(bflo(u4.x) * (acc[m][n][0] + bias), bfhi(u4.x) * (acc[m][n][1] + bias)); o.y = cvt_pk_bf16(bflo(u4.y) * (acc[m][n][2] + bias), bfhi(u4.y) * (acc[m][n][3] + bias));
                        *(u32x2*)(Y + R * 1024 + d) = o; } }
            }
        }
        __syncthreads();
    }
}

__device__ __forceinline__ void route_phase(const Args& a, int l, LAS unsigned char* lds, int G, int wave, int lane) {
    const bf16* X = (const bf16*)(a.ws + WS_XB); unsigned char* H8 = a.ws + WS_H;
    const bf16* WRT = (const bf16*)(a.ws + WS_WRT) + (size_t)l * 48 * 1024; const float* gvec = a.in[2] + l * 1024;
    const float* brg = a.in[20] + l * 4; const float* bre = a.in[22] + l * 32;
    unsigned* ECNT = (unsigned*)(a.ws + WS_CTL) + CW_ECNT + l * 2048; unsigned* PCNT = (unsigned*)(a.ws + WS_CTL) + CW_PCNT + l * 7168;
    unsigned* ELT = (unsigned*)(a.ws + WS_ELT); unsigned* ELG = (unsigned*)(a.ws + WS_ELG); unsigned* PLT = (unsigned*)(a.ws + WS_PLT);
    constexpr int WROW = 2064;
    LAS unsigned char* WL = lds; LAS float* GL = (LAS float*)(lds + 99072); LAS float* SCR = (LAS float*)(lds + 103168) + wave * 768;
    LAS int* TOK = (LAS int*)(lds + 127744);
    LAS int* HIST = (LAS int*)(lds + 135936);
    const int tid = threadIdx.x, fr = lane & 15, fq = lane >> 4;
    for (int tile = blockIdx.x; tile < M / 256; tile += G) {
        __syncthreads();
        for (int i = tid; i < 48 * 128; i += 512) { const int row = i >> 7, ch = i & 127; *(LAS u32x4*)(WL + row * WROW + ch * 16) = *(const u32x4*)(WRT + (size_t)row * 1024 + ch * 8); }
        if (tid < 256) *(LAS f32x4*)(GL + 4 * tid) = *(const f32x4*)(gvec + 4 * tid);
        if (tid < 288) HIST[tid] = 0;
        __syncthreads();
        for (int mt = 2 * wave; mt < 2 * wave + 2; ++mt) {
            const size_t row = (size_t)tile * 256 + 16 * mt + fr; const bf16* xr = X + row * D; unsigned char* hr = H8 + row * 1024;
            f32x4 acc[3]; acc[0] = acc[1] = acc[2] = (f32x4){0.f, 0.f, 0.f, 0.f}; float ss = 0.f;
#pragma unroll 1
            for (int kb = 0; kb < 4; ++kb) {
                u32x4 xv[8];
#pragma unroll
                for (int j = 0; j < 8; ++j) xv[j] = *(const u32x4*)(xr + 32 * (8 * kb + (j & ~1)) + 16 * fq + 8 * (j & 1));
#pragma unroll
                for (int pp = 0; pp < 4; ++pp) { u32x4 h16;
#pragma unroll
                    for (int jj = 0; jj < 2; ++jj) { const int j = 2 * pp + jj; const int k0 = 32 * (8 * kb + 2 * pp) + 16 * fq + 8 * jj; const u32x4 xw = xv[j];
                        const f32x4 x0 = (f32x4){bflo(xw.x), bfhi(xw.x), bflo(xw.y), bfhi(xw.y)}, x1 = (f32x4){bflo(xw.z), bfhi(xw.z), bflo(xw.w), bfhi(xw.w)};
                        const f32x4 g0 = *(const LAS f32x4*)(GL + k0), g1 = *(const LAS f32x4*)(GL + k0 + 4);
                        ss += (x0.x * x0.x + x0.y * x0.y) + (x0.z * x0.z + x0.w * x0.w) + (x1.x * x1.x + x1.y * x1.y) + (x1.z * x1.z + x1.w * x1.w);
                        const f32x4 y0 = x0 * g0, y1 = x1 * g1;
                        u32x4 hw; hw.x = cvt_pk_bf16(y0.x, y0.y); hw.y = cvt_pk_bf16(y0.z, y0.w); hw.z = cvt_pk_bf16(y1.x, y1.y); hw.w = cvt_pk_bf16(y1.z, y1.w);
                        const bf16x8 Af = __builtin_bit_cast(bf16x8, hw);
                        h16[2 * jj] = pk4_fp8(y0.x, y0.y, y0.z, y0.w); h16[2 * jj + 1] = pk4_fp8(y1.x, y1.y, y1.z, y1.w);
#pragma unroll
                        for (int n = 0; n < 3; ++n) { const bf16x8 Bf = *(const LAS bf16x8*)(WL + (16 * n + fr) * WROW + k0 * 2); acc[n] = __builtin_amdgcn_mfma_f32_16x16x32_bf16(Bf, Af, acc[n], 0, 0, 0); } }
                    *(u32x4*)(hr + 32 * (8 * kb + 2 * pp) + 16 * fq) = h16; } }
            ss += __shfl_xor(ss, 16); ss += __shfl_xor(ss, 32);
            const float rstd = 1.0f / sqrtf(ss * (1.0f / D) + EPS);
#pragma unroll
            for (int n = 0; n < 3; ++n)
#pragma unroll
                for (int j = 0; j < 4; ++j) SCR[fr * 48 + 16 * n + 4 * fq + j] = acc[n][j] * rstd;
            LDS_WAIT(); asm volatile("" ::: "memory");
            if (lane < 16) { const LAS float* lg = SCR + lane * 48;
                float gl[4]; int gi = 0; float gm;
#pragma unroll
                for (int j = 0; j < 4; ++j) gl[j] = lg[32 + j] + brg[j];
                gm = gl[0];
#pragma unroll
                for (int j = 1; j < 4; ++j) if (gl[j] > gm) { gm = gl[j]; gi = j; }
                float den = 0.f;
#pragma unroll
                for (int j = 0; j < 4; ++j) den += __expf(gl[j] - gm);
                const float gp = 1.0f / den;
                float el[8];
#pragma unroll
                for (int j = 0; j < 8; ++j) el[j] = lg[8 * gi + j] + bre[8 * gi + j];
                int i1 = 0; float v1 = el[0];
#pragma unroll
                for (int j = 1; j < 8; ++j) if (el[j] > v1) { v1 = el[j]; i1 = j; }
                int i2 = -1; float v2 = -3.0e38f;
#pragma unroll
                for (int j = 0; j < 8; ++j) if (j != i1 && el[j] > v2) { v2 = el[j]; i2 = j; }
                const float e21 = __expf(v2 - v1), p1 = 1.0f / (1.0f + e21), p2 = e21 * p1;
                const int e1 = 8 * gi + i1, e2 = 8 * gi + i2; const int lo = i1 < i2 ? i1 : i2, hi = i1 < i2 ? i2 : i1;
                const int p = gi * 28 + (lo * (15 - lo)) / 2 + (hi - lo - 1);
                LAS int* tk = TOK + (16 * mt + lane) * 8;
                tk[0] = e1; tk[1] = e2; tk[2] = (int)cvt_pk_bf16(gp * p1, rstd); tk[3] = (int)cvt_pk_bf16(gp * p2, rstd);
                tk[4] = __hip_atomic_fetch_add(HIST + e1, 1, __ATOMIC_RELAXED, __HIP_MEMORY_SCOPE_WORKGROUP); tk[5] = __hip_atomic_fetch_add(HIST + e2, 1, __ATOMIC_RELAXED, __HIP_MEMORY_SCOPE_WORKGROUP); tk[6] = __hip_atomic_fetch_add(HIST + 32 + p, 1, __ATOMIC_RELAXED, __HIP_MEMORY_SCOPE_WORKGROUP); tk[7] = p; }
            LDS_WAIT(); asm volatile("" ::: "memory");
        }
        __syncthreads();
        if (tid < 32) { const int c = HIST[tid]; HIST[144 + tid] = c ? (int)__hip_atomic_fetch_add(ECNT + 64 * tid, (unsigned)c, __ATOMIC_RELAXED, __HIP_MEMORY_SCOPE_AGENT) : 0; }
        else if (tid < 144) { const int j = tid - 32; const int c = HIST[32 + j]; HIST[176 + j] = c ? (int)__hip_atomic_fetch_add(PCNT + 64 * j, (unsigned)c, __ATOMIC_RELAXED, __HIP_MEMORY_SCOPE_AGENT) : 0; }
        __syncthreads();
        if (tid < 256) { const LAS int* tk = TOK + tid * 8; const unsigned tok = (unsigned)(tile * 256 + tid);
            const int e1 = tk[0], e2 = tk[1]; const unsigned h1 = e1 < e2 ? 0u : 1u;
            const size_t s1 = (size_t)e1 * 65536 + HIST[144 + e1] + tk[4], s2 = (size_t)e2 * 65536 + HIST[144 + e2] + tk[5];
            ELT[s1] = tok | (h1 << 31); ELG[s1] = (unsigned)tk[2]; ELT[s2] = tok | ((1u - h1) << 31); ELG[s2] = (unsigned)tk[3];
            PLT[(size_t)tk[7] * 65536 + HIST[176 + tk[7]] + tk[6]] = tok; }
    }
}
__device__ __forceinline__ void build_tables(LAS unsigned char* lds, unsigned* counters, int ng) {
    LAS int* pref = (LAS int*)(lds + TAB_OFF); LAS int* cnt = pref + 130;
    __syncthreads();
    if ((int)threadIdx.x < ng) cnt[threadIdx.x] = (int)__hip_atomic_load(counters + 64 * threadIdx.x, __ATOMIC_RELAXED, __HIP_MEMORY_SCOPE_AGENT);
    __syncthreads();
    if (threadIdx.x == 0) { int s = 0; for (int g = 0; g < ng; ++g) { pref[g] = s; s += (cnt[g] + 255) >> 8; } for (int g = ng; g < 130; ++g) pref[g] = s; }
    __syncthreads();
}

__device__ __forceinline__ void conv_phase(const Args& a, int G) {
    const bf16* ZC = (const bf16*)(a.ws + WS_Z); bf16* XRC = (bf16*)(a.ws + WS_H);
    const int tid = threadIdx.x, cc = tid & 127, rg = tid >> 7, c0 = 8 * cc;
    float cw[5][8];
#pragma unroll
    for (int j = 0; j < 8; ++j) { cw[4][j] = a.in[12][c0 + j];
#pragma unroll
        for (int k = 0; k < 4; ++k) cw[k][j] = a.in[11][k * 1024 + c0 + j]; }
    for (int tile_ = blockIdx.x; tile_ < M / 64; tile_ += G) { const int tile = M / 64 - 1 - tile_;
        const size_t R = (size_t)tile * 64 + 16 * rg; const int pos0 = (int)(R & (SEQ - 1));
        u32x4 v[19];
#pragma unroll
        for (int r = 0; r < 19; ++r) { v[r] = (u32x4){0u, 0u, 0u, 0u}; if (pos0 + r - 3 >= 0) v[r] = *(const u32x4*)(ZC + (R + r - 3) * 2048 + 1024 + c0); }
#pragma unroll
        for (int i = 0; i < 16; ++i) { float o[8];
#pragma unroll
            for (int j = 0; j < 8; ++j) o[j] = cw[4][j];
#pragma unroll
            for (int k = 0; k < 4; ++k) { const u32x4 x = v[i + k];
#pragma unroll
                for (int j = 0; j < 4; ++j) { o[2 * j] += cw[k][2 * j] * bflo(x[j]); o[2 * j + 1] += cw[k][2 * j + 1] * bfhi(x[j]); } }
            u32x4 w; w.x = cvt_pk_bf16(o[0], o[1]); w.y = cvt_pk_bf16(o[2], o[3]); w.z = cvt_pk_bf16(o[4], o[5]); w.w = cvt_pk_bf16(o[6], o[7]);
            *(u32x4*)(XRC + (R + i) * 1024 + c0) = w; }
    }
}
__device__ __forceinline__ void scan_chain_phase(const Args& a, LAS unsigned char* lds, int G, int vcu, int wave, int lane) {
    const bf16* ZC = (const bf16*)(a.ws + WS_Z); const bf16* XRC = (const bf16*)(a.ws + WS_H); unsigned char* Y8 = a.ws + WS_Y;
    const bf16* WAX = (const bf16*)(a.ws + WS_WAX);
    LAS unsigned char* AT = lds;
    LAS f32x2* AGG = (LAS f32x2*)(lds + 65536);
    LAS unsigned char* GT = lds + 86016;
    LAS unsigned char* WL = lds + 69632;
    const int tid = threadIdx.x, fr = lane & 15, fq = lane >> 4;
    const int cc = tid & 15, rq = tid >> 4;
    for (int chain = vcu; chain < 256; chain += G) {
        const int b = chain >> 5, hd = (chain >> 2) & 7, cg = chain & 3;
        const size_t Rbase = (size_t)b * SEQ;
        float ba[2], bx[2], kl[2]; int chj[2];
#pragma unroll
        for (int j = 0; j < 2; ++j) { chj[j] = 128 * hd + 32 * cg + 16 * j + fr; ba[j] = -1.44269504f * a.in[14][chj[j]]; bx[j] = -1.44269504f * a.in[16][chj[j]];
            kl[j] = -8.0f * 1.44269504f * log1pf(__expf(-a.in[17][chj[j]])); }
        __syncthreads();
        for (int i = tid; i < 64 * 16; i += 512) { const int row = i >> 4, ch16 = i & 15;
            *(LAS u32x4*)(WL + row * 256 + ((ch16 ^ (row & 15)) << 4)) = *(const u32x4*)(WAX + (size_t)((hd * 256 + (row >> 5) * 128 + 32 * cg + (row & 31)) * 128 + 8 * ch16)); }
        float Hc[2] = {0.f, 0.f};
        const int t0l = 32 * wave + 8 * fq;
        u32x4 pr[8], pq[2];
#define CH_LOAD(sbn) do { const size_t R0n = Rbase + 256 * (sbn); \
            _Pragma("unroll") for (int p = 0; p < 8; ++p) pr[p] = *(const u32x4*)(XRC + (R0n + p * 32 + rq) * 1024 + 128 * hd + 8 * cc); \
            _Pragma("unroll") for (int p = 0; p < 2; ++p) { const int i_ = tid + 512 * p; pq[p] = *(const u32x4*)(ZC + (R0n + (i_ >> 2)) * 2048 + 128 * hd + 32 * cg + 8 * (i_ & 3)); } } while (0)
        CH_LOAD(0);
#pragma unroll 1
        for (int sb = 0; sb < 32; ++sb) {
            const size_t R0 = Rbase + 256 * sb; const int par = sb & 1;
#pragma unroll
            for (int p = 0; p < 8; ++p) { const int t = p * 32 + rq; const int key = (((t >> 3) & 3) << 2) | (t & 3); *(LAS u32x4*)(AT + t * 256 + ((cc ^ key) << 4)) = pr[p]; }
#pragma unroll
            for (int p = 0; p < 2; ++p) { const int i_ = tid + 512 * p, t = i_ >> 2; *(LAS u32x4*)(GT + par * 16384 + t * 64 + (((i_ & 3) ^ ((t >> 3) & 3)) << 4)) = pq[p]; }
            __syncthreads();
            if (sb > 0) {
#pragma unroll
                for (int p = 0; p < 2; ++p) { const int i_ = tid + 512 * p, t = i_ >> 2;
                    const u32x4 yw = *(const LAS u32x4*)(GT + (par ^ 1) * 16384 + t * 64 + (((i_ & 3) ^ ((t >> 3) & 3)) << 4)); u32x2 y8;
                    y8.x = pk4_fp8(bflo(yw.x) * FP8_SY, bfhi(yw.x) * FP8_SY, bflo(yw.y) * FP8_SY, bfhi(yw.y) * FP8_SY); y8.y = pk4_fp8(bflo(yw.z) * FP8_SY, bfhi(yw.z) * FP8_SY, bflo(yw.w) * FP8_SY, bfhi(yw.w) * FP8_SY);
                    *(u32x2*)(Y8 + (R0 - 256 + t) * 1024 + 128 * hd + 32 * cg + 8 * (i_ & 3)) = y8; } }
            if (sb < 31) CH_LOAD(sb + 1);
            f32x4 ar[2][2], ai[2][2];
#pragma unroll
            for (int mm = 0; mm < 2; ++mm)
#pragma unroll
                for (int j = 0; j < 2; ++j) { ar[mm][j] = (f32x4){0.f, 0.f, 0.f, 0.f}; ai[mm][j] = (f32x4){0.f, 0.f, 0.f, 0.f}; }
            const int arow = 32 * wave + 8 * (fr >> 2) + (fr & 3);
#pragma unroll
            for (int ks = 0; ks < 4; ++ks) { bf16x8 Br_[2], Bi_[2];
#pragma unroll
                for (int j = 0; j < 2; ++j) { Br_[j] = *(const LAS bf16x8*)(WL + (16 * j + fr) * 256 + (((4 * ks + fq) ^ fr) << 4)); Bi_[j] = *(const LAS bf16x8*)(WL + (32 + 16 * j + fr) * 256 + (((4 * ks + fq) ^ fr) << 4)); }
#pragma unroll
                for (int mm = 0; mm < 2; ++mm) { const bf16x8 Af = *(const LAS bf16x8*)(AT + (arow + 4 * mm) * 256 + (((4 * ks + fq) ^ fr) << 4));
#pragma unroll
                    for (int j = 0; j < 2; ++j) { ar[mm][j] = __builtin_amdgcn_mfma_f32_16x16x32_bf16(Af, Br_[j], ar[mm][j], 0, 0, 0); ai[mm][j] = __builtin_amdgcn_mfma_f32_16x16x32_bf16(Af, Bi_[j], ai[mm][j], 0, 0, 0); } } }
            float av[2][8], bv[2][8], A2[2], B2[2], Ae[2], Be[2];
#pragma unroll
            for (int j = 0; j < 2; ++j) {
                const f32x2 ba2 = (f32x2){ba[j], ba[j]}, bx2 = (f32x2){bx[j], bx[j]}, kl2 = (f32x2){kl[j], kl[j]}, one2 = (f32x2){1.0f, 1.0f};
#pragma unroll
                for (int mm = 0; mm < 2; ++mm)
#pragma unroll
                    for (int ip = 0; ip < 2; ++ip) { const int i0 = 2 * ip, sidx = 4 * mm + i0, t = t0l + sidx;
                        f32x2 xr2;
                        xr2.x = bf1(*(const LAS unsigned short*)(AT + t * 256 + (((4 * cg + 2 * j + (fr >> 3)) ^ ((fq << 2) | i0)) << 4) + (fr & 7) * 2));
                        xr2.y = bf1(*(const LAS unsigned short*)(AT + (t + 1) * 256 + (((4 * cg + 2 * j + (fr >> 3)) ^ ((fq << 2) | (i0 + 1))) << 4) + (fr & 7) * 2));
                        const f32x2 zr = (f32x2){ar[mm][j][i0], ar[mm][j][i0 + 1]} + ba2, zi = (f32x2){ai[mm][j][i0], ai[mm][j][i0 + 1]} + bx2;
                        const f32x2 dr = (f32x2){__builtin_amdgcn_exp2f(zr.x), __builtin_amdgcn_exp2f(zr.y)} + one2, di = (f32x2){__builtin_amdgcn_exp2f(zi.x), __builtin_amdgcn_exp2f(zi.y)} + one2;
                        const f32x2 ka = (f32x2){__builtin_amdgcn_rcpf(dr.x), __builtin_amdgcn_rcpf(dr.y)} * kl2;
                        const f32x2 aa = (f32x2){__builtin_amdgcn_exp2f(ka.x), __builtin_amdgcn_exp2f(ka.y)};
                        f32x2 om = one2 - aa * aa; om.x = __builtin_fmaxf(om.x, 1e-30f); om.y = __builtin_fmaxf(om.y, 1e-30f);
                        const f32x2 q = om * di * di;
                        const f32x2 b2 = om * (f32x2){__builtin_amdgcn_rsqf(q.x), __builtin_amdgcn_rsqf(q.y)} * xr2;
                        av[j][sidx] = aa.x; av[j][sidx + 1] = aa.y; bv[j][sidx] = b2.x; bv[j][sidx + 1] = b2.y; }
                float As = 1.f, Bs = 0.f;
#pragma unroll
                for (int s2 = 0; s2 < 8; ++s2) { Bs = av[j][s2] * Bs + bv[j][s2]; As *= av[j][s2]; }
                float A1 = As, B1 = Bs;
                { const float Ap = __shfl_up(As, 16), Bp = __shfl_up(Bs, 16); if (fq >= 1) { A1 = Ap * As; B1 = As * Bp + Bs; } }
                A2[j] = A1; B2[j] = B1;
                { const float Ap = __shfl_up(A1, 32), Bp = __shfl_up(B1, 32); if (fq >= 2) { A2[j] = Ap * A1; B2[j] = A1 * Bp + B1; } }
                Ae[j] = __shfl_up(A2[j], 16); Be[j] = __shfl_up(B2[j], 16); if (fq == 0) { Ae[j] = 1.f; Be[j] = 0.f; }
                if (fq == 3) AGG[(par * 8 + wave) * 32 + 16 * j + fr] = (f32x2){A2[j], B2[j]};
            }
            __syncthreads();
#pragma unroll
            for (int j = 0; j < 2; ++j) {
                float hrun = Hc[j], hstart = Hc[j];
#pragma unroll
                for (int w2 = 0; w2 < 8; ++w2) { const f32x2 ab = AGG[(par * 8 + w2) * 32 + 16 * j + fr]; if (w2 == wave) hstart = hrun; hrun = ab.x * hrun + ab.y; }
                Hc[j] = hrun;
                float h = Ae[j] * hstart + Be[j];
                LAS unsigned short* gp = (LAS unsigned short*)(GT + par * 16384 + t0l * 64 + (((2 * j + (fr >> 3)) ^ fq) << 4) + (fr & 7) * 2);
#pragma unroll
                for (int s2 = 0; s2 < 8; ++s2) { h = av[j][s2] * h + bv[j][s2]; gp[s2 * 32] = (unsigned short)(cvt_pk_bf16(bf1(gp[s2 * 32]) * h, 0.f) & 0xffffu); }
            }
        }
        __syncthreads();
#pragma unroll
        for (int p = 0; p < 2; ++p) { const int i_ = tid + 512 * p, t = i_ >> 2;
            const u32x4 yw = *(const LAS u32x4*)(GT + 16384 + t * 64 + (((i_ & 3) ^ ((t >> 3) & 3)) << 4)); u32x2 y8;
            y8.x = pk4_fp8(bflo(yw.x) * FP8_SY, bfhi(yw.x) * FP8_SY, bflo(yw.y) * FP8_SY, bfhi(yw.y) * FP8_SY); y8.y = pk4_fp8(bflo(yw.z) * FP8_SY, bfhi(yw.z) * FP8_SY, bflo(yw.w) * FP8_SY, bfhi(yw.w) * FP8_SY);
            *(u32x2*)(Y8 + (Rbase + 31 * 256 + t) * 1024 + 128 * hd + 32 * cg + 8 * (i_ & 3)) = y8; }
#undef CH_LOAD
    }
}

__device__ __forceinline__ int fp8_layout_selftest(int lane) {
    const int r16 = lane & 15, g = lane >> 4; int found = 0;
#pragma unroll 1
    for (int hyp = 1; hyp <= 3; ++hyp) {
        v8i A, B;
#pragma unroll
        for (int r = 0; r < 8; ++r) { unsigned wa = 0, wb = 0; float fa[4], fb[4];
#pragma unroll
            for (int b = 0; b < 4; ++b) { int k;
                if (hyp == 1) k = 32 * g + 4 * r + b; else if (hyp == 2) k = 16 * g + 4 * (r & 3) + b + 64 * (r >> 2); else k = 8 * g + 4 * (r & 1) + b + 32 * (r >> 1);
                fa[b] = (float)(((k * 5 + r16 * 3) % 7) % 3);
                fb[b] = (float)((k * 3 + r16 * 7 + (k >> 4)) % 5); }
            wa = __builtin_amdgcn_cvt_pk_fp8_f32(fa[0], fa[1], wa, false); wa = __builtin_amdgcn_cvt_pk_fp8_f32(fa[2], fa[3], wa, true);
            wb = __builtin_amdgcn_cvt_pk_fp8_f32(fb[0], fb[1], wb, false); wb = __builtin_amdgcn_cvt_pk_fp8_f32(fb[2], fb[3], wb, true);
            A[r] = (int)wa; B[r] = (int)wb; }
        f32x4 acc = {0.f, 0.f, 0.f, 0.f};
        acc = __builtin_amdgcn_mfma_scale_f32_16x16x128_f8f6f4(A, B, acc, 0, 0, 0, 127, 0, 127);
        bool ok = true;
#pragma unroll 1
        for (int q = 0; q < 4; ++q) { const int i = 4 * g + q, j = r16; int ref = 0;
            for (int k = 0; k < 128; ++k) ref += (((k * 5 + i * 3) % 7) % 3) * ((k * 3 + j * 7 + (k >> 4)) % 5);
            ok = ok && (acc[q] == (float)ref); }
        if (__all(ok) && !found) found = hyp;
    }
    return found;
}

__global__ void __launch_bounds__(512, 2) fwd(Args args) {
    extern __shared__ __attribute__((aligned(16))) unsigned char lds_raw[];
    LAS unsigned char* lds = (LAS unsigned char*)lds_raw;
    volatile LAS unsigned* MISC = (volatile LAS unsigned*)(lds + MISC_OFF);
    const int tid = threadIdx.x, wave = __builtin_amdgcn_readfirstlane(tid >> 6), G = gridDim.x;
    const int vcu = (G % 8 == 0) ? (int)(blockIdx.x % 8) * (G / 8) + (int)(blockIdx.x / 8) : (int)blockIdx.x;
    unsigned char* ws = args.ws;
    if (tid < 64) MISC[tid] = 0u;
    __syncthreads();
    XcdBarrier bar = xcd_barrier_post((unsigned*)(ws + WS_CTL) + CW_BAR + args.li * XCD_BAR_WORDS, MISC + 8);
    const int lo = args.ph_lo, hi = args.ph_hi;
    int fp8_code = 0; if (PROBE_FP8 && blockIdx.x == 0 && wave == 0) fp8_code = fp8_layout_selftest(lane_id_v());
    if (PROBE_PHASE >= 0 && tid == 0) { const unsigned long long t_ = wall_clock64(); MISC[16] = (unsigned)t_; MISC[17] = (unsigned)(t_ >> 32); }
#define IN(k) (ph_on(k) && lo <= (k) && (k) < hi)
#ifndef PROBE_NOSTORE
#define PROBE_NOSTORE 0
#endif
#define RUN(k, ...) do { if (IN(k)) { const int ST_ON = 1; const bool rep_second_ = false; (void)rep_second_; __VA_ARGS__ } if (IN(k) && ((REP_MASK >> (k)) & 1)) { const int ST_ON = PROBE_NOSTORE ? args.pad : 1; const bool rep_second_ = true; (void)rep_second_; __VA_ARGS__ } } while (0)
#ifndef PROBE_P11DUP
#define PROBE_P11DUP 0
#endif
#ifndef PROBE_P11DUP_MODE
#define PROBE_P11DUP_MODE 0
#endif
#ifndef PROBE_BAR2
#define PROBE_BAR2 0
#endif
#define SEAM(k) do { if (IN(k) && hi > (k) + 1) { xcd_barrier(bar); if (PROBE_BAR2) xcd_barrier(bar); } if (PROBE_PHASE >= 0 && tid == 0) { const unsigned long long t_ = wall_clock64(); MISC[16 + 2 * ((k) + 1)] = (unsigned)t_; MISC[17 + 2 * ((k) + 1)] = (unsigned)(t_ >> 32); } } while (0)
#define H ((bf16*)(args.ws + WS_H))
#define Z ((bf16*)(args.ws + WS_Z))
#define Yb ((bf16*)(args.ws + WS_Y))
#define XB ((bf16*)(args.ws + WS_XB))

#ifndef PROBE_P0PARTS
#define PROBE_P0PARTS 3
#endif
    RUN(0, p0_prologue(args, lds, G, wave, lane_id_v(), ST_ON == 1 && !((REP_MASK & 1) && rep_second_) ? 3 : PROBE_P0PARTS););
    SEAM(0);
    unsigned long long pc0 = 0, pw0 = 0, pc1 = 0, pw1 = 0;
    if (PROBE_CLOCK) { pc0 = clock64(); pw0 = wall_clock64(); }
    RUN(1,
        { pg8::DenseOrder S; S.init(M, 2048, G, (int)blockIdx.x, H, 512, ws + WS_WREST, 512, 8);
          pg8::EpiZ E{Z, 2048, 2, ST_ON, 4, 1024, 1.0f, (const float*)(ws + WS_SH), (int)((WS_SWR - WS_SH) / 4), 0}; pg8::gemm_phase<pg8::EpiZ, pg8::DenseOrder, false, 2>(lds, 512, 512, 512, 8, S, E); }
        { pg8::DenseOrder S; S.init(512, M, G, (int)blockIdx.x, ws + WS_WV, 512, H, 512, 8);
          pg8::EpiZ E{(bf16*)(ws + WS_VT), M, 1 << 30, ST_ON, 1 << 30, 0, 1.0f, (const float*)(ws + WS_SH), 0, (int)((WS_SWV - WS_SH) / 4)}; pg8::gemm_phase<pg8::EpiZ, pg8::DenseOrder, false, 2>(lds, 512, 512, 512, 8, S, E); }
    );
    SEAM(1);
    RUN(2, p2_spatial(args, lds, G, wave, lane_id_v()););
    SEAM(2);
    RUN(3, pg8::DenseOrder S; S.init(M, 1024, G, (int)blockIdx.x, Yb, 1024, ws + WS_WO, 1024, 16);
        pg8::EpiRes<true> E{args.in[0], XB, 1.0f}; pg8::gemm_phase<pg8::EpiRes<true>, pg8::DenseOrder, false>(lds, 1024, 1024, 1024, 16, S, E););
    SEAM(3);
#define MOE_LAYER(l, pb) do { \
        if (IN(pb)) route_phase(args, l, lds, G, wave, lane_id_v()); \
        SEAM(pb); \
        RUN((pb) + 1, \
            build_tables(lds, (unsigned*)(ws + WS_CTL) + CW_ECNT + (l) * 2048, NE); \
            pg8::GroupOrder<false> S; S.pref = (const LAS int*)(lds + TAB_OFF); S.ng = NE; S.G = G; S.c = vcu; S.lane = lane_id_v(); \
            S.A = (const char*)H; S.W = (const char*)(ws + WS_WGU) + (size_t)(l) * 32 * 1024 * 1024; S.lists = (const unsigned*)(ws + WS_ELT); \
            pg8::EpiG1 E{(unsigned char*)Z}; pg8::gemm_phase<pg8::EpiG1, pg8::GroupOrder<false>, true, 1>(lds, 512, 512, 512, 8, S, E); \
        ); \
        SEAM((pb) + 1); \
        if (IN((pb) + 2)) { \
            build_tables(lds, (unsigned*)(ws + WS_CTL) + CW_PCNT + (l) * 7168, NPAIR); \
            pg8::GroupOrder<true> S; S.pref = (const LAS int*)(lds + TAB_OFF); S.ng = NPAIR; S.G = G; S.c = vcu; S.lane = lane_id_v(); \
            S.A = (const char*)Z; S.W = (const char*)(ws + WS_WD) + (size_t)(l) * 32 * 1024 * 512; S.lists = (const unsigned*)(ws + WS_PLT); \
            pg8::EpiG2 E{XB}; pg8::gemm_phase<pg8::EpiG2, pg8::GroupOrder<true>, true, 1>(lds, 512, 256, 512, 4, S, E); \
        } \
        SEAM((pb) + 2); } while (0)
    MOE_LAYER(0, 4);
    RUN(7, norm_phase(XB, args.in[1] + 1024, ws + WS_H, (float*)(ws + WS_SH), G, wave, lane_id_v()););
    SEAM(7);
    RUN(8, pg8::DenseOrder S; S.init(M, 2048, G, (int)blockIdx.x, H, 512, ws + WS_WC, 512, 8);
        pg8::EpiZ E{Z, 2048, 4, ST_ON, 1 << 30, 0, 1.0f, (const float*)(ws + WS_SH), (int)((WS_SWC - WS_SH) / 4), 0}; pg8::gemm_phase<pg8::EpiZ, pg8::DenseOrder, false, 2>(lds, 512, 512, 512, 8, S, E););
    SEAM(8);
    RUN(9, conv_phase(args, G););
    SEAM(9);
    RUN(10, scan_chain_phase(args, lds, G, vcu, wave, lane_id_v()););
    SEAM(10);
    if (IN(11)) { pg8::DenseOrder S; S.init(M, 1024, G, (int)blockIdx.x, Yb, 512, ws + WS_WCO, 512, 8);
        pg8::EpiRes<false> E{XB, XB, 1.0f / (FP8_SW * FP8_SY)}; pg8::gemm_phase<pg8::EpiRes<false>, pg8::DenseOrder, false, 1>(lds, 512, 512, 512, 8, S, E); }
#if PROBE_P11DUP
    if (IN(11)) { pg8::DenseOrder S; S.init(M, 1024, G, (int)blockIdx.x, Yb, 512, ws + WS_WCO, 512, 8);
        pg8::EpiRes<false> E{XB, (bf16*)(ws + WS_H), 1.0f / (FP8_SW * FP8_SY), PROBE_P11DUP_MODE + args.pad}; pg8::gemm_phase<pg8::EpiRes<false>, pg8::DenseOrder, false, 1>(lds, 512, 512, 512, 8, S, E); }
#endif
    SEAM(11);
    MOE_LAYER(1, 12);
#undef MOE_LAYER
    if (IN(15)) final_norm_phase(XB, args.out, args.in[3], G, wave, lane_id_v());
    if (PROBE_PHASE >= 0 && blockIdx.x == 0 && tid == 0) {
        const unsigned long long te = wall_clock64(); if (PROBE_PHASE == 15) { MISC[16 + 32] = (unsigned)te; MISC[17 + 32] = (unsigned)(te >> 32); }
        const unsigned long long ta = ((unsigned long long)MISC[17 + 2 * PROBE_PHASE] << 32) | MISC[16 + 2 * PROBE_PHASE], tb = ((unsigned long long)MISC[17 + 2 * (PROBE_PHASE + 1)] << 32) | MISC[16 + 2 * (PROBE_PHASE + 1)];
        const unsigned long long t0 = wall_clock64(), ticks = 4ull * (tb - ta);
        while (wall_clock64() - t0 < ticks) __builtin_amdgcn_s_sleep(8);
    }
    if (PROBE_FP8 && blockIdx.x == 0 && wave == 0) {
        const unsigned long long t0 = wall_clock64(), ticks = fp8_code ? 40000ull * fp8_code : 200000ull;
        while (wall_clock64() - t0 < ticks) __builtin_amdgcn_s_sleep(8);
    }
    if (PROBE_CLOCK && blockIdx.x == 0 && wave == 0) {
        const unsigned long long dw = pw1 - pw0, dc = pc1 - pc0;
        const unsigned long long fmhz = dw ? (dc * 100ull) / dw : 0ull;
        const unsigned long long t0 = wall_clock64(), ticks = fmhz * 100ull;
        while (wall_clock64() - t0 < ticks) __builtin_amdgcn_s_sleep(8);
    }
#undef IN
#undef SEAM
#undef H
#undef Z
#undef Yb
#undef XB
}

extern "C" void kernel_launch(void* const* d_in, const int* in_sizes, int n_in, void* d_out, int out_size, void* d_ws, size_t ws_size, hipStream_t stream) {
    static int grid = 0;
    if (grid == 0) {
        if (n_in != 26 || in_sizes[0] != M * D || out_size != M * D || ws_size < WS_END) { fprintf(stderr, "kernel_launch: unexpected shapes (n_in %d, in0 %d, out %d, ws %zu < %zu); nothing launched\n", n_in, n_in > 0 ? in_sizes[0] : -1, out_size, ws_size, (size_t)WS_END); grid = -1; return; }
        int dev = 0, cus = 0, per_cu = 0;
        if (hipGetDevice(&dev) != hipSuccess || hipDeviceGetAttribute(&cus, hipDeviceAttributeMultiprocessorCount, dev) != hipSuccess) { grid = -1; return; }
        if (hipFuncSetAttribute((const void*)fwd, hipFuncAttributeMaxDynamicSharedMemorySize, LDS_BYTES) != hipSuccess) { fprintf(stderr, "kernel_launch: hipFuncSetAttribute failed\n"); grid = -1; return; }
        if (hipOccupancyMaxActiveBlocksPerMultiprocessor(&per_cu, (const void*)fwd, 512, LDS_BYTES) != hipSuccess || per_cu < 1) fprintf(stderr, "kernel_launch: occupancy query reports %d workgroups per CU\n", per_cu);
        (void)hipGetLastError();
        grid = cus;
    }
    if (grid < 0) return;
    if (hipMemsetAsync((char*)d_ws + WS_CTL, 0, CTL_ZERO_BYTES, stream) != hipSuccess) return;
    Args a{};
    for (int i = 0; i < 26; ++i) a.in[i] = (const float*)d_in[i];
    a.out = (float*)d_out; a.ws = (unsigned char*)d_ws; a.pad = 0;
#if MK_CUTS
    int li = 0;
    for (int k = 0; k < NPH; ++k) { if (!ph_on(k)) continue;
        a.ph_lo = k; a.ph_hi = k + 1; a.li = li++; hipLaunchKernelGGL(fwd, dim3(grid), dim3(512), LDS_BYTES, stream, a); }
#else
    a.ph_lo = 0; a.ph_hi = NPH; a.li = 0;
    hipLaunchKernelGGL(fwd, dim3(grid), dim3(512), LDS_BYTES, stream, a);
#endif
    const hipError_t le = hipPeekAtLastError();
    if (le != hipSuccess) fprintf(stderr, "kernel_launch: launch failed: %s\n", hipGetErrorName(le));
}
```
